# Optimizing an MI355X kernel written in HIP

```python
import jax, jax.numpy as jnp
from jax import lax
import numpy as np

D_MODEL = 2048
BATCH = 8
SEQ = 2048
DEPTH = 4
DEC_BATCH = 16
DEC_SEQ = 16
PAST_LEN = 2048

CHUNK = 64
Q_BLOCK = 128
N_HEADS = 8
NOPE_DIM = 128
ROPE_DIM = 64
V_DIM = 128
QK_DIM = NOPE_DIM + ROPE_DIM
Q_LORA = 512
KV_LORA = 512
D_ATTN = N_HEADS * V_DIM
D_CONV = D_MODEL - D_ATTN
D_MIX = D_ATTN + D_CONV
CONV_W = 3
D_FF = 4 * D_MODEL
IN_COLS = Q_LORA + KV_LORA + ROPE_DIM + 3 * D_CONV
SPLITS = (Q_LORA, Q_LORA + KV_LORA, Q_LORA + KV_LORA + ROPE_DIM,
          Q_LORA + KV_LORA + ROPE_DIM + D_CONV, Q_LORA + KV_LORA + ROPE_DIM + 2 * D_CONV)
ROPE_BASE = 10000.0
EPS = 1e-6
ATTN_SCALE = QK_DIM ** -0.5

kernel_name = "hymba_mla_shortconv_adaln_stream_step"


def rms_norm(x, gain=None):
    xf = x.astype(jnp.float32)
    y = xf * lax.rsqrt(jnp.mean(xf * xf, axis=-1, keepdims=True) + EPS)
    if gain is not None:
        y = y * gain.astype(jnp.float32)
    return y.astype(x.dtype)


def rope_tables(pos):
    half = ROPE_DIM // 2
    inv = ROPE_BASE ** (-jnp.arange(half, dtype=jnp.float32) / half)
    ang = pos.astype(jnp.float32)[:, None] * inv[None, :]
    return jnp.cos(ang), jnp.sin(ang)


def rope(x, cos, sin):
    xf = x.astype(jnp.float32)
    x1, x2 = xf[..., :ROPE_DIM // 2], xf[..., ROPE_DIM // 2:]
    out = jnp.concatenate([x1 * cos - x2 * sin, x2 * cos + x1 * sin], axis=-1)
    return out.astype(x.dtype)


def modulation(c, w_ada, b_ada):
    m = jax.nn.silu(c) @ w_ada + b_ada
    return jnp.split(m[:, None, :], 6, axis=-1)


def expand_latent(c_kv, w_ukv):
    b, t, _ = c_kv.shape
    kv = (c_kv @ w_ukv).reshape(b, t, N_HEADS, NOPE_DIM + V_DIM)
    return kv[..., :NOPE_DIM], kv[..., NOPE_DIM:]


def attend(q_nope, q_pe, k_nope, k_pe, v, mask):
    s = (jnp.einsum('bqhd,bkhd->bhqk', q_nope, k_nope)
         + jnp.einsum('bqhr,bkr->bhqk', q_pe, k_pe)).astype(jnp.float32) * ATTN_SCALE
    if mask is not None:
        s = jnp.where(mask, s, -jnp.inf)
    p = jax.nn.softmax(s, axis=-1).astype(v.dtype)
    return jnp.einsum('bhqk,bkhd->bqhd', p, v)


def prompt_attention(q_nope, q_pe, k_nope, k_pe, v):
    b, s = q_nope.shape[:2]
    key_chunk = jnp.arange(s) // CHUNK

    def block(i):
        start = i * Q_BLOCK
        qn = lax.dynamic_slice_in_dim(q_nope, start, Q_BLOCK, axis=1)
        qp = lax.dynamic_slice_in_dim(q_pe, start, Q_BLOCK, axis=1)
        q_chunk = (start + jnp.arange(Q_BLOCK)) // CHUNK
        mask = key_chunk[None, :] <= q_chunk[:, None]
        return attend(qn, qp, k_nope, k_pe, v, mask[None, None])

    out = lax.map(block, jnp.arange(s // Q_BLOCK))
    return jnp.moveaxis(out, 0, 1).reshape(b, s, D_ATTN)


def short_conv(u, prev, w):
    t = u.shape[1]
    full = jnp.concatenate([prev.astype(u.dtype), u], axis=1)
    y = w[0] * full[:, 0:t]
    for k in range(1, CONV_W):
        y = y + w[k] * full[:, k:k + t]
    return y, full[:, t:]


def trunk_layer(x, c, cos, sin, past_ckv, past_kpe, conv_prev,
                w_ada, b_ada, w_in, q_norm, w_uq, kv_norm, w_ukv, conv_w,
                attn_out_norm, conv_out_norm, w_out, w_up, w_down):
    b, t, _ = x.shape
    sh_a, sc_a, g_a, sh_m, sc_m, g_m = modulation(c, w_ada, b_ada)
    h = rms_norm(x) * (1 + sc_a) + sh_a
    z = h @ w_in
    q_lat, kv_lat, k_pe, gate_b, gate_c, u = jnp.split(z, SPLITS, axis=-1)
    q = (rms_norm(q_lat, q_norm) @ w_uq).reshape(b, t, N_HEADS, QK_DIM)
    q_nope = q[..., :NOPE_DIM]
    q_pe = rope(q[..., NOPE_DIM:], cos[:, None, :], sin[:, None, :])
    c_kv = rms_norm(kv_lat, kv_norm)
    k_pe = rope(k_pe, cos, sin)
    if past_ckv is None:
        k_nope, v = expand_latent(c_kv, w_ukv)
        attn = prompt_attention(q_nope, q_pe, k_nope, k_pe, v)
    else:
        ckv_all = jnp.concatenate([past_ckv.astype(c_kv.dtype), c_kv], axis=1)
        kpe_all = jnp.concatenate([past_kpe.astype(k_pe.dtype), k_pe], axis=1)
        k_nope, v = expand_latent(ckv_all, w_ukv)
        attn = attend(q_nope, q_pe, k_nope, kpe_all, v, None).reshape(b, t, D_ATTN)
    conv_y, conv_state = short_conv(gate_c * u, conv_prev, conv_w)
    conv_o = gate_b * conv_y
    mix = jnp.concatenate([rms_norm(attn, attn_out_norm),
                           rms_norm(conv_o, conv_out_norm)], axis=-1) @ w_out
    x = x + g_a * mix
    h = rms_norm(x) * (1 + sc_m) + sh_m
    x = x + g_m * (jnp.square(jax.nn.relu(h @ w_up)) @ w_down)
    return x, c_kv, k_pe, conv_state


def setup_inputs(seed: int = 0) -> dict:
    key = jax.random.key(seed)
    ks = jax.random.split(key, 24)
    f32 = jnp.float32
    nrm = lambda k, shape, s: jax.random.normal(k, shape, f32) * s
    return {
        "x_prompt": nrm(ks[0], (BATCH, SEQ, D_MODEL), 1.0),
        "x_sample": nrm(ks[1], (DEC_BATCH, DEC_SEQ, D_MODEL), 1.0),
        "c_prompt": nrm(ks[2], (BATCH, D_MODEL), 1.0),
        "c_sample": nrm(ks[3], (DEC_BATCH, D_MODEL), 1.0),
        "cache_kv_latent": nrm(ks[4], (DEPTH, DEC_BATCH, PAST_LEN, KV_LORA), 1.0),
        "cache_k_rope": nrm(ks[5], (DEPTH, DEC_BATCH, PAST_LEN, ROPE_DIM), 1.0),
        "state_conv": nrm(ks[6], (DEPTH, DEC_BATCH, CONV_W - 1, D_CONV), 1.0),
        "w_ada": nrm(ks[7], (DEPTH, D_MODEL, 6 * D_MODEL), 0.3 * D_MODEL ** -0.5),
        "b_ada": nrm(ks[8], (DEPTH, 6 * D_MODEL), 0.01),
        "w_in": nrm(ks[9], (DEPTH, D_MODEL, IN_COLS), D_MODEL ** -0.5),
        "q_norm": 1.0 + nrm(ks[10], (DEPTH, Q_LORA), 0.01),
        "w_uq": nrm(ks[11], (DEPTH, Q_LORA, N_HEADS * QK_DIM), Q_LORA ** -0.5),
        "kv_norm": 1.0 + nrm(ks[12], (DEPTH, KV_LORA), 0.01),
        "w_ukv": nrm(ks[13], (DEPTH, KV_LORA, N_HEADS * (NOPE_DIM + V_DIM)), KV_LORA ** -0.5),
        "conv_w": nrm(ks[14], (DEPTH, CONV_W, D_CONV), CONV_W ** -0.5),
        "attn_out_norm": 1.0 + nrm(ks[15], (DEPTH, D_ATTN), 0.01),
        "conv_out_norm": 1.0 + nrm(ks[16], (DEPTH, D_CONV), 0.01),
        "w_out": nrm(ks[17], (DEPTH, D_MIX, D_MODEL), D_MIX ** -0.5),
        "w_up": nrm(ks[18], (DEPTH, D_MODEL, D_FF), D_MODEL ** -0.5),
        "w_down": nrm(ks[19], (DEPTH, D_FF, D_MODEL), D_FF ** -0.5),
        "final_norm": 1.0 + nrm(ks[20], (D_MODEL,), 0.01),
    }


def reference(x_prompt, x_sample, c_prompt, c_sample, cache_kv_latent, cache_k_rope, state_conv,
              w_ada, b_ada, w_in, q_norm, w_uq, kv_norm, w_ukv, conv_w,
              attn_out_norm, conv_out_norm, w_out, w_up, w_down, final_norm):
    b_p, s_p, _ = x_prompt.shape
    b_s, s_s, _ = x_sample.shape
    past_len = cache_kv_latent.shape[2]
    cos_p, sin_p = rope_tables(jnp.arange(s_p))
    cos_s, sin_s = rope_tables(past_len + jnp.arange(s_s))
    zero_conv = jnp.zeros((b_p, CONV_W - 1, D_CONV), x_prompt.dtype)

    xp, xs = x_prompt, x_sample
    ckv_p, kpe_p, conv_p, ckv_s, kpe_s, conv_s = [], [], [], [], [], []
    for l in range(DEPTH):
        params = (w_ada[l], b_ada[l], w_in[l], q_norm[l], w_uq[l], kv_norm[l], w_ukv[l],
                  conv_w[l], attn_out_norm[l], conv_out_norm[l], w_out[l], w_up[l], w_down[l])
        xp, a, k, cs = trunk_layer(xp, c_prompt, cos_p, sin_p, None, None, zero_conv, *params)
        ckv_p.append(a); kpe_p.append(k); conv_p.append(cs)
        xs, a, k, cs = trunk_layer(xs, c_sample, cos_s, sin_s, cache_kv_latent[l],
                                   cache_k_rope[l], state_conv[l], *params)
        ckv_s.append(a); kpe_s.append(k); conv_s.append(cs)

    y_prompt = rms_norm(xp, final_norm)
    y_sample = rms_norm(xs, final_norm)
    return (y_prompt, y_sample,
            jnp.stack(ckv_p), jnp.stack(kpe_p), jnp.stack(conv_p),
            jnp.stack(ckv_s), jnp.stack(kpe_s), jnp.stack(conv_s))
```

```cpp
#include <hip/hip_runtime.h>
#include <cstdio>
#include <cstdint>
namespace pg8 {
#define PG8_LAS __attribute__((address_space(3)))
typedef unsigned short bf16_t;
typedef short bf16x8 __attribute__((ext_vector_type(8)));
typedef float f32x4 __attribute__((ext_vector_type(4)));
typedef unsigned u32x4 __attribute__((ext_vector_type(4)));
constexpr int BM = 256, BK = 64, HALF = 128, HTB = HALF * BK * 2  , STAGE_BYTES = 8 * HTB, NXCD = 8, WGM = 8;

__host__ __device__ __forceinline__ int lds_byte(int r, int c) { const int st = (r >> 4) * 2 + (c >> 5), rr = r & 15, cc = c & 31, ob = rr * 64 + cc * 2; return st * 1024 + (ob ^ (((ob >> 9) & 1) << 5)); }
__host__ __device__ __forceinline__ void stage_rc(int b, int& R, int& C) { const int st = b / 1024, sb = b % 1024, swz = sb ^ (((sb >> 9) & 1) << 5); R = (st >> 1) * 16 + swz / 64; C = (st & 1) * 32 + (swz % 64) / 2; }
__host__ __device__ __forceinline__ int perm32(int rho) { const int n = rho >> 4, i = rho & 15; return 8 * (i >> 2) + 4 * n + (i & 3); }

struct Unit { int pm, pn; };
struct Gemm { const bf16_t* A; const bf16_t* Bt; int M, N, K; };

struct StaticOrder {
    int nM, nN, nwg, G, c;
    __host__ __device__ void init(int M, int N, int G_, int c_) { nM = M / BM; nN = N / BM; nwg = nM * nN; G = G_; c = c_; }
    __host__ __device__ bool next(int i, Unit& u) const {
        const long L = (long)i * G + c; if (L >= nwg) return false;
        int wgid = (int)L; { const int q = nwg / NXCD, r = nwg % NXCD, xcd = wgid % NXCD, off = wgid / NXCD; wgid = (xcd < r ? xcd * (q + 1) : r * (q + 1) + (xcd - r) * q) + off; }
        const int nig = WGM * nN, gid = wgid / nig, fm = gid * WGM, gsz = (nM - fm) < WGM ? (nM - fm) : WGM;
        u.pm = fm + ((wgid % nig) % gsz); u.pn = (wgid % nig) / gsz; return true;
    }
    __device__ __forceinline__ void a_ready(const Unit&) const {}
    __device__ __forceinline__ void done(const Unit&) const {}
};

__device__ __forceinline__ unsigned cvt_pk_bf16(float lo, float hi) { unsigned r; asm volatile("v_cvt_pk_bf16_f32 %0, %1, %2" : "=v"(r) : "v"(lo), "v"(hi)); return r; }
typedef float f32x2 __attribute__((ext_vector_type(2)));
template <class Epi, class Sched, bool ALIGN_EPI = false, bool SP2 = false>
__device__ __forceinline__ void gemm_phase(PG8_LAS unsigned char* lds, const Gemm g, const Sched& S, const Epi& E, const int wave_s  ) {
    int tid_l = __builtin_amdgcn_mbcnt_hi(~0u, __builtin_amdgcn_mbcnt_lo(~0u, 0u)); asm volatile("" : "+v"(tid_l)); tid_l += wave_s * 64;
    const int tid = tid_l, wid = wave_s, lane = tid & 63, wr = wid >> 2, wc = wid & 3, fr = lane & 15, fq = lane >> 4;
    const int K = g.K, nt = K / BK;
    unsigned voffA[2], voffB[2];
#pragma unroll
    for (int i = 0; i < 2; ++i) { int R, C; stage_rc(tid * 16 + i * 8192, R, C); const int Rb = Epi::PERM ? ((R & ~31) + perm32(R & 31)) : R;
        voffA[i] = (unsigned)(R * K + C) * 2u; voffB[i] = (unsigned)(Rb * K + C) * 2u; }
    const size_t kstep = (size_t)(BK * 2);
    const size_t hstep = (size_t)HALF * K * 2;
    const size_t tstep = 2 * hstep;
    const unsigned ldsw = (unsigned)wid * 1024u;
    const int aoff = lds_byte(wr * 64 + fr, fq * 8), boff = lds_byte(wc * 32 + fr, fq * 8);
#define PG8_SA(b, h) (((b) * 2 + (h)) * HTB)
#define PG8_SB(b, h) ((4 + (b) * 2 + (h)) * HTB)
#define PG8_STAGE(bufoff, gbase, voff) do { _Pragma("unroll") for (int _i = 0; _i < 2; ++_i) \
        __builtin_amdgcn_global_load_lds((const unsigned*)((const char*)(gbase) + (voff)[_i]), (PG8_LAS unsigned*)(lds + (bufoff) + ldsw + _i * 8192), 16, 0, 0); } while (0)
#define PG8_LDA(dst, b, h) do { _Pragma("unroll") for (int m = 0; m < 4; ++m) _Pragma("unroll") for (int k = 0; k < 2; ++k) dst[m][k] = *(const PG8_LAS bf16x8*)(lds + PG8_SA(b, h) + aoff + m * 2048 + k * 1024); } while (0)
#define PG8_LDB(dst, b, h) do { _Pragma("unroll") for (int n = 0; n < 2; ++n) _Pragma("unroll") for (int k = 0; k < 2; ++k) dst[n][k] = *(const PG8_LAS bf16x8*)(lds + PG8_SB(b, h) + boff + n * 2048 + k * 1024); } while (0)
#define PG8_MMA(ai, bj, At, Bt) do { __builtin_amdgcn_s_setprio(1); _Pragma("unroll") for (int m = 0; m < 4; ++m) _Pragma("unroll") for (int n = 0; n < 2; ++n) _Pragma("unroll") for (int k = 0; k < 2; ++k) \
        acc[ai][bj][m][n] = __builtin_amdgcn_mfma_f32_16x16x32_bf16(Bt[n][k], At[m][k], acc[ai][bj][m][n], 0, 0, 0); __builtin_amdgcn_s_setprio(0); } while (0)
#define PG8_WAIT_V(n) asm volatile("s_waitcnt vmcnt(" #n ")" ::: "memory")
#define PG8_WAIT_L(n) asm volatile("s_waitcnt lgkmcnt(" #n ")" ::: "memory")
#define PG8_BAR __builtin_amdgcn_s_barrier()
#define PG8_SCHED __builtin_amdgcn_sched_barrier(0)
    Unit cur, nxt; int ui = 0;
    if (!S.next(0, cur)) return;
    f32x4 acc[2][2][4][2];
#pragma unroll
    for (int a = 0; a < 2; ++a)
#pragma unroll
        for (int b = 0; b < 2; ++b)
#pragma unroll
            for (int m = 0; m < 4; ++m)
#pragma unroll
                for (int n = 0; n < 2; ++n) acc[a][b][m][n] = (f32x4){0.f, 0.f, 0.f, 0.f};
    bf16x8 At[4][2], B0[2][2], B1[2][2];
    const char* cA = (const char*)g.A + (size_t)cur.pm * tstep; const char* cB = (const char*)g.Bt + (size_t)cur.pn * tstep;
    S.a_ready(cur);
    if constexpr (SP2) {
        PG8_STAGE(PG8_SB(0, 0), cB, voffB); PG8_STAGE(PG8_SB(0, 1), cB + hstep, voffB); PG8_STAGE(PG8_SA(0, 0), cA, voffA); PG8_STAGE(PG8_SA(0, 1), cA + hstep, voffA);
        if (wr == 1) PG8_BAR;
        PG8_WAIT_V(2); PG8_BAR;
        PG8_STAGE(PG8_SB(1, 0), cB + kstep, voffB); PG8_STAGE(PG8_SA(1, 0), cA + kstep, voffA); PG8_STAGE(PG8_SB(1, 1), cB + hstep + kstep, voffB);
        PG8_WAIT_V(6); PG8_BAR;
    } else {
        PG8_STAGE(PG8_SB(0, 0), cB, voffB); PG8_STAGE(PG8_SA(0, 0), cA, voffA); PG8_STAGE(PG8_SB(0, 1), cB + hstep, voffB); PG8_STAGE(PG8_SA(0, 1), cA + hstep, voffA);
        if (wr == 1) PG8_BAR;
        PG8_WAIT_V(4); PG8_BAR;
        PG8_STAGE(PG8_SB(1, 0), cB + kstep, voffB); PG8_STAGE(PG8_SA(1, 0), cA + kstep, voffA); PG8_STAGE(PG8_SB(1, 1), cB + hstep + kstep, voffB);
        PG8_WAIT_V(6); PG8_BAR;
    }
    for (;;) {
        const bool has_next = S.next(ui + 1, nxt);
        const char* nA = has_next ? (const char*)g.A + (size_t)nxt.pm * tstep : cA; const char* nB = has_next ? (const char*)g.Bt + (size_t)nxt.pn * tstep : cB;
        for (int t = 0; t < nt; t += 2) {
            const bool last = (t == nt - 2);
            const char* a1 = cA + (size_t)(t + 1) * kstep;
            const char* a2 = last ? nA : cA + (size_t)(t + 2) * kstep; const char* b2 = last ? nB : cB + (size_t)(t + 2) * kstep;
            const char* a3 = a2 + kstep; const char* b3 = b2 + kstep;
            if (last && has_next) S.a_ready(nxt);
            if constexpr (SP2) {
            PG8_LDB(B0, 0, 0); PG8_LDB(B1, 0, 1); PG8_SCHED; PG8_LDA(At, 0, 0); PG8_STAGE(PG8_SA(1, 1), a1 + hstep, voffA);
            PG8_WAIT_V(8); PG8_WAIT_L(0); PG8_BAR; PG8_MMA(0, 0, At, B0); PG8_MMA(0, 1, At, B1); PG8_BAR; PG8_SCHED;
            PG8_LDA(At, 0, 1); PG8_STAGE(PG8_SB(0, 0), b2, voffB); PG8_STAGE(PG8_SB(0, 1), b2 + hstep, voffB); PG8_STAGE(PG8_SA(0, 0), a2, voffA);
            PG8_WAIT_V(8); PG8_WAIT_L(0); PG8_BAR; PG8_MMA(1, 0, At, B0); PG8_MMA(1, 1, At, B1); PG8_BAR; PG8_SCHED;
            PG8_LDB(B0, 1, 0); PG8_LDB(B1, 1, 1); PG8_SCHED; PG8_LDA(At, 1, 0); PG8_STAGE(PG8_SA(0, 1), a2 + hstep, voffA);
            PG8_WAIT_V(8); PG8_WAIT_L(0); PG8_BAR; PG8_MMA(0, 0, At, B0); PG8_MMA(0, 1, At, B1); PG8_BAR; PG8_SCHED;
            PG8_LDA(At, 1, 1); PG8_STAGE(PG8_SB(1, 0), b3, voffB); PG8_STAGE(PG8_SB(1, 1), b3 + hstep, voffB); PG8_STAGE(PG8_SA(1, 0), a3, voffA);
            PG8_WAIT_V(8); PG8_WAIT_L(0); PG8_BAR; PG8_MMA(1, 0, At, B0); PG8_MMA(1, 1, At, B1); PG8_BAR; PG8_SCHED;
            } else {
            PG8_LDB(B0, 0, 0); PG8_SCHED; PG8_LDA(At, 0, 0); PG8_STAGE(PG8_SA(1, 1), a1 + hstep, voffA);
            PG8_WAIT_L(8); PG8_BAR; PG8_WAIT_L(0); PG8_MMA(0, 0, At, B0); PG8_BAR; PG8_SCHED;
            PG8_LDB(B1, 0, 1); PG8_STAGE(PG8_SB(0, 0), b2, voffB);
            PG8_BAR; PG8_WAIT_L(0); PG8_MMA(0, 1, At, B1); PG8_BAR;
            PG8_LDA(At, 0, 1); PG8_STAGE(PG8_SA(0, 0), a2, voffA);
            PG8_BAR; PG8_WAIT_L(0); PG8_MMA(1, 0, At, B0); PG8_BAR; PG8_SCHED;
            PG8_STAGE(PG8_SB(0, 1), b2 + hstep, voffB);
            PG8_WAIT_V(6); PG8_BAR; PG8_MMA(1, 1, At, B1); PG8_BAR;
            PG8_LDB(B0, 1, 0); PG8_SCHED; PG8_LDA(At, 1, 0); PG8_STAGE(PG8_SA(0, 1), a2 + hstep, voffA);
            PG8_WAIT_L(8); PG8_BAR; PG8_WAIT_L(0); PG8_MMA(0, 0, At, B0); PG8_BAR; PG8_SCHED;
            PG8_LDB(B1, 1, 1); PG8_STAGE(PG8_SB(1, 0), b3, voffB);
            PG8_BAR; PG8_WAIT_L(0); PG8_MMA(0, 1, At, B1); PG8_BAR;
            PG8_LDA(At, 1, 1); PG8_STAGE(PG8_SA(1, 0), a3, voffA);
            PG8_BAR; PG8_WAIT_L(0); PG8_MMA(1, 0, At, B0); PG8_BAR; PG8_SCHED;
            PG8_STAGE(PG8_SB(1, 1), b3 + hstep, voffB);
            PG8_WAIT_V(6); PG8_BAR; PG8_MMA(1, 1, At, B1); PG8_BAR;
            }
        }
        if constexpr (ALIGN_EPI) { if (wr == 0) PG8_BAR; }
        if constexpr (!Epi::AFTER_DRAIN) { E(acc, cur, wr, wc, fr, fq); S.done(cur); }
        if (!has_next) break;
#pragma unroll
        for (int a = 0; a < 2; ++a)
#pragma unroll
            for (int b = 0; b < 2; ++b)
#pragma unroll
                for (int m = 0; m < 4; ++m)
#pragma unroll
                    for (int n = 0; n < 2; ++n) acc[a][b][m][n] = (f32x4){0.f, 0.f, 0.f, 0.f};
        cur = nxt; cA = nA; cB = nB; ++ui;
        if constexpr (ALIGN_EPI) { if (wr == 1) PG8_BAR; }
    }
    PG8_WAIT_V(0);
    if constexpr (!ALIGN_EPI) { if (wr == 0) PG8_BAR; }
    PG8_BAR;
    if constexpr (Epi::AFTER_DRAIN) { E.fused(acc, cur, wr, wc, fr, fq, lds, wid, lane); S.done(cur); }
#undef PG8_SA
#undef PG8_SB
#undef PG8_STAGE
#undef PG8_LDA
#undef PG8_LDB
#undef PG8_MMA
#undef PG8_WAIT_V
#undef PG8_WAIT_L
#undef PG8_BAR
#undef PG8_SCHED
}
}
#define GAS __attribute__((address_space(1)))
#define LAS __attribute__((address_space(3)))
typedef unsigned short bf16;
typedef unsigned v4u __attribute__((ext_vector_type(4)));
typedef float f32x4 __attribute__((ext_vector_type(4)));
typedef short bf16x8 __attribute__((ext_vector_type(8)));
typedef GAS unsigned gu32;
typedef GAS unsigned long long gu64;
#define RLX_AGENT __ATOMIC_RELAXED, __HIP_MEMORY_SCOPE_AGENT
#define LDS_WAIT() asm volatile("s_waitcnt lgkmcnt(0)" ::: "memory")
#define VM_WAIT() asm volatile("s_waitcnt vmcnt(0)" ::: "memory")
__device__ __forceinline__ unsigned long long rt() { return __builtin_amdgcn_s_memrealtime(); }
__device__ __forceinline__ unsigned f2bf(float f) { unsigned u = __builtin_bit_cast(unsigned, f); return (u + 0x7fffu + ((u >> 16) & 1u)) >> 16; }
__device__ __forceinline__ unsigned pk2(float lo, float hi) { return f2bf(lo) | (f2bf(hi) << 16); }
#define XB_TMO      128
#define XB_XCNT(j)  (256  + 64 * (j))
#define XB_XSUB(j)  (1280 + 64 * (j))
#define XB_XGEN(j)  (2304 + 64 * (j))
#define XB_TOP      3328
#define XB_TOPGEN   3392
#define XCD_BAR_WORDS 3456
#define XB_SPIN_CAP (1u << 18)

__device__ __forceinline__ unsigned xb_ld(unsigned* p)              { return __hip_atomic_load(p, __ATOMIC_RELAXED, __HIP_MEMORY_SCOPE_AGENT); }
__device__ __forceinline__ unsigned xb_add(unsigned* p, unsigned v) { return __hip_atomic_fetch_add(p, v, __ATOMIC_RELAXED, __HIP_MEMORY_SCOPE_AGENT); }
__device__ __forceinline__ unsigned xb_xcc_id() { return (unsigned)__builtin_amdgcn_s_getreg((3 << 11) | 20) & 0xFu; }
#define XB_SPIN(cond, bar) do { unsigned _sp = 0; while (cond) { __builtin_amdgcn_s_sleep(1); \
    if ((++_sp & 255u) == 0u) { if (xb_ld(&(bar)[XB_TMO])) break; if (_sp > XB_SPIN_CAP) { atomicAdd(&(bar)[XB_TMO], 1u); break; } } } } while (0)

struct XcdBarrier {
    unsigned* bar; unsigned x;
    volatile LAS unsigned* st;
};

__device__ __forceinline__ XcdBarrier xcd_barrier_post(unsigned* bar, volatile LAS unsigned* st) {
    XcdBarrier b; b.bar = bar; b.x = xb_xcc_id(); b.st = st;
    if (threadIdx.x == 0) (void)xb_add(&bar[XB_XCNT(b.x)], 1u);
    return b;
}
__device__ __forceinline__ void xcd_barrier_complete(unsigned* bar, unsigned x, unsigned& nloc, unsigned& nx) {
    const unsigned G = gridDim.x * gridDim.y * gridDim.z;
    unsigned sum, cnt, mine, sp = 0u;
    for (;;) {
        sum = 0u; cnt = 0u; mine = 0u;
#pragma unroll
        for (unsigned j = 0; j < 16; ++j) { const unsigned c = xb_ld(&bar[XB_XCNT(j)]); sum += c; cnt += (c > 0u) ? 1u : 0u; mine = (j == x) ? c : mine; }
        if (sum == G) break;
        __builtin_amdgcn_s_sleep(1);
        if ((++sp & 255u) == 0u) { if (xb_ld(&bar[XB_TMO])) break; if (sp > XB_SPIN_CAP) { atomicAdd(&bar[XB_TMO], 1u); break; } }
    }
    nloc = mine > 0u ? mine : 1u; nx = cnt > 0u ? cnt : 1u;
}

__device__ __forceinline__ void xcd_barrier(const XcdBarrier& b) {
    asm volatile("s_waitcnt vmcnt(0)" ::: "memory");
    __syncthreads();
    if (threadIdx.x == 0) {
        unsigned* bar = b.bar;
        __builtin_amdgcn_s_waitcnt(0);
        unsigned nloc = b.st[0], nx = b.st[1];
        if (nloc == 0u) { xcd_barrier_complete(bar, b.x, nloc, nx); b.st[0] = nloc; b.st[1] = nx; }
        const unsigned old = xb_add(&bar[XB_XSUB(b.x)], 1u);
        const unsigned gen = old / nloc;
        if (old + 1u == (gen + 1u) * nloc) {
            __builtin_amdgcn_fence(__ATOMIC_RELEASE, "agent");
            asm volatile("s_waitcnt vmcnt(0)" ::: "memory");
            const unsigned og = xb_add(&bar[XB_TOP], 1u);
            const unsigned tg = og / nx;
            if (og + 1u == (tg + 1u) * nx) xb_add(&bar[XB_TOPGEN], 1u);
            else XB_SPIN(xb_ld(&bar[XB_TOPGEN]) == tg, bar);
            __builtin_amdgcn_fence(__ATOMIC_ACQUIRE, "agent");
            xb_add(&bar[XB_XGEN(b.x)], 1u);
            asm volatile("s_waitcnt vmcnt(0)" ::: "memory");
        } else {
            XB_SPIN(xb_ld(&bar[XB_XGEN(b.x)]) == gen, bar);
            __builtin_amdgcn_fence(__ATOMIC_ACQUIRE, "agent");
            asm volatile("s_waitcnt vmcnt(0)" ::: "memory");
        }
    }
    __syncthreads();
}

constexpr int DM = 2048, SEQ = 2048, NBP = 8, NBS = 16, TS = 16, PAST = 2048, DEPTH = 4;
constexpr int MP = NBP * SEQ, MS = NBS * TS, MR = MP + MS, MC = NBS * PAST, MKV = MR + MC;
constexpr int NH = 8, QKD = 192, QLR = 512, KVLR = 512, DATT = 1024, DCONV = 1024, DFF = 8192, INC = 4160;
constexpr int ZW = 3072, NQ = NH * QKD, NKV = NH * 256, MODW = 6 * DM, NB = NBP + NBS;
constexpr int NPOS = PAST + TS;
constexpr float EPS = 1e-6f;
constexpr float ATTN_SCALE = 0.07216878364870322f;
constexpr float LOG2E = 1.4426950408889634f;

namespace pg8 {
template <int ACT> struct EpiStore {
    static constexpr bool PERM = true, AFTER_DRAIN = false;
    bf16_t* O; int ldc;
    __device__ __forceinline__ void operator()(const f32x4 (&acc)[2][2][4][2], const Unit& u, int wr, int wc, int fr, int fq) const {
        const int row0 = u.pm * BM + wr * 64 + fr, col0 = u.pn * BM + wc * 32 + 8 * fq;
#pragma unroll
        for (int ai = 0; ai < 2; ++ai)
#pragma unroll
            for (int m = 0; m < 4; ++m) { bf16_t* rowp = O + (size_t)(row0 + ai * HALF + m * 16) * ldc + col0;
#pragma unroll
                for (int bj = 0; bj < 2; ++bj) { f32x4 v0 = acc[ai][bj][m][0], v1 = acc[ai][bj][m][1];
                    if (ACT == 1) {
#pragma unroll
                        for (int e = 0; e < 4; ++e) { const float a = v0[e] > 0.f ? v0[e] : 0.f, b = v1[e] > 0.f ? v1[e] : 0.f; v0[e] = a * a; v1[e] = b * b; } }
                    u32x4 w; w.x = cvt_pk_bf16(v0[0], v0[1]); w.y = cvt_pk_bf16(v0[2], v0[3]); w.z = cvt_pk_bf16(v1[0], v1[1]); w.w = cvt_pk_bf16(v1[2], v1[3]);
                    *(u32x4*)(rowp + bj * HALF) = w; } }
    }
};
struct EpiZ {
    static constexpr bool PERM = true, AFTER_DRAIN = false;
    bf16_t* O;
    __device__ __forceinline__ void operator()(const f32x4 (&acc)[2][2][4][2], const Unit& u, int wr, int wc, int fr, int fq) const {
        const int row0 = u.pm * BM + wr * 64 + fr, lc = wc * 32 + 8 * fq;
        const bool prod = (u.pn >= 4 && u.pn < 12);
        const int colb = prod ? 1024 + 128 * (u.pn - 4) : (u.pn < 4 ? 256 * u.pn : 2048 + 256 * (u.pn - 12));
#pragma unroll
        for (int ai = 0; ai < 2; ++ai)
#pragma unroll
            for (int m = 0; m < 4; ++m) { bf16_t* rowp = O + (size_t)(row0 + ai * HALF + m * 16) * ZW + colb + lc;
                if (prod) { const f32x4 v0 = acc[ai][0][m][0] * acc[ai][1][m][0], v1 = acc[ai][0][m][1] * acc[ai][1][m][1];
                    u32x4 w; w.x = cvt_pk_bf16(v0[0], v0[1]); w.y = cvt_pk_bf16(v0[2], v0[3]); w.z = cvt_pk_bf16(v1[0], v1[1]); w.w = cvt_pk_bf16(v1[2], v1[3]);
                    *(u32x4*)(rowp) = w; }
                else {
#pragma unroll
                    for (int bj = 0; bj < 2; ++bj) { const f32x4 v0 = acc[ai][bj][m][0], v1 = acc[ai][bj][m][1];
                        u32x4 w; w.x = cvt_pk_bf16(v0[0], v0[1]); w.y = cvt_pk_bf16(v0[2], v0[3]); w.z = cvt_pk_bf16(v1[0], v1[1]); w.w = cvt_pk_bf16(v1[2], v1[3]);
                        *(u32x4*)(rowp + bj * HALF) = w; } } }
    }
};
struct EpiResid {
    static constexpr bool PERM = false, AFTER_DRAIN = false;
    const float* xin; float* xout; const float* gate;
    __device__ __forceinline__ void operator()(const f32x4 (&acc)[2][2][4][2], const Unit& u, int wr, int wc, int fr, int fq) const {
        const int col0 = u.pn * BM + wc * 32 + 4 * fq;
        const bool samp = (u.pm >= MP / BM);
#pragma unroll
        for (int ai = 0; ai < 2; ++ai)
#pragma unroll
            for (int m = 0; m < 4; ++m) { const int rl = ai * HALF + wr * 64 + m * 16;
                const int b = samp ? NBP + (rl >> 4) : (u.pm >> 3);
                const float* g = gate + (size_t)b * MODW + col0;
                const size_t off = (size_t)(u.pm * BM + rl + fr) * DM + col0;
#pragma unroll
                for (int bj = 0; bj < 2; ++bj)
#pragma unroll
                    for (int n = 0; n < 2; ++n) { const f32x4 gv = *(const f32x4*)(g + bj * HALF + n * 16); const f32x4 xv = *(const f32x4*)(xin + off + bj * HALF + n * 16);
                        *(f32x4*)(xout + off + bj * HALF + n * 16) = xv + gv * acc[ai][bj][m][n]; } }
    }
};
}

namespace att {
using bf16x8 = __attribute__((ext_vector_type(8))) short;
using s16x4  = __attribute__((ext_vector_type(4))) short;
using f32x16 = __attribute__((ext_vector_type(16))) float;
using f32x4  = __attribute__((ext_vector_type(4))) float;
using u32x4  = __attribute__((ext_vector_type(4))) unsigned;
typedef unsigned short bf16_t;
constexpr int NW = 8, QBLK = 32, KVBLK = 64;
constexpr int SHM_V = KVBLK * 128 * 2, SHM_KN = KVBLK * 128 * 2, SHM_KP = KVBLK * 64 * 2;
constexpr int OFF_V = 0, OFF_KN = 2 * SHM_V, OFF_KP = OFF_KN + 2 * SHM_KN, OFF_WS = OFF_KP + 2 * SHM_KP, OFF_QP = OFF_WS + NW * 64 * 4, ATT_LDS = OFF_QP + NW * 4 * 1024;
constexpr float THR = 8.f;
constexpr float CSC = ATTN_SCALE * LOG2E;
#define KSWZ(row, colB) ((row) * 256 + ((colB) ^ (((row) & 7) << 4)))
#define PSWZ(row, colB) ((row) * 128 + ((colB) ^ (((row) & 7) << 4)))
#define SBAR() __builtin_amdgcn_sched_barrier(0)
__device__ __forceinline__ int crow(int r, int hi) { return (r & 3) + 8 * (r >> 2) + 4 * hi; }
__device__ __forceinline__ unsigned cvtpk(float lo, float hi) { unsigned r; asm volatile("v_cvt_pk_bf16_f32 %0, %1, %2" : "=v"(r) : "v"(lo), "v"(hi)); return r; }
__device__ __forceinline__ float bflo(unsigned w) { return __uint_as_float(w << 16); }
__device__ __forceinline__ float bfhi(unsigned w) { return __uint_as_float(w & 0xffff0000u); }

__device__ __forceinline__ void partialSM(f32x16& p0, f32x16& p1, float& m_reg, float& mn, float& alpha) {
  float pmax = p0[0];
#pragma unroll
  for (int r = 1; r < 16; ++r) pmax = fmaxf(pmax, p0[r]);
#pragma unroll
  for (int r = 0; r < 16; ++r) pmax = fmaxf(pmax, p1[r]);
  { auto rr = __builtin_amdgcn_permlane32_swap(__float_as_uint(pmax), __float_as_uint(pmax), false, false);
    pmax = fmaxf(__uint_as_float(rr[0]), __uint_as_float(rr[1])); }
  if (__builtin_expect(__all(pmax - m_reg <= THR / ATTN_SCALE), 1)) { mn = m_reg; alpha = 1.f; }
  else { mn = fmaxf(m_reg, pmax); alpha = __builtin_amdgcn_exp2f((m_reg - mn) * CSC); m_reg = mn; }
  const float mnC = -mn * CSC;
#pragma unroll
  for (int r = 0; r < 16; ++r) p0[r] = fmaf(p0[r], CSC, mnC);
#pragma unroll
  for (int r = 0; r < 16; ++r) p1[r] = fmaf(p1[r], CSC, mnC);
#pragma unroll
  for (int r = 0; r < 16; ++r) p0[r] = __builtin_amdgcn_exp2f(p0[r]);
}
__device__ __forceinline__ void finishSM(f32x16& p0, f32x16& p1, float alpha, float& l_reg, bf16x8& pa0, bf16x8& pa1, bf16x8& pa2, bf16x8& pa3) {
#pragma unroll
  for (int r = 0; r < 16; ++r) p1[r] = __builtin_amdgcn_exp2f(p1[r]);
  float ps = 0;
#pragma unroll
  for (int r = 0; r < 16; ++r) ps += p0[r];
#pragma unroll
  for (int r = 0; r < 16; ++r) ps += p1[r];
  { auto rr = __builtin_amdgcn_permlane32_swap(__float_as_uint(ps), __float_as_uint(ps), false, false);
    ps = __uint_as_float(rr[0]) + __uint_as_float(rr[1]); }
  l_reg = l_reg * alpha + ps;
#define PK4(P, BASE, OUT) do { unsigned a0 = cvtpk(P[BASE + 0], P[BASE + 1]), a1 = cvtpk(P[BASE + 2], P[BASE + 3]);   \
    unsigned b0 = cvtpk(P[BASE + 4], P[BASE + 5]), b1 = cvtpk(P[BASE + 6], P[BASE + 7]);                              \
    auto r0 = __builtin_amdgcn_permlane32_swap(a0, b0, false, false); auto r1 = __builtin_amdgcn_permlane32_swap(a1, b1, false, false); \
    u32x4 w = {r0[0], r1[0], r0[1], r1[1]}; OUT = *reinterpret_cast<bf16x8*>(&w); } while (0)
  PK4(p0, 0, pa0); PK4(p0, 8, pa1); PK4(p1, 0, pa2); PK4(p1, 8, pa3);
#undef PK4
}
__device__ __forceinline__ void qkt(f32x16& p0, f32x16& p1, const char* Kn, const char* Kp, const bf16x8* qr, const char* qp, int r32, int hi) {
  p0 = f32x16{}; p1 = f32x16{};
#pragma unroll
  for (int d0 = 0; d0 < 8; ++d0) { const int cb = (d0 * 16 + hi * 8) * 2;
    const bf16x8 b0 = *reinterpret_cast<const bf16x8*>(Kn + KSWZ(r32, cb));
    const bf16x8 b1 = *reinterpret_cast<const bf16x8*>(Kn + KSWZ(32 + r32, cb));
    p0 = __builtin_amdgcn_mfma_f32_32x32x16_bf16(b0, qr[d0], p0, 0, 0, 0);
    p1 = __builtin_amdgcn_mfma_f32_32x32x16_bf16(b1, qr[d0], p1, 0, 0, 0); }
#pragma unroll
  for (int d0 = 0; d0 < 4; ++d0) { const int cb = (d0 * 16 + hi * 8) * 2;
    const bf16x8 b0 = *reinterpret_cast<const bf16x8*>(Kp + PSWZ(r32, cb));
    const bf16x8 b1 = *reinterpret_cast<const bf16x8*>(Kp + PSWZ(32 + r32, cb));
    const bf16x8 qd = *reinterpret_cast<const bf16x8*>(qp + d0 * 1024);
    p0 = __builtin_amdgcn_mfma_f32_32x32x16_bf16(b0, qd, p0, 0, 0, 0);
    p1 = __builtin_amdgcn_mfma_f32_32x32x16_bf16(b1, qd, p1, 0, 0, 0); }
}
__device__ __forceinline__ void maskt(f32x16& p0, f32x16& p1, bool hide) {
  if (hide) {
#pragma unroll
    for (int r = 0; r < 16; ++r) { p0[r] = -INFINITY; p1[r] = -INFINITY; } }
}
__device__ __forceinline__ int v_st(int k, int c) { const int kk = (k & ~0xC) | ((k & 4) << 1) | ((k & 8) >> 1); return ((kk >> 3) * 4 + (c >> 5)) * 512 + ((kk & 7) * 32 + (c & 31)) * 2; }
__device__ __forceinline__ int v_rd_base(int lane) { return ((lane & 3) << 3) | (((lane >> 2) & 3) << 6) | (((lane >> 4) & 1) << 5) | (((lane >> 5) & 1) << 8); }
constexpr int v_rd_off(int d0, int ks, int half) { return d0 * 512 + ks * 4096 + half * 2048; }
template <int OFF> __device__ __forceinline__ s16x4 tr_read(int vb) {
  s16x4 r; asm volatile("ds_read_b64_tr_b16 %0, %1 offset:%2" : "=&v"(r) : "v"(vb), "i"(OFF) : "memory"); return r;
}
template <int D0> __device__ __forceinline__ void pv_one(f32x16& od, int vb, bf16x8 pa0, bf16x8 pa1, bf16x8 pa2, bf16x8 pa3) {
  const s16x4 l0 = tr_read<v_rd_off(D0, 0, 0)>(vb), h0 = tr_read<v_rd_off(D0, 0, 1)>(vb), l1 = tr_read<v_rd_off(D0, 1, 0)>(vb), h1 = tr_read<v_rd_off(D0, 1, 1)>(vb);
  const s16x4 l2 = tr_read<v_rd_off(D0, 2, 0)>(vb), h2 = tr_read<v_rd_off(D0, 2, 1)>(vb), l3 = tr_read<v_rd_off(D0, 3, 0)>(vb), h3 = tr_read<v_rd_off(D0, 3, 1)>(vb);
  asm volatile("s_waitcnt lgkmcnt(0)" ::: "memory"); SBAR();
#define PK(L, H) (bf16x8){L[0], L[1], L[2], L[3], H[0], H[1], H[2], H[3]}
  od = __builtin_amdgcn_mfma_f32_32x32x16_bf16(pa0, PK(l0, h0), od, 0, 0, 0);
  od = __builtin_amdgcn_mfma_f32_32x32x16_bf16(pa1, PK(l1, h1), od, 0, 0, 0);
  od = __builtin_amdgcn_mfma_f32_32x32x16_bf16(pa2, PK(l2, h2), od, 0, 0, 0);
  od = __builtin_amdgcn_mfma_f32_32x32x16_bf16(pa3, PK(l3, h3), od, 0, 0, 0);
#undef PK
}
__device__ __forceinline__ void pv_d0(f32x16* o, int vb, bf16x8 pa0, bf16x8 pa1, bf16x8 pa2, bf16x8 pa3) {
  pv_one<0>(o[0], vb, pa0, pa1, pa2, pa3); pv_one<1>(o[1], vb, pa0, pa1, pa2, pa3); pv_one<2>(o[2], vb, pa0, pa1, pa2, pa3); pv_one<3>(o[3], vb, pa0, pa1, pa2, pa3);
}

__device__ __forceinline__ void attn_unit(int b, int h, int qb, const bf16_t* __restrict__ Qb, const bf16_t* __restrict__ KVb, const bf16_t* __restrict__ KPb, bf16_t* __restrict__ Ob,
                                          const float* __restrict__ cosT, const float* __restrict__ sinT, char* lds, const int wave_s) {
  int tid_l = __builtin_amdgcn_mbcnt_hi(~0u, __builtin_amdgcn_mbcnt_lo(~0u, 0u)); asm volatile("" : "+v"(tid_l)); tid_l += wave_s * 64;
  const int tid = tid_l, wid = wave_s, lane = tid & 63, r32 = lane & 31, hi = lane >> 5;
  char* V_lds = lds + OFF_V; char* KN_lds = lds + OFF_KN; char* KP_lds = lds + OFF_KP;
  float* ws = (float*)(lds + OFF_WS) + wid * 64; float* li_l = ws; float* al_l = ws + 32;
  float m_reg = -1e30f, l_reg = 0; f32x16 o[4] = {}; bf16x8 qr[8];
  char* qp = lds + OFF_QP + wid * 4096 + lane * 16;
  const int q0 = qb * 256, tq = q0 + wid * QBLK + r32;
  const long rowbase = (long)b * SEQ;
  { const bf16_t* Qw = Qb + (rowbase + tq) * NQ + h * QKD + hi * 8;
#pragma unroll
    for (int d0 = 0; d0 < 8; ++d0) qr[d0] = *reinterpret_cast<const bf16x8*>(Qw + d0 * 16);
#pragma unroll
    for (int pr = 0; pr < 2; ++pr) {
      const float* cp = cosT + (long)tq * 32 + pr * 16 + hi * 8; const float* sp = sinT + (long)tq * 32 + pr * 16 + hi * 8;
      const f32x4 c0 = *(const f32x4*)cp, c1 = *(const f32x4*)(cp + 4), s0 = *(const f32x4*)sp, s1 = *(const f32x4*)(sp + 4);
      const u32x4 x1 = *reinterpret_cast<const u32x4*>(Qw + (8 + pr) * 16), x2 = *reinterpret_cast<const u32x4*>(Qw + (10 + pr) * 16);
      u32x4 y1, y2;
#pragma unroll
      for (int w = 0; w < 4; ++w) {
        const float ca = w < 2 ? c0[2 * w] : c1[2 * w - 4], cb = w < 2 ? c0[2 * w + 1] : c1[2 * w - 3];
        const float sa = w < 2 ? s0[2 * w] : s1[2 * w - 4], sb = w < 2 ? s0[2 * w + 1] : s1[2 * w - 3];
        const float a1 = bflo(x1[w]), b1 = bfhi(x1[w]), a2 = bflo(x2[w]), b2 = bfhi(x2[w]);
        y1[w] = cvtpk(a1 * ca - a2 * sa, b1 * cb - b2 * sb);
        y2[w] = cvtpk(a2 * ca + a1 * sa, b2 * cb + b1 * sb); }
      *reinterpret_cast<u32x4*>(qp + pr * 1024) = y1; *reinterpret_cast<u32x4*>(qp + (2 + pr) * 1024) = y2; }
    asm volatile("s_waitcnt lgkmcnt(0)" ::: "memory");
  }
  const bf16_t* Kh = KVb + rowbase * NKV + h * 256; const bf16_t* Vh = Kh + 128; const bf16_t* Ph = KPb + rowbase * 64;
  const int sr = tid >> 4, sc = (tid & 15) * 8, vst0 = v_st(sr, sc), vst1 = v_st(32 + sr, sc);
  const int pr_ = tid >> 3, pc_ = (tid & 7) * 8;
  const int vb0 = (int)(uintptr_t)V_lds + v_rd_base(lane);
  bf16x8 vs0, vs1, ks0, ks1, ps0;
#define SLOAD(k0) do { vs0 = *reinterpret_cast<const bf16x8*>(&Vh[(long)((k0) + sr) * NKV + sc]); vs1 = *reinterpret_cast<const bf16x8*>(&Vh[(long)((k0) + 32 + sr) * NKV + sc]); \
    ks0 = *reinterpret_cast<const bf16x8*>(&Kh[(long)((k0) + sr) * NKV + sc]); ks1 = *reinterpret_cast<const bf16x8*>(&Kh[(long)((k0) + 32 + sr) * NKV + sc]); \
    ps0 = *reinterpret_cast<const bf16x8*>(&Ph[(long)((k0) + pr_) * 64 + pc_]); } while (0)
#define SWRITE(bb) do { *(bf16x8*)(V_lds + (bb) * SHM_V + vst0) = vs0; *(bf16x8*)(V_lds + (bb) * SHM_V + vst1) = vs1; \
    *(bf16x8*)(KN_lds + (bb) * SHM_KN + KSWZ(sr, sc * 2)) = ks0; *(bf16x8*)(KN_lds + (bb) * SHM_KN + KSWZ(32 + sr, sc * 2)) = ks1; \
    *(bf16x8*)(KP_lds + (bb) * SHM_KP + PSWZ(pr_, pc_ * 2)) = ps0; } while (0)
#define SWAIT() asm volatile("s_waitcnt vmcnt(0)" ::: "memory")
#define RESC(a) do { if (__any((a) < 1.f)) { if (hi == 0) al_l[r32] = (a); asm volatile("s_waitcnt lgkmcnt(0)" ::: "memory"); \
    _Pragma("unroll") for (int d = 0; d < 4; ++d) _Pragma("unroll") for (int r = 0; r < 16; ++r) o[d][r] *= al_l[crow(r, hi)]; } } while (0)
  f32x16 pA0, pA1, pB0, pB1; float mnA, mnB, alA, alB; bf16x8 pa0, pa1, pa2, pa3;
  const int NT = 4 * qb + 4, cw = 4 * qb + (wid >> 1);
  SLOAD(0); SWAIT(); SWRITE(0); __syncthreads();
  qkt(pA0, pA1, KN_lds, KP_lds, qr, qp, r32, hi); partialSM(pA0, pA1, m_reg, mnA, alA);
  SLOAD(KVBLK);
  SWAIT(); SWRITE(1); __syncthreads();
  for (int j = 1; j + 1 < NT; j += 2) {
    SBAR(); qkt(pB0, pB1, KN_lds + SHM_KN, KP_lds + SHM_KP, qr, qp, r32, hi); maskt(pB0, pB1, j > cw);
    finishSM(pA0, pA1, alA, l_reg, pa0, pa1, pa2, pa3); SBAR();
    SLOAD((j + 1) * KVBLK); SBAR();
    pv_d0(o, vb0, pa0, pa1, pa2, pa3); partialSM(pB0, pB1, m_reg, mnB, alB);
    __syncthreads(); SWAIT(); SWRITE(0);
    RESC(alB); __syncthreads();
    SBAR(); qkt(pA0, pA1, KN_lds, KP_lds, qr, qp, r32, hi); maskt(pA0, pA1, j + 1 > cw);
    finishSM(pB0, pB1, alB, l_reg, pa0, pa1, pa2, pa3); SBAR();
    SLOAD((j + 2) * KVBLK); SBAR();
    pv_d0(o, vb0 + SHM_V, pa0, pa1, pa2, pa3); partialSM(pA0, pA1, m_reg, mnA, alA);
    __syncthreads(); SWAIT(); SWRITE(1);
    RESC(alA); __syncthreads();
  }
  SBAR(); qkt(pB0, pB1, KN_lds + SHM_KN, KP_lds + SHM_KP, qr, qp, r32, hi); maskt(pB0, pB1, NT - 1 > cw);
  finishSM(pA0, pA1, alA, l_reg, pa0, pa1, pa2, pa3); SBAR();
  pv_d0(o, vb0, pa0, pa1, pa2, pa3); partialSM(pB0, pB1, m_reg, mnB, alB);
  __syncthreads(); RESC(alB);
  finishSM(pB0, pB1, alB, l_reg, pa0, pa1, pa2, pa3); SBAR();
  pv_d0(o, vb0 + SHM_V, pa0, pa1, pa2, pa3);
  if (hi == 0) li_l[r32] = l_reg; asm volatile("s_waitcnt lgkmcnt(0)" ::: "memory");
  float rli[16];
#pragma unroll
  for (int r = 0; r < 16; ++r) rli[r] = __builtin_amdgcn_rcpf(li_l[crow(r, hi)]);
  bf16_t* Ow = Ob + (rowbase + q0 + wid * QBLK) * DM + h * 128;
#pragma unroll
  for (int r = 0; r < 16; ++r) { const int orow = crow(r, hi);
#pragma unroll
    for (int d0 = 0; d0 < 4; ++d0) Ow[(long)orow * DM + d0 * 32 + r32] = (bf16_t)(cvtpk(o[d0][r] * rli[r], 0.f) & 0xffffu); }
  __syncthreads();
#undef SLOAD
#undef SWRITE
#undef SWAIT
#undef RESC
}
#undef SBAR
}

constexpr size_t MiB = 1u << 20;
constexpr size_t WS_CTL = 0, CTL_ZERO_BYTES = 1 * MiB;
constexpr size_t WS_MOD = 2 * MiB;
constexpr size_t WS_SCT = 7 * MiB;
constexpr size_t WS_COS = 8 * MiB, WS_SIN = 8 * MiB + 512 * 1024;
constexpr size_t WS_W = 16 * MiB, W_LAYER = 92 * MiB;
constexpr size_t WO_IN = 0, WO_PE = 16 * MiB, WO_UQ = WO_PE + 256 * 1024, WO_UKV = WO_UQ + 1536 * 1024, WO_OUT = WO_UKV + 2 * MiB, WO_UP = WO_OUT + 8 * MiB, WO_DN = WO_UP + 32 * MiB;
static_assert(WO_DN + 32 * MiB <= W_LAYER, "weights per layer");
constexpr size_t WS_X = WS_W + DEPTH * W_LAYER;
constexpr size_t WS_H = WS_X + 130 * MiB;
constexpr size_t WS_R = WS_H + 66 * MiB;
constexpr size_t WS_Z = WS_R;
constexpr size_t WS_QN = WS_R + 98 * MiB;
constexpr size_t WS_CKV = WS_R + 115 * MiB;
constexpr size_t WS_KPE = WS_R + 164 * MiB;
constexpr size_t WS_Q = WS_R + 171 * MiB;
constexpr size_t WS_KV = WS_R + 220 * MiB;
constexpr size_t WS_MIX = WS_R + 414 * MiB;
constexpr size_t WS_HB = WS_R;
constexpr size_t WS_END = WS_R + 480 * MiB;
static_assert((size_t)MR * DM * 4 <= 130 * MiB && (size_t)MR * DM * 2 <= 66 * MiB && (size_t)MR * ZW * 2 <= 98 * MiB && (size_t)MKV * 512 * 2 <= 49 * MiB && (size_t)MKV * 64 * 2 <= 7 * MiB
              && (size_t)MR * NQ * 2 <= 49 * MiB && (size_t)MKV * NKV * 2 <= 194 * MiB && (size_t)MR * DFF * 2 <= 414 * MiB, "d_ws map");
constexpr size_t O_Y = 0, O_CKVP = (size_t)MR * DM, O_KPEP = O_CKVP + (size_t)DEPTH * MP * 512, O_CONVP = O_KPEP + (size_t)DEPTH * MP * 64, O_CKVS = O_CONVP + (size_t)DEPTH * NBP * 2 * 1024,
                 O_KPES = O_CKVS + (size_t)DEPTH * MS * 512, O_CONVS = O_KPES + (size_t)DEPTH * MS * 64, O_END = O_CONVS + (size_t)DEPTH * NBS * 2 * 1024;
static_assert(O_END == 72613888, "output size");
constexpr int CW_BAR = 4096;
constexpr int RING_BYTES = 135168;
constexpr int LDSCTL_OFF = RING_BYTES, MISC_OFF = LDSCTL_OFF + 320, LDS_BYTES = RING_BYTES + 1024;
constexpr int NWAVES = 8;
typedef float f32x8v __attribute__((ext_vector_type(8)));

template <int M> __device__ __forceinline__ float swz_xor(float v) { return __int_as_float(__builtin_amdgcn_ds_swizzle(__float_as_int(v), (M << 10) | 0x1f)); }
__device__ __forceinline__ float half_swap_add(float v) { auto rr = __builtin_amdgcn_permlane32_swap(__float_as_uint(v), __float_as_uint(v), false, false); return __uint_as_float(rr[0]) + __uint_as_float(rr[1]); }
__device__ __forceinline__ float half_swap_max(float v) { auto rr = __builtin_amdgcn_permlane32_swap(__float_as_uint(v), __float_as_uint(v), false, false); return fmaxf(__uint_as_float(rr[0]), __uint_as_float(rr[1])); }
__device__ __forceinline__ float wave_sum(float v) {
    v += swz_xor<1>(v); v += swz_xor<2>(v); v += swz_xor<4>(v); v += swz_xor<8>(v); v += swz_xor<16>(v);
    return half_swap_add(v);
}
__device__ __forceinline__ float wave_max(float v) {
    v = fmaxf(v, swz_xor<1>(v)); v = fmaxf(v, swz_xor<2>(v)); v = fmaxf(v, swz_xor<4>(v)); v = fmaxf(v, swz_xor<8>(v)); v = fmaxf(v, swz_xor<16>(v));
    return half_swap_max(v);
}
__device__ __forceinline__ float bf_lo(unsigned w) { return __uint_as_float(w << 16); }
__device__ __forceinline__ float bf_hi(unsigned w) { return __uint_as_float(w & 0xffff0000u); }
__device__ __forceinline__ unsigned pkbf(float lo, float hi) { return pg8::cvt_pk_bf16(lo, hi); }
__device__ __forceinline__ int row_batch(int row) { return row < MP ? (row >> 11) : NBP + ((row - MP) >> 4); }
__device__ __forceinline__ int row_pos(int row) { return row < MP ? (row & (SEQ - 1)) : PAST + ((row - MP) & (TS - 1)); }

__device__ __forceinline__ void transpose_item(const float* W, int K, int N, int src_col0, bf16* WT, int dst_row0, LAS float* scr, int kb, int lane) {
    const int k0 = 64 * kb;
#pragma unroll 8
    for (int i = 0; i < 32; ++i) { const int kk = 2 * i + (lane >> 5); scr[kk * 33 + (lane & 31)] = W[(size_t)(k0 + kk) * N + src_col0 + (lane & 31)]; }
    LDS_WAIT(); asm volatile("" ::: "memory");
    const int c = lane & 7;
#pragma unroll
    for (int j = 0; j < 4; ++j) { const int n = (lane >> 3) + 8 * j; const LAS float* s = scr + (8 * c) * 33 + n;
        v4u o; o.x = pkbf(s[0 * 33], s[1 * 33]); o.y = pkbf(s[2 * 33], s[3 * 33]); o.z = pkbf(s[4 * 33], s[5 * 33]); o.w = pkbf(s[6 * 33], s[7 * 33]);
        *(GAS v4u*)(WT + (size_t)(dst_row0 + n) * K + k0 + 8 * c) = o; }
    LDS_WAIT(); asm volatile("" ::: "memory");
}
__device__ __forceinline__ int win_src_col(int v0) {
    if (v0 < 1024) return v0;
    if (v0 < 3072) { const int t = v0 - 1024, j = t >> 8, r = t & 255; return r < 128 ? 2112 + 128 * j + r : 3136 + 128 * j + (r - 128); }
    return 1088 + (v0 - 3072);
}
constexpr int IT_IN = 32 * 128, IT_PE = 32 * 2, IT_UQ = 8 * 48, IT_UKV = 8 * 64, IT_OUT = 32 * 64, IT_UP = 32 * 256, IT_DN = 128 * 64;
constexpr int IT_LAYER = IT_IN + IT_PE + IT_UQ + IT_UKV + IT_OUT + IT_UP + IT_DN;
__device__ __forceinline__ void p0_prep(const float* w_in, const float* w_uq, const float* w_ukv, const float* w_out, const float* w_up, const float* w_down, const float* c_p, const float* c_s, unsigned char* ws, LAS unsigned char* lds, int tid, int lane, int wave, int vcu, int G) {
    LAS float* scr = (LAS float*)(lds + wave * 16384);
    const int gw = vcu * NWAVES + wave, NGW = G * NWAVES;
    for (int it = gw; it < DEPTH * IT_LAYER; it += NGW) {
        const int l = it / IT_LAYER; int r = it % IT_LAYER;
        unsigned char* wl = ws + WS_W + (size_t)l * W_LAYER;
        if (r < IT_IN) { const int kb = r / 128, nb = r % 128; transpose_item(w_in + (size_t)l * DM * INC, DM, INC, win_src_col(32 * nb), (bf16*)(wl + WO_IN), 32 * nb, scr, kb, lane); continue; } r -= IT_IN;
        if (r < IT_PE) { const int kb = r / 2, nb = r % 2; transpose_item(w_in + (size_t)l * DM * INC, DM, INC, 1024 + 32 * nb, (bf16*)(wl + WO_PE), 32 * nb, scr, kb, lane); continue; } r -= IT_PE;
        if (r < IT_UQ) { const int kb = r / 48, nb = r % 48; transpose_item(w_uq + (size_t)l * QLR * NQ, QLR, NQ, 32 * nb, (bf16*)(wl + WO_UQ), 32 * nb, scr, kb, lane); continue; } r -= IT_UQ;
        if (r < IT_UKV) { const int kb = r / 64, nb = r % 64; transpose_item(w_ukv + (size_t)l * KVLR * NKV, KVLR, NKV, 32 * nb, (bf16*)(wl + WO_UKV), 32 * nb, scr, kb, lane); continue; } r -= IT_UKV;
        if (r < IT_OUT) { const int kb = r / 64, nb = r % 64; transpose_item(w_out + (size_t)l * DM * DM, DM, DM, 32 * nb, (bf16*)(wl + WO_OUT), 32 * nb, scr, kb, lane); continue; } r -= IT_OUT;
        if (r < IT_UP) { const int kb = r / 256, nb = r % 256; transpose_item(w_up + (size_t)l * DM * DFF, DM, DFF, 32 * nb, (bf16*)(wl + WO_UP), 32 * nb, scr, kb, lane); continue; } r -= IT_UP;
        { const int kb = r / 64, nb = r % 64; transpose_item(w_down + (size_t)l * DFF * DM, DFF, DM, 32 * nb, (bf16*)(wl + WO_DN), 32 * nb, scr, kb, lane); }
    }
    const int gt = (vcu * NWAVES + wave) * 64 + lane, NGT = NGW * 64;
    float* sct = (float*)(ws + WS_SCT);
    for (int i = gt; i < NB * DM; i += NGT) { const int b = i / DM, k = i % DM; const float c = b < NBP ? c_p[b * DM + k] : c_s[(b - NBP) * DM + k];
        sct[k * 32 + b] = c / (1.0f + __expf(-c)); }
    float* cosT = (float*)(ws + WS_COS); float* sinT = (float*)(ws + WS_SIN);
    for (int i = gt; i < NPOS * 32; i += NGT) { const int pos = i >> 5, fi = i & 31;
        double inv_d = 1.0; for (int q = 0; q < fi; ++q) inv_d *= 0.74989420933245582730;
        const float inv_f = (float)inv_d; const float ang = __fmul_rn((float)pos, inv_f);
        const double rev4 = (double)ang * 0.63661977236758134308;
        const double qd = __builtin_rint(rev4); const double y = (rev4 - qd) * 1.57079632679489661923;
        const double y2 = y * y;
        const double sy = y * (1.0 + y2 * (-1.0 / 6 + y2 * (1.0 / 120 + y2 * (-1.0 / 5040 + y2 * (1.0 / 362880 + y2 * (-1.0 / 39916800 + y2 * (1.0 / 6227020800.0)))))));
        const double cy = 1.0 + y2 * (-0.5 + y2 * (1.0 / 24 + y2 * (-1.0 / 720 + y2 * (1.0 / 40320 + y2 * (-1.0 / 3628800 + y2 * (1.0 / 479001600.0 + y2 * (-1.0 / 87178291200.0)))))));
        const int qi = ((int)qd) & 3;
        const double cv = qi == 0 ? cy : qi == 1 ? -sy : qi == 2 ? -cy : sy;
        const double sv = qi == 0 ? sy : qi == 1 ? cy : qi == 2 ? -sy : -cy;
        cosT[i] = (float)cv; sinT[i] = (float)sv; }
}
__device__ __forceinline__ void p1_mod(const float* w_ada, const float* b_ada, unsigned char* ws, LAS unsigned char* lds, int tid, int lane, int wave, int vcu, int G) {
    const float* sct = (const float*)(ws + WS_SCT); float* mod = (float*)(ws + WS_MOD);
    LAS float* red = (LAS float*)lds;
    for (int it = vcu; it < DEPTH * (MODW / 64); it += G) {
        const int l = it / (MODW / 64), n0 = 64 * (it % (MODW / 64));
        float acc[NB];
#pragma unroll
        for (int b = 0; b < NB; ++b) acc[b] = 0.f;
        const float* wp = w_ada + ((size_t)l * DM + (size_t)wave * 256) * MODW + n0 + lane;
        const float* sp = sct + (size_t)wave * 256 * 32;
#pragma unroll 4
        for (int k = 0; k < 256; ++k) { const float wv = wp[(size_t)k * MODW]; const float* s = sp + k * 32;
#pragma unroll
            for (int b = 0; b < NB; ++b) acc[b] = fmaf(s[b], wv, acc[b]); }
#pragma unroll
        for (int b = 0; b < NB; ++b) red[(wave * NB + b) * 64 + lane] = acc[b];
        __syncthreads();
        for (int i = tid; i < NB * 64; i += NWAVES * 64) { const int b = i >> 6, c = i & 63; float s = b_ada[(size_t)l * MODW + n0 + c];
#pragma unroll
            for (int w = 0; w < NWAVES; ++w) s += red[(w * NB + b) * 64 + c];
            mod[((size_t)l * NB + b) * MODW + n0 + c] = s; }
        __syncthreads();
    }
}
__device__ __forceinline__ void norm_rows(const float* xp, const float* xs, const float* X, bool first, float* Xcopy, const float* modl, int sh_off, int sc_off, bf16* H, int lane, int gw, int NGW) {
    for (int row = gw; row < MR; row += NGW) {
        const float* xr = first ? (row < MP ? xp + (size_t)row * DM : xs + (size_t)(row - MP) * DM) : X + (size_t)row * DM;
        const GAS f32x4* x4 = (const GAS f32x4*)xr + lane;
        f32x4 v[8]; float s = 0.f;
#pragma unroll
        for (int j = 0; j < 8; ++j) { v[j] = x4[64 * j]; s += (v[j].x * v[j].x + v[j].y * v[j].y) + (v[j].z * v[j].z + v[j].w * v[j].w); }
        const float rstd = 1.0f / sqrtf(wave_sum(s) * (1.f / DM) + EPS);
        const int b = row_batch(row);
        const GAS f32x4* sc4 = (const GAS f32x4*)(modl + (size_t)b * MODW + sc_off) + lane; const GAS f32x4* sh4 = (const GAS f32x4*)(modl + (size_t)b * MODW + sh_off) + lane;
        GAS unsigned long long* o8 = (GAS unsigned long long*)(H + (size_t)row * DM) + lane;
#pragma unroll
        for (int j = 0; j < 8; ++j) { const f32x4 sc = sc4[64 * j], sh = sh4[64 * j];
            const float a = v[j].x * rstd * (1.f + sc.x) + sh.x, bq = v[j].y * rstd * (1.f + sc.y) + sh.y, c = v[j].z * rstd * (1.f + sc.z) + sh.z, d = v[j].w * rstd * (1.f + sc.w) + sh.w;
            o8[64 * j] = (unsigned long long)pkbf(a, bq) | ((unsigned long long)pkbf(c, d) << 32); }
        if (first) { GAS f32x4* xc = (GAS f32x4*)(Xcopy + (size_t)row * DM) + lane;
#pragma unroll
            for (int j = 0; j < 8; ++j) xc[64 * j] = v[j]; }
    }
}
__device__ __forceinline__ void final_norm_rows(const float* X, const float* gain, float* out, int lane, int gw, int NGW) {
    for (int row = gw; row < MR; row += NGW) {
        const GAS f32x4* x4 = (const GAS f32x4*)(X + (size_t)row * DM) + lane; const GAS f32x4* g4 = (const GAS f32x4*)gain + lane;
        f32x4 v[8]; float s = 0.f;
#pragma unroll
        for (int j = 0; j < 8; ++j) { v[j] = x4[64 * j]; s += (v[j].x * v[j].x + v[j].y * v[j].y) + (v[j].z * v[j].z + v[j].w * v[j].w); }
        const float rstd = 1.0f / sqrtf(wave_sum(s) * (1.f / DM) + EPS);
        GAS f32x4* o4 = (GAS f32x4*)(out + (size_t)row * DM) + lane;
#pragma unroll
        for (int j = 0; j < 8; ++j) o4[64 * j] = v[j] * rstd * g4[64 * j];
    }
}
__device__ __forceinline__ void elt_kpe(const bf16* H, const bf16* WPE, bf16* KPE, const float* cosT, const float* sinT, float* outp, float* outs, LAS unsigned char* lds,
                                        int tid, int lane, int wave, int vcu, int G) {
    typedef float f32x16 __attribute__((ext_vector_type(16)));
    LAS float* red = (LAS float*)lds;
    const int r32 = lane & 31, hi = lane >> 5, rt = wave & 1, kq = wave >> 1;
    for (int it = vcu; it < MR / 64; it += G) {
        const int R0 = 64 * it + 32 * rt;
        f32x16 a0 = {}, a1 = {};
        const bf16* Ap = H + (size_t)(R0 + r32) * DM + 512 * kq + 8 * hi;
        const bf16* B0 = WPE + (size_t)r32 * DM + 512 * kq + 8 * hi; const bf16* B1 = B0 + (size_t)32 * DM;
#pragma unroll 8
        for (int s = 0; s < 32; ++s) { const bf16x8 a = *(const bf16x8*)(Ap + 16 * s), b0 = *(const bf16x8*)(B0 + 16 * s), b1 = *(const bf16x8*)(B1 + 16 * s);
            a0 = __builtin_amdgcn_mfma_f32_32x32x16_bf16(a, b0, a0, 0, 0, 0); a1 = __builtin_amdgcn_mfma_f32_32x32x16_bf16(a, b1, a1, 0, 0, 0); }
#pragma unroll
        for (int r = 0; r < 16; ++r) { red[(wave * 32 + r) * 64 + lane] = a0[r]; red[(wave * 32 + 16 + r) * 64 + lane] = a1[r]; }
        __syncthreads();
        if (kq == 0) {
#pragma unroll
            for (int r = 0; r < 16; ++r) { float x1 = 0.f, x2 = 0.f;
#pragma unroll
                for (int q = 0; q < 4; ++q) { x1 += red[((rt + 2 * q) * 32 + r) * 64 + lane]; x2 += red[((rt + 2 * q) * 32 + 16 + r) * 64 + lane]; }
                const int row = R0 + (r & 3) + 8 * (r >> 2) + 4 * hi, pos = row_pos(row);
                const float cs = cosT[pos * 32 + r32], sn = sinT[pos * 32 + r32];
                const float o1 = x1 * cs - x2 * sn, o2 = x2 * cs + x1 * sn;
                float* of = row < MP ? outp + (size_t)row * 64 : outs + (size_t)(row - MP) * 64;
                of[r32] = o1; of[32 + r32] = o2;
                KPE[(size_t)row * 64 + r32] = (bf16)(pkbf(o1, 0.f) & 0xffffu); KPE[(size_t)row * 64 + 32 + r32] = (bf16)(pkbf(o2, 0.f) & 0xffffu); }
        }
        __syncthreads();
    }
}
__device__ __forceinline__ void elt_rows(const bf16* Z, const float* q_norm, const float* kv_norm, const float* conv_w, const float* conv_norm, const float* state_conv_l,
                                         bf16* QN, bf16* CKV, bf16* MIX, float* ockv_p, float* ockv_s, float* oconv_p, float* oconv_s, int lane, int gw, int NGW) {
    for (int row = gw; row < MR; row += NGW) {
        const bf16* zr = Z + (size_t)row * ZW;
        {
            const v4u w = *(const GAS v4u*)(zr + 8 * lane); float x[8];
#pragma unroll
            for (int i = 0; i < 4; ++i) { x[2 * i] = bf_lo(w[i]); x[2 * i + 1] = bf_hi(w[i]); }
            float s = 0.f;
#pragma unroll
            for (int i = 0; i < 8; ++i) s += x[i] * x[i];
            const float rstd = 1.0f / sqrtf(wave_sum(s) * (1.f / QLR) + EPS);
            const f32x4 g0 = *(const GAS f32x4*)(q_norm + 8 * lane), g1 = *(const GAS f32x4*)(q_norm + 8 * lane + 4);
            v4u o; o.x = pkbf(x[0] * rstd * g0.x, x[1] * rstd * g0.y); o.y = pkbf(x[2] * rstd * g0.z, x[3] * rstd * g0.w); o.z = pkbf(x[4] * rstd * g1.x, x[5] * rstd * g1.y); o.w = pkbf(x[6] * rstd * g1.z, x[7] * rstd * g1.w);
            *(GAS v4u*)(QN + (size_t)row * QLR + 8 * lane) = o; }
        {
            const v4u w = *(const GAS v4u*)(zr + 512 + 8 * lane); float x[8];
#pragma unroll
            for (int i = 0; i < 4; ++i) { x[2 * i] = bf_lo(w[i]); x[2 * i + 1] = bf_hi(w[i]); }
            float s = 0.f;
#pragma unroll
            for (int i = 0; i < 8; ++i) s += x[i] * x[i];
            const float rstd = 1.0f / sqrtf(wave_sum(s) * (1.f / KVLR) + EPS);
            const f32x4 g0 = *(const GAS f32x4*)(kv_norm + 8 * lane), g1 = *(const GAS f32x4*)(kv_norm + 8 * lane + 4);
            const f32x4 y0 = {x[0] * rstd * g0.x, x[1] * rstd * g0.y, x[2] * rstd * g0.z, x[3] * rstd * g0.w}, y1 = {x[4] * rstd * g1.x, x[5] * rstd * g1.y, x[6] * rstd * g1.z, x[7] * rstd * g1.w};
            float* of = row < MP ? ockv_p + (size_t)row * KVLR : ockv_s + (size_t)(row - MP) * KVLR;
            *(GAS f32x4*)(of + 8 * lane) = y0; *(GAS f32x4*)(of + 8 * lane + 4) = y1;
            v4u o; o.x = pkbf(y0.x, y0.y); o.y = pkbf(y0.z, y0.w); o.z = pkbf(y1.x, y1.y); o.w = pkbf(y1.z, y1.w);
            *(GAS v4u*)(CKV + (size_t)row * KVLR + 8 * lane) = o; }
        {
            const bool samp = row >= MP; const int t = samp ? ((row - MP) & (TS - 1)) : (row & (SEQ - 1)); const int b = samp ? ((row - MP) >> 4) : (row >> 11); const int T = samp ? TS : SEQ;
            const int c0 = 16 * lane;
            float cu[16], f1[16], f0[16], gb[16];
            { const v4u a = *(const GAS v4u*)(zr + 1024 + c0), bq = *(const GAS v4u*)(zr + 1024 + c0 + 8);
#pragma unroll
              for (int i = 0; i < 4; ++i) { cu[2 * i] = bf_lo(a[i]); cu[2 * i + 1] = bf_hi(a[i]); cu[8 + 2 * i] = bf_lo(bq[i]); cu[8 + 2 * i + 1] = bf_hi(bq[i]); } }
            { const v4u a = *(const GAS v4u*)(zr + 2048 + c0), bq = *(const GAS v4u*)(zr + 2048 + c0 + 8);
#pragma unroll
              for (int i = 0; i < 4; ++i) { gb[2 * i] = bf_lo(a[i]); gb[2 * i + 1] = bf_hi(a[i]); gb[8 + 2 * i] = bf_lo(bq[i]); gb[8 + 2 * i + 1] = bf_hi(bq[i]); } }
            if (t >= 1) { const bf16* z1 = zr - ZW; const v4u a = *(const GAS v4u*)(z1 + 1024 + c0), bq = *(const GAS v4u*)(z1 + 1024 + c0 + 8);
#pragma unroll
              for (int i = 0; i < 4; ++i) { f1[2 * i] = bf_lo(a[i]); f1[2 * i + 1] = bf_hi(a[i]); f1[8 + 2 * i] = bf_lo(bq[i]); f1[8 + 2 * i + 1] = bf_hi(bq[i]); } }
            else {
#pragma unroll
              for (int i = 0; i < 16; ++i) f1[i] = samp ? state_conv_l[((size_t)b * 2 + 1) * DCONV + c0 + i] : 0.f; }
            if (t >= 2) { const bf16* z2 = zr - 2 * ZW; const v4u a = *(const GAS v4u*)(z2 + 1024 + c0), bq = *(const GAS v4u*)(z2 + 1024 + c0 + 8);
#pragma unroll
              for (int i = 0; i < 4; ++i) { f0[2 * i] = bf_lo(a[i]); f0[2 * i + 1] = bf_hi(a[i]); f0[8 + 2 * i] = bf_lo(bq[i]); f0[8 + 2 * i + 1] = bf_hi(bq[i]); } }
            else {
#pragma unroll
              for (int i = 0; i < 16; ++i) f0[i] = samp ? state_conv_l[((size_t)b * 2 + t) * DCONV + c0 + i] : 0.f; }
            float o[16]; float s = 0.f;
#pragma unroll
            for (int i = 0; i < 16; ++i) { const float y = conv_w[c0 + i] * f0[i] + conv_w[DCONV + c0 + i] * f1[i] + conv_w[2 * DCONV + c0 + i] * cu[i]; o[i] = gb[i] * y; s += o[i] * o[i]; }
            const float rstd = 1.0f / sqrtf(wave_sum(s) * (1.f / DCONV) + EPS);
            v4u p0, p1;
#pragma unroll
            for (int i = 0; i < 4; ++i) { p0[i] = pkbf(o[2 * i] * rstd * conv_norm[c0 + 2 * i], o[2 * i + 1] * rstd * conv_norm[c0 + 2 * i + 1]);
                                          p1[i] = pkbf(o[8 + 2 * i] * rstd * conv_norm[c0 + 8 + 2 * i], o[8 + 2 * i + 1] * rstd * conv_norm[c0 + 8 + 2 * i + 1]); }
            *(GAS v4u*)(MIX + (size_t)row * DM + DATT + c0) = p0; *(GAS v4u*)(MIX + (size_t)row * DM + DATT + c0 + 8) = p1;
            if (t >= T - 2) { float* oc = (samp ? oconv_s : oconv_p) + ((size_t)b * 2 + (t - (T - 2))) * DCONV + c0;
#pragma unroll
              for (int i = 0; i < 4; ++i) *(GAS f32x4*)(oc + 4 * i) = (f32x4){cu[4 * i], cu[4 * i + 1], cu[4 * i + 2], cu[4 * i + 3]}; }
        }
    }
}
__device__ __forceinline__ void elt_cache(const float* ckv_l, const float* kpe_l, bf16* CKV, bf16* KPE, int gt, int NGT) {
    for (int i = gt; i < MC * 512 / 8; i += NGT) { const f32x8v x = *(const GAS f32x8v*)(ckv_l + (size_t)i * 8);
        v4u o; o.x = pkbf(x[0], x[1]); o.y = pkbf(x[2], x[3]); o.z = pkbf(x[4], x[5]); o.w = pkbf(x[6], x[7]); *(GAS v4u*)(CKV + (size_t)MR * 512 + (size_t)i * 8) = o; }
    for (int i = gt; i < MC * 64 / 8; i += NGT) { const f32x8v x = *(const GAS f32x8v*)(kpe_l + (size_t)i * 8);
        v4u o; o.x = pkbf(x[0], x[1]); o.y = pkbf(x[2], x[3]); o.z = pkbf(x[4], x[5]); o.w = pkbf(x[6], x[7]); *(GAS v4u*)(KPE + (size_t)MR * 64 + (size_t)i * 8) = o; }
}
__device__ __forceinline__ void anorm_rows(bf16* MIX, const float* gain, int lane, int gw, int NGW) {
    for (int row = gw; row < MR; row += NGW) {
        bf16* mr = MIX + (size_t)row * DM + 16 * lane;
        const v4u a = *(const GAS v4u*)mr, bq = *(const GAS v4u*)(mr + 8); float x[16];
#pragma unroll
        for (int i = 0; i < 4; ++i) { x[2 * i] = bf_lo(a[i]); x[2 * i + 1] = bf_hi(a[i]); x[8 + 2 * i] = bf_lo(bq[i]); x[8 + 2 * i + 1] = bf_hi(bq[i]); }
        float s = 0.f;
#pragma unroll
        for (int i = 0; i < 16; ++i) s += x[i] * x[i];
        const float rstd = 1.0f / sqrtf(wave_sum(s) * (1.f / DATT) + EPS);
        v4u p0, p1;
#pragma unroll
        for (int i = 0; i < 4; ++i) { p0[i] = pkbf(x[2 * i] * rstd * gain[16 * lane + 2 * i], x[2 * i + 1] * rstd * gain[16 * lane + 2 * i + 1]);
                                      p1[i] = pkbf(x[8 + 2 * i] * rstd * gain[16 * lane + 8 + 2 * i], x[8 + 2 * i + 1] * rstd * gain[16 * lane + 8 + 2 * i + 1]); }
        *(GAS v4u*)mr = p0; *(GAS v4u*)(mr + 8) = p1;
    }
}
__device__ __forceinline__ void sattn_unit(int b, int h, const bf16* Qb, const bf16* KVb, const bf16* KPb, bf16* Ob, const float* cosT, const float* sinT, LAS unsigned char* lds, int tid, int lane, int wave) {
    constexpr int NKEY = PAST + TS;
    LAS float* S = (LAS float*)lds; LAS float* invl = (LAS float*)(lds + NKEY * 64);
    const int qi = lane & 15, g = lane >> 4;
    const int qrow0 = MP + b * TS;
    bf16x8 qf[6];
    { const bf16* qp = Qb + (size_t)(qrow0 + qi) * NQ + h * QKD + 8 * g;
#pragma unroll
      for (int s = 0; s < 6; ++s) qf[s] = *(const bf16x8*)(qp + 32 * s);
      const int pos = PAST + qi; const float* cp = cosT + pos * 32 + 8 * g; const float* sp = sinT + pos * 32 + 8 * g;
      const v4u x1 = *reinterpret_cast<const v4u*>(&qf[4]), x2 = *reinterpret_cast<const v4u*>(&qf[5]); v4u y1, y2;
#pragma unroll
      for (int w = 0; w < 4; ++w) { const float ca = cp[2 * w], cb = cp[2 * w + 1], sa = sp[2 * w], sb = sp[2 * w + 1];
          const float a1 = bf_lo(x1[w]), b1 = bf_hi(x1[w]), a2 = bf_lo(x2[w]), b2 = bf_hi(x2[w]);
          y1[w] = pkbf(a1 * ca - a2 * sa, b1 * cb - b2 * sb); y2[w] = pkbf(a2 * ca + a1 * sa, b2 * cb + b1 * sb); }
      qf[4] = *reinterpret_cast<const bf16x8*>(&y1); qf[5] = *reinterpret_cast<const bf16x8*>(&y2); }
    for (int tt = wave; tt < NKEY / 16; tt += NWAVES) {
        const int key = 16 * tt + qi;
        const size_t krow = key < PAST ? (size_t)MR + (size_t)b * PAST + key : (size_t)MP + b * TS + (key - PAST);
        const bf16* kn = KVb + krow * NKV + h * 256 + 8 * g; const bf16* kp = KPb + krow * 64 + 8 * g;
        f32x4 acc = {0.f, 0.f, 0.f, 0.f};
#pragma unroll
        for (int s = 0; s < 4; ++s) acc = __builtin_amdgcn_mfma_f32_16x16x32_bf16(*(const bf16x8*)(kn + 32 * s), qf[s], acc, 0, 0, 0);
#pragma unroll
        for (int s = 0; s < 2; ++s) acc = __builtin_amdgcn_mfma_f32_16x16x32_bf16(*(const bf16x8*)(kp + 32 * s), qf[4 + s], acc, 0, 0, 0);
#pragma unroll
        for (int r = 0; r < 4; ++r) S[(16 * tt + 4 * g + r) * 16 + qi] = acc[r] * (ATTN_SCALE * LOG2E);
    }
    __syncthreads();
    for (int q = 2 * wave; q < 2 * wave + 2; ++q) {
        float m = -INFINITY;
        for (int k = lane; k < NKEY; k += 64) m = fmaxf(m, S[k * 16 + q]);
        m = wave_max(m);
        float s = 0.f;
        for (int k = lane; k < NKEY; k += 64) { const float p = __builtin_amdgcn_exp2f(S[k * 16 + q] - m); S[k * 16 + q] = p; s += p; }
        s = wave_sum(s);
        if (lane == 0) invl[q] = 1.0f / s;
    }
    __syncthreads();
    { const int vc4 = tid & 31, ks = tid >> 5;
      float o[16][4];
#pragma unroll
      for (int q = 0; q < 16; ++q)
#pragma unroll
          for (int c = 0; c < 4; ++c) o[q][c] = 0.f;
#pragma unroll 2
      for (int key = ks; key < NKEY; key += 16) {
          const size_t krow = key < PAST ? (size_t)MR + (size_t)b * PAST + key : (size_t)MP + b * TS + (key - PAST);
          const unsigned long long w = *(const GAS unsigned long long*)(KVb + krow * NKV + h * 256 + 128 + 4 * vc4);
          float v[4]; v[0] = bf_lo((unsigned)w); v[1] = bf_hi((unsigned)w); v[2] = bf_lo((unsigned)(w >> 32)); v[3] = bf_hi((unsigned)(w >> 32));
          const LAS f32x4* p4 = (const LAS f32x4*)(S + key * 16);
#pragma unroll
          for (int qq = 0; qq < 4; ++qq) { const f32x4 p = p4[qq];
#pragma unroll
              for (int c = 0; c < 4; ++c) { o[4 * qq][c] = fmaf(p.x, v[c], o[4 * qq][c]); o[4 * qq + 1][c] = fmaf(p.y, v[c], o[4 * qq + 1][c]); o[4 * qq + 2][c] = fmaf(p.z, v[c], o[4 * qq + 2][c]); o[4 * qq + 3][c] = fmaf(p.w, v[c], o[4 * qq + 3][c]); } }
      }
#pragma unroll
      for (int q = 0; q < 16; ++q)
#pragma unroll
          for (int c = 0; c < 4; ++c) o[q][c] = half_swap_add(o[q][c]);
      __syncthreads();
      LAS float* red = (LAS float*)lds;
      if (lane < 32) {
#pragma unroll
          for (int q = 0; q < 16; ++q) *(LAS f32x4*)(red + (wave * 16 + q) * 128 + 4 * vc4) = (f32x4){o[q][0], o[q][1], o[q][2], o[q][3]}; }
      const float il = invl[tid >> 5];
      __syncthreads();
      { const int q = tid >> 5, c4 = (tid & 31) * 4; f32x4 acc = {0.f, 0.f, 0.f, 0.f};
#pragma unroll
        for (int w = 0; w < NWAVES; ++w) acc += *(const LAS f32x4*)(red + (w * 16 + q) * 128 + c4);
        acc = acc * il;
        unsigned long long pk = (unsigned long long)pkbf(acc.x, acc.y) | ((unsigned long long)pkbf(acc.z, acc.w) << 32);
        *(GAS unsigned long long*)(Ob + (size_t)(qrow0 + q) * DM + h * 128 + c4) = pk; }
    }
    __syncthreads();
}

#ifndef MK_MULTI
#define MK_MULTI 0
#endif
constexpr int PH_PREP = 0, PH_MOD = 1, PH_L0 = 2, PH_PER_LAYER = 10, PH_FINAL = PH_L0 + DEPTH * PH_PER_LAYER, N_PHASES = PH_FINAL + 1;
struct Args { const float* in[21]; float* out; unsigned char* ws; int ph_lo, ph_hi; };
static_assert(sizeof(Args) == 21 * 8 + 8 + 8 + 8, "Args has no padding");

__global__ void __launch_bounds__(NWAVES * 64, 2) trunk_fwd(Args args) {
    extern __shared__ __attribute__((aligned(16))) unsigned char lds_raw[];
    LAS unsigned char* lds = (LAS unsigned char*)lds_raw;
    volatile LAS unsigned* MISC = (volatile LAS unsigned*)(lds + MISC_OFF);
    const int wave0 = __builtin_amdgcn_readfirstlane((int)threadIdx.x >> 6);
    const int G = gridDim.x; const int bx = blockIdx.x; const int vcu = (G % 8 == 0) ? (bx % 8) * (G / 8) + bx / 8 : bx;
    { const int t0 = threadIdx.x; for (int u = t0; u < (LDS_BYTES - LDSCTL_OFF) / 4; u += NWAVES * 64) ((LAS unsigned*)(lds + LDSCTL_OFF))[u] = 0u; }
    __syncthreads();
#if MK_MULTI
#define GRID_BAR() do { } while (0)
#else
    XcdBarrier bar = xcd_barrier_post((unsigned*)((gu32*)(args.ws + WS_CTL) + CW_BAR), MISC + 8);
#define GRID_BAR() xcd_barrier(bar)
#endif
    const int lo = args.ph_lo, hi = args.ph_hi;
#define IN(k) (lo <= (k) && (k) < hi)
#define SEAM(k) do { if ((k) + 1 < hi) GRID_BAR(); } while (0)
#define PHASE_ENV() int ln_ = __builtin_amdgcn_mbcnt_hi(~0u, __builtin_amdgcn_mbcnt_lo(~0u, 0u)); asm volatile("" : "+v"(ln_)); int wv_ = wave0; asm volatile("" : "+s"(wv_)); const int wave = wv_, lane = ln_, tid = wave * 64 + lane; \
    const int gw = vcu * NWAVES + wave, NGW = G * NWAVES, gt = gw * 64 + lane, NGT = NGW * 64; (void)gt; (void)NGT; (void)gw; (void)NGW; (void)tid; (void)lane; \
    size_t zoff_ = 0; asm volatile("" : "+s"(zoff_)); unsigned char* ws = args.ws + zoff_; float* out = args.out; (void)out; \
    float* X = (float*)(ws + WS_X); bf16* H = (bf16*)(ws + WS_H); bf16* Z = (bf16*)(ws + WS_Z); bf16* QN = (bf16*)(ws + WS_QN); bf16* CKV = (bf16*)(ws + WS_CKV); \
    bf16* KPE = (bf16*)(ws + WS_KPE); bf16* Qb = (bf16*)(ws + WS_Q); bf16* KVb = (bf16*)(ws + WS_KV); bf16* MIX = (bf16*)(ws + WS_MIX); bf16* HB = (bf16*)(ws + WS_HB); \
    const float* cosT = (const float*)(ws + WS_COS); const float* sinT = (const float*)(ws + WS_SIN); \
    const unsigned char* wl = ws + WS_W + (size_t)l * W_LAYER; const float* modl = (const float*)(ws + WS_MOD) + (size_t)l * NB * MODW; \
    (void)X; (void)H; (void)Z; (void)QN; (void)CKV; (void)KPE; (void)Qb; (void)KVb; (void)MIX; (void)HB; (void)cosT; (void)sinT; (void)wl; (void)modl;

    if (IN(PH_PREP)) { const int l = 0; PHASE_ENV(); p0_prep(args.in[9], args.in[11], args.in[13], args.in[17], args.in[18], args.in[19], args.in[2], args.in[3], ws, lds, tid, lane, wave, vcu, G); SEAM(PH_PREP); }
    if (IN(PH_MOD)) { const int l = 0; PHASE_ENV(); p1_mod(args.in[7], args.in[8], ws, lds, tid, lane, wave, vcu, G); SEAM(PH_MOD); }

    for (int l = 0; l < DEPTH; ++l) {
        const int pb = PH_L0 + l * PH_PER_LAYER;
        if (hi <= pb || lo >= pb + PH_PER_LAYER) continue;
        if (IN(pb + 0)) { PHASE_ENV(); norm_rows(args.in[0], args.in[1], X, l == 0, X, modl, 0, DM, H, lane, gw, NGW); SEAM(pb + 0); }
        if (IN(pb + 1)) { PHASE_ENV();
            pg8::Gemm g{H, (const bf16*)(wl + WO_IN), MR, 4096, DM}; pg8::StaticOrder S; S.init(MR, 4096, G, bx);
            pg8::EpiZ E{Z};
            pg8::gemm_phase<pg8::EpiZ, pg8::StaticOrder, true, true>(lds, g, S, E, wave0);
            SEAM(pb + 1);
        }
        if (IN(pb + 2)) { PHASE_ENV();
            elt_kpe(H, (const bf16*)(wl + WO_PE), KPE, cosT, sinT, out + O_KPEP + (size_t)l * MP * 64, out + O_KPES + (size_t)l * MS * 64, lds, tid, lane, wave, vcu, G);
            elt_rows(Z, args.in[10] + l * QLR, args.in[12] + l * KVLR, args.in[14] + l * 3 * DCONV, args.in[16] + l * DCONV, args.in[6] + (size_t)l * NBS * 2 * DCONV,
                     QN, CKV, MIX, out + O_CKVP + (size_t)l * MP * 512, out + O_CKVS + (size_t)l * MS * 512, out + O_CONVP + (size_t)l * NBP * 2 * DCONV, out + O_CONVS + (size_t)l * NBS * 2 * DCONV, lane, gw, NGW);
            elt_cache(args.in[4] + (size_t)l * MC * 512, args.in[5] + (size_t)l * MC * 64, CKV, KPE, gt, NGT);
            SEAM(pb + 2);
        }
        if (IN(pb + 3)) { PHASE_ENV();
            { pg8::Gemm g{QN, (const bf16*)(wl + WO_UQ), MR, NQ, QLR}; pg8::StaticOrder S; S.init(MR, NQ, G, bx);
              pg8::EpiStore<0> E{Qb, NQ};
              pg8::gemm_phase<pg8::EpiStore<0>, pg8::StaticOrder, true, true>(lds, g, S, E, wave0); }
            __syncthreads();
            { pg8::Gemm g{CKV, (const bf16*)(wl + WO_UKV), MKV, NKV, KVLR}; pg8::StaticOrder S; S.init(MKV, NKV, G, bx);
              pg8::EpiStore<0> E{KVb, NKV};
              pg8::gemm_phase<pg8::EpiStore<0>, pg8::StaticOrder, true, true>(lds, g, S, E, wave0); }
            SEAM(pb + 3);
        }
        if (IN(pb + 4)) { PHASE_ENV();
            for (int pu = vcu; pu < NBP * NH * 4; pu += G) {
                const int bh = pu >> 2, s = pu & 3;
#pragma unroll 1
                for (int k = 0; k < 2; ++k) att::attn_unit(bh >> 3, bh & 7, k == 0 ? 7 - s : s, Qb, KVb, KPE, MIX, cosT, sinT, (char*)lds_raw, wave0);
            }
            for (int su = vcu; su < NBS * NH; su += G) sattn_unit(su >> 3, su & 7, Qb, KVb, KPE, MIX, cosT, sinT, lds, tid, lane, wave);
            SEAM(pb + 4);
        }
        if (IN(pb + 5)) { PHASE_ENV(); anorm_rows(MIX, args.in[15] + l * DATT, lane, gw, NGW); SEAM(pb + 5); }
        if (IN(pb + 6)) { PHASE_ENV();
            pg8::Gemm g{MIX, (const bf16*)(wl + WO_OUT), MR, DM, DM}; pg8::StaticOrder S; S.init(MR, DM, G, bx);
            pg8::EpiResid E{X, X, modl + 2 * DM};
            pg8::gemm_phase<pg8::EpiResid, pg8::StaticOrder, true, true>(lds, g, S, E, wave0);
            SEAM(pb + 6);
        }
        if (IN(pb + 7)) { PHASE_ENV(); norm_rows(nullptr, nullptr, X, false, nullptr, modl, 3 * DM, 4 * DM, H, lane, gw, NGW); SEAM(pb + 7); }
        if (IN(pb + 8)) { PHASE_ENV();
            pg8::Gemm g{H, (const bf16*)(wl + WO_UP), MR, DFF, DM}; pg8::StaticOrder S; S.init(MR, DFF, G, bx);
            pg8::EpiStore<1> E{HB, DFF};
            pg8::gemm_phase<pg8::EpiStore<1>, pg8::StaticOrder, true, true>(lds, g, S, E, wave0);
            SEAM(pb + 8);
        }
        if (IN(pb + 9)) { PHASE_ENV();
            pg8::Gemm g{HB, (const bf16*)(wl + WO_DN), MR, DM, DFF}; pg8::StaticOrder S; S.init(MR, DM, G, bx);
            pg8::EpiResid E{X, X, modl + 5 * DM};
            pg8::gemm_phase<pg8::EpiResid, pg8::StaticOrder, true, true>(lds, g, S, E, wave0);
            SEAM(pb + 9);
        }
    }
    int lo_f = args.ph_lo, hi_f = args.ph_hi; asm volatile("" : "+s"(lo_f), "+s"(hi_f));
    if (lo_f <= PH_FINAL && PH_FINAL < hi_f) { const int l = 0; PHASE_ENV(); final_norm_rows(X, args.in[20], out, lane, gw, NGW); }
#undef IN
#undef SEAM
}

extern "C" void kernel_launch(void* const* d_in, const int* in_sizes, int n_in, void* d_out, int out_size, void* d_ws, size_t ws_size, hipStream_t stream) {
    static int grid = 0;
    if (grid == 0) {
        if (n_in != 21 || in_sizes[0] != MP * DM || (size_t)out_size != O_END || ws_size < WS_END) {
            fprintf(stderr, "kernel_launch: shape mismatch: n_in %d in0 %d out %d ws %zu (need %zu); nothing launched\n", n_in, n_in > 0 ? in_sizes[0] : -1, out_size, ws_size, (size_t)WS_END); grid = -1; return; }
        int dev = 0, cus = 0, per_cu = 0;
        if (hipGetDevice(&dev) != hipSuccess || hipDeviceGetAttribute(&cus, hipDeviceAttributeMultiprocessorCount, dev) != hipSuccess) { fprintf(stderr, "kernel_launch: device query failed\n"); grid = -1; return; }
        if (hipFuncSetAttribute((const void*)trunk_fwd, hipFuncAttributeMaxDynamicSharedMemorySize, LDS_BYTES) != hipSuccess) { fprintf(stderr, "kernel_launch: hipFuncSetAttribute failed\n"); grid = -1; return; }
        if (hipOccupancyMaxActiveBlocksPerMultiprocessor(&per_cu, (const void*)trunk_fwd, NWAVES * 64, LDS_BYTES) != hipSuccess || per_cu < 1)
            fprintf(stderr, "kernel_launch: note: occupancy query reports %d workgroups per CU\n", per_cu);
        (void)hipGetLastError();
        grid = cus;
    }
    if (grid < 0) return;
    if (hipMemsetAsync((char*)d_ws + WS_CTL, 0, CTL_ZERO_BYTES, stream) != hipSuccess) { fprintf(stderr, "kernel_launch: memset failed\n"); return; }
    Args a{};
    for (int i = 0; i < 21; ++i) a.in[i] = (const float*)d_in[i];
    a.out = (float*)d_out; a.ws = (unsigned char*)d_ws;
#if MK_MULTI
    for (int p = 0; p < N_PHASES; ++p) { a.ph_lo = p; a.ph_hi = p + 1; hipLaunchKernelGGL(trunk_fwd, dim3(grid), dim3(NWAVES * 64), LDS_BYTES, stream, a); }
#else
    a.ph_lo = 0; a.ph_hi = N_PHASES;
    hipLaunchKernelGGL(trunk_fwd, dim3(grid), dim3(NWAVES * 64), LDS_BYTES, stream, a);
#endif
    const hipError_t le = hipPeekAtLastError();
    if (le != hipSuccess) fprintf(stderr, "kernel_launch: launch failed: %s\n", hipGetErrorName(le));
}
```

```cpp
#include <hip/hip_runtime.h>
#include <cstdio>
#include <cstdint>
namespace pg8 {
#define PG8_LAS __attribute__((address_space(3)))
typedef unsigned short bf16_t;
typedef short bf16x8 __attribute__((ext_vector_type(8)));
typedef float f32x4 __attribute__((ext_vector_type(4)));
typedef unsigned u32x4 __attribute__((ext_vector_type(4)));
constexpr int BM = 256, BK = 64, HALF = 128, HTB = HALF * BK * 2  , STAGE_BYTES = 8 * HTB, NXCD = 8, WGM = 8;

__host__ __device__ __forceinline__ int lds_byte(int r, int c) { const int st = (r >> 4) * 2 + (c >> 5), rr = r & 15, cc = c & 31, ob = rr * 64 + cc * 2; return st * 1024 + (ob ^ (((ob >> 9) & 1) << 5)); }
__host__ __device__ __forceinline__ void stage_rc(int b, int& R, int& C) { const int st = b / 1024, sb = b % 1024, swz = sb ^ (((sb >> 9) & 1) << 5); R = (st >> 1) * 16 + swz / 64; C = (st & 1) * 32 + (swz % 64) / 2; }
__host__ __device__ __forceinline__ int perm32(int rho) { const int n = rho >> 4, i = rho & 15; return 8 * (i >> 2) + 4 * n + (i & 3); }

struct Unit { int pm, pn; };
struct Gemm { const bf16_t* A; const bf16_t* Bt; int M, N, K; bf16_t* dummy; };

struct StaticOrder {
    int nM, nN, nwg, G, c;
    __host__ __device__ void init(int M, int N, int G_, int c_) { nM = M / BM; nN = N / BM; nwg = nM * nN; G = G_; c = c_; }
    __host__ __device__ bool next(int i, Unit& u) const {
        const long L = (long)i * G + c; if (L >= nwg) return false;
        int wgid = (int)L; { const int q = nwg / NXCD, r = nwg % NXCD, xcd = wgid % NXCD, off = wgid / NXCD; wgid = (xcd < r ? xcd * (q + 1) : r * (q + 1) + (xcd - r) * q) + off; }
        const int nig = WGM * nN, gid = wgid / nig, fm = gid * WGM, gsz = (nM - fm) < WGM ? (nM - fm) : WGM;
        u.pm = fm + ((wgid % nig) % gsz); u.pn = (wgid % nig) / gsz; return true;
    }
    __device__ __forceinline__ void a_ready(const Unit&) const {}
    __device__ __forceinline__ void done(const Unit&) const {}
};

typedef float f32x2pk __attribute__((ext_vector_type(2))); typedef __bf16 bf16x2pk __attribute__((ext_vector_type(2)));
__device__ __forceinline__ unsigned cvt_pk_bf16(float lo, float hi) { const f32x2pk v = {lo, hi}; const bf16x2pk b = __builtin_convertvector(v, bf16x2pk); return __builtin_bit_cast(unsigned, b); }
typedef float f32x2 __attribute__((ext_vector_type(2)));
template <class Epi, class Sched, bool ALIGN_EPI = false, bool SP2 = false>
__device__ __forceinline__ void gemm_phase(PG8_LAS unsigned char* lds, const Gemm g, const Sched& S, const Epi& E, const int wave_s  ) {
    int tid_l; asm volatile("v_mbcnt_lo_u32_b32 %0, -1, 0\n\tv_mbcnt_hi_u32_b32 %0, -1, %0" : "=v"(tid_l)); tid_l += wave_s * 64;
    const int tid = tid_l, wid = wave_s, lane = tid & 63, wr = wid >> 2, wc = wid & 3, fr = lane & 15, fq = lane >> 4;
    const int K = g.K, nt = K / BK;
    unsigned voffA[2], voffB[2];
#pragma unroll
    for (int i = 0; i < 2; ++i) { int R, C; stage_rc(tid * 16 + i * 8192, R, C); const int Rb = Epi::PERM ? ((R & ~31) + perm32(R & 31)) : R;
        voffA[i] = (unsigned)(R * K + C) * 2u; voffB[i] = (unsigned)(Rb * K + C) * 2u; }
    const size_t kstep = (size_t)(BK * 2);
    const size_t hstep = (size_t)HALF * K * 2;
    const size_t tstep = 2 * hstep;
    const unsigned ldsw = (unsigned)wid * 1024u;
    const int aoff = lds_byte(wr * 64 + fr, fq * 8), boff = lds_byte(wc * 32 + fr, fq * 8);
#define PG8_SA(b, h) (((b) * 2 + (h)) * HTB)
#define PG8_SB(b, h) ((4 + (b) * 2 + (h)) * HTB)
#define PG8_STAGE(bufoff, gbase, voff) do { _Pragma("unroll") for (int _i = 0; _i < 2; ++_i) \
        __builtin_amdgcn_global_load_lds((const unsigned*)((const char*)(gbase) + (voff)[_i]), (PG8_LAS unsigned*)(lds + (bufoff) + ldsw + _i * 8192), 16, 0, 0); } while (0)
#define PG8_LDA(dst, b, h) do { _Pragma("unroll") for (int m = 0; m < 4; ++m) _Pragma("unroll") for (int k = 0; k < 2; ++k) dst[m][k] = *(const PG8_LAS bf16x8*)(lds + PG8_SA(b, h) + aoff + m * 2048 + k * 1024); } while (0)
#define PG8_LDB(dst, b, h) do { _Pragma("unroll") for (int n = 0; n < 2; ++n) _Pragma("unroll") for (int k = 0; k < 2; ++k) dst[n][k] = *(const PG8_LAS bf16x8*)(lds + PG8_SB(b, h) + boff + n * 2048 + k * 1024); } while (0)
#define PG8_MMA(ai, bj, At, Bt) do { __builtin_amdgcn_s_setprio(1); _Pragma("unroll") for (int m = 0; m < 4; ++m) _Pragma("unroll") for (int n = 0; n < 2; ++n) _Pragma("unroll") for (int k = 0; k < 2; ++k) \
        acc[ai][bj][m][n] = __builtin_amdgcn_mfma_f32_16x16x32_bf16(Bt[n][k], At[m][k], acc[ai][bj][m][n], 0, 0, 0); __builtin_amdgcn_s_setprio(0); } while (0)
#define PG8_WAIT_V(n) asm volatile("s_waitcnt vmcnt(" #n ")" ::: "memory")
#define PG8_WAIT_L(n) asm volatile("s_waitcnt lgkmcnt(" #n ")" ::: "memory")
#define PG8_WAIT_VR(flag, n) asm volatile("s_cmp_eq_u32 %0, 0\n\ts_cbranch_scc0 .Lpg8w%=\n\ts_waitcnt vmcnt(8)\n.Lpg8w%=:\n\ts_waitcnt vmcnt(%1)" :: "s"(flag), "n"(n) : "memory", "scc")
#define PG8_BAR __builtin_amdgcn_s_barrier()
#define PG8_SCHED __builtin_amdgcn_sched_barrier(0)
    Unit cur, nxt; int ui = 0;
    if (!S.next(0, cur)) return;
    f32x4 acc[2][2][4][2];
#pragma unroll
    for (int a = 0; a < 2; ++a)
#pragma unroll
        for (int b = 0; b < 2; ++b)
#pragma unroll
            for (int m = 0; m < 4; ++m)
#pragma unroll
                for (int n = 0; n < 2; ++n) acc[a][b][m][n] = (f32x4){0.f, 0.f, 0.f, 0.f};
    bf16x8 At[4][2], B0[2][2], B1[2][2];
    const char* cA = (const char*)g.A + (size_t)cur.pm * tstep; const char* cB = (const char*)g.Bt + (size_t)cur.pn * tstep;
    S.a_ready(cur);
    if constexpr (SP2) {
        PG8_STAGE(PG8_SB(0, 0), cB, voffB); PG8_STAGE(PG8_SB(0, 1), cB + hstep, voffB); PG8_STAGE(PG8_SA(0, 0), cA, voffA); PG8_STAGE(PG8_SA(0, 1), cA + hstep, voffA);
        if (wr == 1) PG8_BAR;
        PG8_WAIT_V(2); PG8_BAR;
        PG8_STAGE(PG8_SB(1, 0), cB + kstep, voffB); PG8_STAGE(PG8_SA(1, 0), cA + kstep, voffA); PG8_STAGE(PG8_SB(1, 1), cB + hstep + kstep, voffB);
        PG8_WAIT_V(6); PG8_BAR;
    } else {
        PG8_STAGE(PG8_SB(0, 0), cB, voffB); PG8_STAGE(PG8_SA(0, 0), cA, voffA); PG8_STAGE(PG8_SB(0, 1), cB + hstep, voffB); PG8_STAGE(PG8_SA(0, 1), cA + hstep, voffA);
        if (wr == 1) PG8_BAR;
        PG8_WAIT_V(4); PG8_BAR;
        PG8_STAGE(PG8_SB(1, 0), cB + kstep, voffB); PG8_STAGE(PG8_SA(1, 0), cA + kstep, voffA); PG8_STAGE(PG8_SB(1, 1), cB + hstep + kstep, voffB);
        PG8_WAIT_V(6); PG8_BAR;
    }
    for (;;) {
        const bool has_next = S.next(ui + 1, nxt);
        const char* nA = has_next ? (const char*)g.A + (size_t)nxt.pm * tstep : cA; const char* nB = has_next ? (const char*)g.Bt + (size_t)nxt.pn * tstep : cB;
        for (int t = 0; t < nt; t += 2) {
            const bool last = (t == nt - 2);
            const char* a1 = cA + (size_t)(t + 1) * kstep;
            const char* a2 = last ? nA : cA + (size_t)(t + 2) * kstep; const char* b2 = last ? nB : cB + (size_t)(t + 2) * kstep;
            const char* a3 = a2 + kstep; const char* b3 = b2 + kstep;
            if (last && has_next) S.a_ready(nxt);
            if constexpr (SP2) {
            PG8_LDB(B0, 0, 0); PG8_LDB(B1, 0, 1); PG8_SCHED; PG8_LDA(At, 0, 0); PG8_STAGE(PG8_SA(1, 1), a1 + hstep, voffA);
            PG8_WAIT_V(8); PG8_WAIT_L(0); PG8_BAR; PG8_MMA(0, 0, At, B0); PG8_MMA(0, 1, At, B1); PG8_BAR; PG8_SCHED;
            PG8_LDA(At, 0, 1); PG8_STAGE(PG8_SB(0, 0), b2, voffB); PG8_STAGE(PG8_SB(0, 1), b2 + hstep, voffB); PG8_STAGE(PG8_SA(0, 0), a2, voffA);
            PG8_WAIT_V(8); PG8_WAIT_L(0); PG8_BAR; PG8_MMA(1, 0, At, B0); PG8_MMA(1, 1, At, B1); PG8_BAR; PG8_SCHED;
            PG8_LDB(B0, 1, 0); PG8_LDB(B1, 1, 1); PG8_SCHED; PG8_LDA(At, 1, 0); PG8_STAGE(PG8_SA(0, 1), a2 + hstep, voffA);
            PG8_WAIT_V(8); PG8_WAIT_L(0); PG8_BAR; PG8_MMA(0, 0, At, B0); PG8_MMA(0, 1, At, B1); PG8_BAR; PG8_SCHED;
            PG8_LDA(At, 1, 1); PG8_STAGE(PG8_SB(1, 0), b3, voffB); PG8_STAGE(PG8_SB(1, 1), b3 + hstep, voffB); PG8_STAGE(PG8_SA(1, 0), a3, voffA);
            PG8_WAIT_V(8); PG8_WAIT_L(0); PG8_BAR; PG8_MMA(1, 0, At, B0); PG8_MMA(1, 1, At, B1); PG8_BAR; PG8_SCHED;
            } else {
            PG8_LDB(B0, 0, 0); PG8_SCHED; PG8_LDA(At, 0, 0); PG8_STAGE(PG8_SA(1, 1), a1 + hstep, voffA);
            PG8_WAIT_L(8); PG8_BAR; PG8_WAIT_L(0); PG8_MMA(0, 0, At, B0); PG8_BAR; PG8_SCHED;
            PG8_LDB(B1, 0, 1); PG8_STAGE(PG8_SB(0, 0), b2, voffB);
            PG8_BAR; PG8_WAIT_L(0); PG8_MMA(0, 1, At, B1); PG8_BAR;
            PG8_LDA(At, 0, 1); PG8_STAGE(PG8_SA(0, 0), a2, voffA);
            PG8_BAR; PG8_WAIT_L(0); PG8_MMA(1, 0, At, B0); PG8_BAR; PG8_SCHED;
            PG8_STAGE(PG8_SB(0, 1), b2 + hstep, voffB);
            PG8_WAIT_V(6); PG8_BAR; PG8_MMA(1, 1, At, B1); PG8_BAR;
            PG8_LDB(B0, 1, 0); PG8_SCHED; PG8_LDA(At, 1, 0); PG8_STAGE(PG8_SA(0, 1), a2 + hstep, voffA);
            PG8_WAIT_L(8); PG8_BAR; PG8_WAIT_L(0); PG8_MMA(0, 0, At, B0); PG8_BAR; PG8_SCHED;
            PG8_LDB(B1, 1, 1); PG8_STAGE(PG8_SB(1, 0), b3, voffB);
            PG8_BAR; PG8_WAIT_L(0); PG8_MMA(0, 1, At, B1); PG8_BAR;
            PG8_LDA(At, 1, 1); PG8_STAGE(PG8_SA(1, 0), a3, voffA);
            PG8_BAR; PG8_WAIT_L(0); PG8_MMA(1, 0, At, B0); PG8_BAR; PG8_SCHED;
            PG8_STAGE(PG8_SB(1, 1), b3 + hstep, voffB);
            PG8_WAIT_V(6); PG8_BAR; PG8_MMA(1, 1, At, B1); PG8_BAR;
            }
        }
        if constexpr (ALIGN_EPI) { if (wr == 0) PG8_BAR; }
        if constexpr (!Epi::AFTER_DRAIN) { E(acc, cur, wr, wc, fr, fq); S.done(cur); }
        if (!has_next) break;
#pragma unroll
        for (int a = 0; a < 2; ++a)
#pragma unroll
            for (int b = 0; b < 2; ++b)
#pragma unroll
                for (int m = 0; m < 4; ++m)
#pragma unroll
                    for (int n = 0; n < 2; ++n) acc[a][b][m][n] = (f32x4){0.f, 0.f, 0.f, 0.f};
        cur = nxt; cA = nA; cB = nB; ++ui;
        if constexpr (ALIGN_EPI) { if (wr == 1) PG8_BAR; }
    }
    PG8_WAIT_V(0);
    if constexpr (!ALIGN_EPI) { if (wr == 0) PG8_BAR; }
    PG8_BAR;
    if constexpr (Epi::AFTER_DRAIN) { E.fused(acc, cur, wr, wc, fr, fq, lds, wid, lane); S.done(cur); }
#undef PG8_SA
#undef PG8_SB
#undef PG8_STAGE
#undef PG8_LDA
#undef PG8_LDB
#undef PG8_MMA
#undef PG8_WAIT_V
#undef PG8_WAIT_L
#undef PG8_WAIT_VR
#undef PG8_BAR
#undef PG8_SCHED
}
}
#define GAS __attribute__((address_space(1)))
#define LAS __attribute__((address_space(3)))
typedef unsigned short bf16;
typedef unsigned v4u __attribute__((ext_vector_type(4)));
typedef float f32x4 __attribute__((ext_vector_type(4)));
typedef short bf16x8 __attribute__((ext_vector_type(8)));
typedef GAS unsigned gu32;
typedef GAS unsigned long long gu64;
#define RLX_AGENT __ATOMIC_RELAXED, __HIP_MEMORY_SCOPE_AGENT
#define LDS_WAIT() asm volatile("s_waitcnt lgkmcnt(0)" ::: "memory")
#define VM_WAIT() asm volatile("s_waitcnt vmcnt(0)" ::: "memory")
__device__ __forceinline__ unsigned long long rt() { return __builtin_amdgcn_s_memrealtime(); }
__device__ __forceinline__ unsigned f2bf(float f) { unsigned u = __builtin_bit_cast(unsigned, f); return (u + 0x7fffu + ((u >> 16) & 1u)) >> 16; }
__device__ __forceinline__ unsigned pk2(float lo, float hi) { return f2bf(lo) | (f2bf(hi) << 16); }
#define XB_TMO      128
#define XB_XCNT(j)  (256  + 64 * (j))
#define XB_XSUB(j)  (1280 + 64 * (j))
#define XB_XGEN(j)  (2304 + 64 * (j))
#define XB_TOP      3328
#define XB_TOPGEN   3392
#define XCD_BAR_WORDS 3456
#define XB_SPIN_CAP (1u << 18)

__device__ __forceinline__ unsigned xb_ld(unsigned* p)              { return __hip_atomic_load(p, __ATOMIC_RELAXED, __HIP_MEMORY_SCOPE_AGENT); }
__device__ __forceinline__ unsigned xb_add(unsigned* p, unsigned v) { return __hip_atomic_fetch_add(p, v, __ATOMIC_RELAXED, __HIP_MEMORY_SCOPE_AGENT); }
__device__ __forceinline__ unsigned xb_xcc_id() { return (unsigned)__builtin_amdgcn_s_getreg((3 << 11) | 20) & 0xFu; }
#define XB_SPIN(cond, bar) do { unsigned _sp = 0; while (cond) { __builtin_amdgcn_s_sleep(1); \
    if ((++_sp & 255u) == 0u) { if (xb_ld(&(bar)[XB_TMO])) break; if (_sp > XB_SPIN_CAP) { atomicAdd(&(bar)[XB_TMO], 1u); break; } } } } while (0)

struct XcdBarrier {
    unsigned* bar; unsigned x;
    volatile LAS unsigned* st;
};

__device__ __forceinline__ XcdBarrier xcd_barrier_post(unsigned* bar, volatile LAS unsigned* st) {
    XcdBarrier b; b.bar = bar; b.x = xb_xcc_id(); b.st = st;
    if (threadIdx.x == 0) (void)xb_add(&bar[XB_XCNT(b.x)], 1u);
    return b;
}
__device__ __forceinline__ void xcd_barrier_complete(unsigned* bar, unsigned x, unsigned& nloc, unsigned& nx) {
    const unsigned G = gridDim.x * gridDim.y * gridDim.z;
    unsigned sum, cnt, mine, sp = 0u;
    for (;;) {
        sum = 0u; cnt = 0u; mine = 0u;
#pragma unroll
        for (unsigned j = 0; j < 16; ++j) { const unsigned c = xb_ld(&bar[XB_XCNT(j)]); sum += c; cnt += (c > 0u) ? 1u : 0u; mine = (j == x) ? c : mine; }
        if (sum == G) break;
        __builtin_amdgcn_s_sleep(1);
        if ((++sp & 255u) == 0u) { if (xb_ld(&bar[XB_TMO])) break; if (sp > XB_SPIN_CAP) { atomicAdd(&bar[XB_TMO], 1u); break; } }
    }
    nloc = mine > 0u ? mine : 1u; nx = cnt > 0u ? cnt : 1u;
}

__device__ __forceinline__ void xcd_barrier(const XcdBarrier& b) {
    asm volatile("s_waitcnt vmcnt(0)" ::: "memory");
    __syncthreads();
    if (threadIdx.x == 0) {
        unsigned* bar = b.bar;
        __builtin_amdgcn_s_waitcnt(0);
        unsigned nloc = b.st[0], nx = b.st[1];
        if (nloc == 0u) { xcd_barrier_complete(bar, b.x, nloc, nx); b.st[0] = nloc; b.st[1] = nx; }
        const unsigned old = xb_add(&bar[XB_XSUB(b.x)], 1u);
        const unsigned gen = old / nloc;
        if (old + 1u == (gen + 1u) * nloc) {
            __builtin_amdgcn_fence(__ATOMIC_RELEASE, "agent");
            asm volatile("s_waitcnt vmcnt(0)" ::: "memory");
            const unsigned og = xb_add(&bar[XB_TOP], 1u);
            const unsigned tg = og / nx;
            if (og + 1u == (tg + 1u) * nx) xb_add(&bar[XB_TOPGEN], 1u);
            else XB_SPIN(xb_ld(&bar[XB_TOPGEN]) == tg, bar);
            __builtin_amdgcn_fence(__ATOMIC_ACQUIRE, "agent");
            xb_add(&bar[XB_XGEN(b.x)], 1u);
            asm volatile("s_waitcnt vmcnt(0)" ::: "memory");
        } else {
            XB_SPIN(xb_ld(&bar[XB_XGEN(b.x)]) == gen, bar);
            __builtin_amdgcn_fence(__ATOMIC_ACQUIRE, "agent");
            asm volatile("s_waitcnt vmcnt(0)" ::: "memory");
        }
    }
    __syncthreads();
}

constexpr int DM = 2048, SEQ = 2048, NBP = 8, NBS = 16, TS = 16, PAST = 2048, DEPTH = 4;
constexpr int MP = NBP * SEQ, MS = NBS * TS, MR = MP + MS, MC = NBS * PAST, MKV = MR + MC;
constexpr int NH = 8, QKD = 192, QLR = 512, KVLR = 512, DATT = 1024, DCONV = 1024, DFF = 8192, INC = 4160;
constexpr int ZW = 3072, NQ = NH * QKD, NKV = NH * 256, MODW = 6 * DM, NB = NBP + NBS;
constexpr int NPOS = PAST + TS;
constexpr float EPS = 1e-6f;
constexpr float ATTN_SCALE = 0.07216878364870322f;
constexpr float LOG2E = 1.4426950408889634f;

namespace pg8 {
template <int ACT> struct EpiStore {
    static constexpr bool PERM = true, AFTER_DRAIN = false; static constexpr int NST = 16;
    bf16_t* O; int ldc;
    __device__ __forceinline__ void operator()(const f32x4 (&acc)[2][2][4][2], const Unit& u, int wr, int wc, int fr, int fq) const {
        const int row0 = u.pm * BM + wr * 64 + fr, col0 = u.pn * BM + wc * 32 + 8 * fq;
#pragma unroll
        for (int ai = 0; ai < 2; ++ai)
#pragma unroll
            for (int m = 0; m < 4; ++m) { bf16_t* rowp = O + (size_t)(row0 + ai * HALF + m * 16) * ldc + col0;
#pragma unroll
                for (int bj = 0; bj < 2; ++bj) { f32x4 v0 = acc[ai][bj][m][0], v1 = acc[ai][bj][m][1];
                    if (ACT == 1) {
#pragma unroll
                        for (int e = 0; e < 4; ++e) { const float a = v0[e] > 0.f ? v0[e] : 0.f, b = v1[e] > 0.f ? v1[e] : 0.f; v0[e] = a * a; v1[e] = b * b; } }
                    u32x4 w; w.x = cvt_pk_bf16(v0[0], v0[1]); w.y = cvt_pk_bf16(v0[2], v0[3]); w.z = cvt_pk_bf16(v1[0], v1[1]); w.w = cvt_pk_bf16(v1[2], v1[3]);
                    *(u32x4*)(rowp + bj * HALF) = w; } }
    }
};
struct EpiZ {
    static constexpr bool PERM = true, AFTER_DRAIN = false; static constexpr int NST = 8;
    bf16_t* O;
    __device__ __forceinline__ void operator()(const f32x4 (&acc)[2][2][4][2], const Unit& u, int wr, int wc, int fr, int fq) const {
        const int row0 = u.pm * BM + wr * 64 + fr, lc = wc * 32 + 8 * fq;
        const bool prod = (u.pn >= 4 && u.pn < 12);
        const int colb = prod ? 1024 + 128 * (u.pn - 4) : (u.pn < 4 ? 256 * u.pn : 2048 + 256 * (u.pn - 12));
#pragma unroll
        for (int ai = 0; ai < 2; ++ai)
#pragma unroll
            for (int m = 0; m < 4; ++m) { bf16_t* rowp = O + (size_t)(row0 + ai * HALF + m * 16) * ZW + colb + lc;
                if (prod) { const f32x4 v0 = acc[ai][0][m][0] * acc[ai][1][m][0], v1 = acc[ai][0][m][1] * acc[ai][1][m][1];
                    u32x4 w; w.x = cvt_pk_bf16(v0[0], v0[1]); w.y = cvt_pk_bf16(v0[2], v0[3]); w.z = cvt_pk_bf16(v1[0], v1[1]); w.w = cvt_pk_bf16(v1[2], v1[3]);
                    *(u32x4*)(rowp) = w; }
                else {
#pragma unroll
                    for (int bj = 0; bj < 2; ++bj) { const f32x4 v0 = acc[ai][bj][m][0], v1 = acc[ai][bj][m][1];
                        u32x4 w; w.x = cvt_pk_bf16(v0[0], v0[1]); w.y = cvt_pk_bf16(v0[2], v0[3]); w.z = cvt_pk_bf16(v1[0], v1[1]); w.w = cvt_pk_bf16(v1[2], v1[3]);
                        *(u32x4*)(rowp + bj * HALF) = w; } } }
    }
};
struct EpiResid {
    static constexpr bool PERM = true, AFTER_DRAIN = false; static constexpr int NST = 0;
    const float* xin32; const bf16_t* xin16; bf16_t* xout; const float* gate;
    __device__ __forceinline__ void operator()(const f32x4 (&acc)[2][2][4][2], const Unit& u, int wr, int wc, int fr, int fq) const {
        const int col0 = u.pn * BM + wc * 32 + 8 * fq;
        const float* g = gate + (size_t)(u.pm >> 3) * MODW + col0;
#pragma unroll
        for (int ai = 0; ai < 2; ++ai)
#pragma unroll
            for (int m = 0; m < 4; ++m) { const size_t off = (size_t)(u.pm * BM + ai * HALF + wr * 64 + m * 16 + fr) * DM + col0;
#pragma unroll
                for (int bj = 0; bj < 2; ++bj) { f32x4 x0, x1;
                    if (xin32) { x0 = *(const f32x4*)(xin32 + off + bj * HALF); x1 = *(const f32x4*)(xin32 + off + bj * HALF + 4); }
                    else { const u32x4 w = *(const u32x4*)(xin16 + off + bj * HALF);
                        x0 = (f32x4){__uint_as_float(w.x << 16), __uint_as_float(w.x & 0xffff0000u), __uint_as_float(w.y << 16), __uint_as_float(w.y & 0xffff0000u)};
                        x1 = (f32x4){__uint_as_float(w.z << 16), __uint_as_float(w.z & 0xffff0000u), __uint_as_float(w.w << 16), __uint_as_float(w.w & 0xffff0000u)}; }
                    const f32x4 y0 = x0 + *(const f32x4*)(g + bj * HALF) * acc[ai][bj][m][0], y1 = x1 + *(const f32x4*)(g + bj * HALF + 4) * acc[ai][bj][m][1];
                    u32x4 o; o.x = cvt_pk_bf16(y0[0], y0[1]); o.y = cvt_pk_bf16(y0[2], y0[3]); o.z = cvt_pk_bf16(y1[0], y1[1]); o.w = cvt_pk_bf16(y1[2], y1[3]);
                    *(u32x4*)(xout + off + bj * HALF) = o; } }
    }
};
}

namespace att {
using bf16x8 = __attribute__((ext_vector_type(8))) short;
using s16x4  = __attribute__((ext_vector_type(4))) short;
using f32x16 = __attribute__((ext_vector_type(16))) float;
using f32x4  = __attribute__((ext_vector_type(4))) float;
using u32x4  = __attribute__((ext_vector_type(4))) unsigned;
typedef unsigned short bf16_t;
constexpr int NW = 8, QBLK = 32, KVBLK = 64;
constexpr int SHM_V = KVBLK * 128 * 2, SHM_KN = KVBLK * 128 * 2, SHM_KP = KVBLK * 64 * 2;
constexpr int OFF_V = 0, OFF_KN = 2 * SHM_V, OFF_KP = OFF_KN + 2 * SHM_KN, OFF_WS = OFF_KP + 2 * SHM_KP, OFF_QP = OFF_WS + NW * 64 * 4, ATT_LDS = OFF_QP + NW * 4 * 1024;
constexpr float THR = 8.f;
constexpr float CSC = ATTN_SCALE * LOG2E;
#define KSWZ(row, colB) ((row) * 256 + ((colB) ^ (((row) & 7) << 4)))
#define PSWZ(row, colB) ((row) * 128 + ((colB) ^ (((row) & 7) << 4)))
#define SBAR() __builtin_amdgcn_sched_barrier(0)
__device__ __forceinline__ int crow(int r, int hi) { return (r & 3) + 8 * (r >> 2) + 4 * hi; }
__device__ __forceinline__ unsigned cvtpk(float lo, float hi) { unsigned r; asm volatile("v_cvt_pk_bf16_f32 %0, %1, %2" : "=v"(r) : "v"(lo), "v"(hi)); return r; }
__device__ __forceinline__ float bflo(unsigned w) { return __uint_as_float(w << 16); }
__device__ __forceinline__ float bfhi(unsigned w) { return __uint_as_float(w & 0xffff0000u); }

__device__ __forceinline__ void partialSM(f32x16& p0, f32x16& p1, float& m_reg, float& mn, float& alpha) {
  float pmax = p0[0];
#pragma unroll
  for (int r = 1; r < 16; ++r) pmax = fmaxf(pmax, p0[r]);
#pragma unroll
  for (int r = 0; r < 16; ++r) pmax = fmaxf(pmax, p1[r]);
  { auto rr = __builtin_amdgcn_permlane32_swap(__float_as_uint(pmax), __float_as_uint(pmax), false, false);
    pmax = fmaxf(__uint_as_float(rr[0]), __uint_as_float(rr[1])); }
  if (__builtin_expect(__all(pmax - m_reg <= THR / ATTN_SCALE), 1)) { mn = m_reg; alpha = 1.f; }
  else { mn = fmaxf(m_reg, pmax); alpha = __builtin_amdgcn_exp2f((m_reg - mn) * CSC); m_reg = mn; }
  const float mnC = -mn * CSC;
#pragma unroll
  for (int r = 0; r < 16; ++r) p0[r] = fmaf(p0[r], CSC, mnC);
#pragma unroll
  for (int r = 0; r < 16; ++r) p1[r] = fmaf(p1[r], CSC, mnC);
#pragma unroll
  for (int r = 0; r < 16; ++r) p0[r] = __builtin_amdgcn_exp2f(p0[r]);
}
__device__ __forceinline__ void finishSM(f32x16& p0, f32x16& p1, float alpha, float& l_reg, bf16x8& pa0, bf16x8& pa1, bf16x8& pa2, bf16x8& pa3) {
#pragma unroll
  for (int r = 0; r < 16; ++r) p1[r] = __builtin_amdgcn_exp2f(p1[r]);
  float ps = 0;
#pragma unroll
  for (int r = 0; r < 16; ++r) ps += p0[r];
#pragma unroll
  for (int r = 0; r < 16; ++r) ps += p1[r];
  { auto rr = __builtin_amdgcn_permlane32_swap(__float_as_uint(ps), __float_as_uint(ps), false, false);
    ps = __uint_as_float(rr[0]) + __uint_as_float(rr[1]); }
  l_reg = l_reg * alpha + ps;
#define PK4(P, BASE, OUT) do { unsigned a0 = cvtpk(P[BASE + 0], P[BASE + 1]), a1 = cvtpk(P[BASE + 2], P[BASE + 3]);   \
    unsigned b0 = cvtpk(P[BASE + 4], P[BASE + 5]), b1 = cvtpk(P[BASE + 6], P[BASE + 7]);                              \
    auto r0 = __builtin_amdgcn_permlane32_swap(a0, b0, false, false); auto r1 = __builtin_amdgcn_permlane32_swap(a1, b1, false, false); \
    u32x4 w = {r0[0], r1[0], r0[1], r1[1]}; OUT = *reinterpret_cast<bf16x8*>(&w); } while (0)
  PK4(p0, 0, pa0); PK4(p0, 8, pa1); PK4(p1, 0, pa2); PK4(p1, 8, pa3);
#undef PK4
}
__device__ __forceinline__ void qkt(f32x16& p0, f32x16& p1, const char* Kn, const char* Kp, const bf16x8* qr, const char* qp, int r32, int hi) {
  p0 = f32x16{}; p1 = f32x16{};
#pragma unroll
  for (int d0 = 0; d0 < 8; ++d0) { const int cb = (d0 * 16 + hi * 8) * 2;
    const bf16x8 b0 = *reinterpret_cast<const bf16x8*>(Kn + KSWZ(r32, cb));
    const bf16x8 b1 = *reinterpret_cast<const bf16x8*>(Kn + KSWZ(32 + r32, cb));
    p0 = __builtin_amdgcn_mfma_f32_32x32x16_bf16(b0, qr[d0], p0, 0, 0, 0);
    p1 = __builtin_amdgcn_mfma_f32_32x32x16_bf16(b1, qr[d0], p1, 0, 0, 0); }
#pragma unroll
  for (int d0 = 0; d0 < 4; ++d0) { const int cb = (d0 * 16 + hi * 8) * 2;
    const bf16x8 b0 = *reinterpret_cast<const bf16x8*>(Kp + PSWZ(r32, cb));
    const bf16x8 b1 = *reinterpret_cast<const bf16x8*>(Kp + PSWZ(32 + r32, cb));
    const bf16x8 qd = *reinterpret_cast<const bf16x8*>(qp + d0 * 1024);
    p0 = __builtin_amdgcn_mfma_f32_32x32x16_bf16(b0, qd, p0, 0, 0, 0);
    p1 = __builtin_amdgcn_mfma_f32_32x32x16_bf16(b1, qd, p1, 0, 0, 0); }
}
__device__ __forceinline__ void maskt(f32x16& p0, f32x16& p1, bool hide) {
  if (hide) {
#pragma unroll
    for (int r = 0; r < 16; ++r) { p0[r] = -INFINITY; p1[r] = -INFINITY; } }
}
__device__ __forceinline__ int v_st(int k, int c) { const int kk = (k & ~0xC) | ((k & 4) << 1) | ((k & 8) >> 1); return ((kk >> 3) * 4 + (c >> 5)) * 512 + ((kk & 7) * 32 + (c & 31)) * 2; }
__device__ __forceinline__ int v_rd_base(int lane) { return ((lane & 3) << 3) | (((lane >> 2) & 3) << 6) | (((lane >> 4) & 1) << 5) | (((lane >> 5) & 1) << 8); }
constexpr int v_rd_off(int d0, int ks, int half) { return d0 * 512 + ks * 4096 + half * 2048; }
template <int OFF> __device__ __forceinline__ s16x4 tr_read(int vb) {
  s16x4 r; asm volatile("ds_read_b64_tr_b16 %0, %1 offset:%2" : "=&v"(r) : "v"(vb), "i"(OFF) : "memory"); return r;
}
template <int D0> __device__ __forceinline__ void pv_one(f32x16& od, int vb, bf16x8 pa0, bf16x8 pa1, bf16x8 pa2, bf16x8 pa3) {
  const s16x4 l0 = tr_read<v_rd_off(D0, 0, 0)>(vb), h0 = tr_read<v_rd_off(D0, 0, 1)>(vb), l1 = tr_read<v_rd_off(D0, 1, 0)>(vb), h1 = tr_read<v_rd_off(D0, 1, 1)>(vb);
  const s16x4 l2 = tr_read<v_rd_off(D0, 2, 0)>(vb), h2 = tr_read<v_rd_off(D0, 2, 1)>(vb), l3 = tr_read<v_rd_off(D0, 3, 0)>(vb), h3 = tr_read<v_rd_off(D0, 3, 1)>(vb);
  asm volatile("s_waitcnt lgkmcnt(0)" ::: "memory"); SBAR();
#define PK(L, H) (bf16x8){L[0], L[1], L[2], L[3], H[0], H[1], H[2], H[3]}
  od = __builtin_amdgcn_mfma_f32_32x32x16_bf16(pa0, PK(l0, h0), od, 0, 0, 0);
  od = __builtin_amdgcn_mfma_f32_32x32x16_bf16(pa1, PK(l1, h1), od, 0, 0, 0);
  od = __builtin_amdgcn_mfma_f32_32x32x16_bf16(pa2, PK(l2, h2), od, 0, 0, 0);
  od = __builtin_amdgcn_mfma_f32_32x32x16_bf16(pa3, PK(l3, h3), od, 0, 0, 0);
#undef PK
}
__device__ __forceinline__ void pv_d0(f32x16* o, int vb, bf16x8 pa0, bf16x8 pa1, bf16x8 pa2, bf16x8 pa3) {
  pv_one<0>(o[0], vb, pa0, pa1, pa2, pa3); pv_one<1>(o[1], vb, pa0, pa1, pa2, pa3); pv_one<2>(o[2], vb, pa0, pa1, pa2, pa3); pv_one<3>(o[3], vb, pa0, pa1, pa2, pa3);
}

__device__ __forceinline__ void attn_unit(int b, int h, int qb, const bf16_t* __restrict__ Qb, const bf16_t* __restrict__ KVb, const bf16_t* __restrict__ KPb, bf16_t* __restrict__ Ob,
                                          const float* __restrict__ cosT, const float* __restrict__ sinT, char* lds, const int wave_s) {
  int tid_l; asm volatile("v_mbcnt_lo_u32_b32 %0, -1, 0\n\tv_mbcnt_hi_u32_b32 %0, -1, %0" : "=v"(tid_l)); tid_l += wave_s * 64;
  const int tid = tid_l, wid = wave_s, lane = tid & 63, r32 = lane & 31, hi = lane >> 5;
  char* V_lds = lds + OFF_V; char* KN_lds = lds + OFF_KN; char* KP_lds = lds + OFF_KP;
  float* ws = (float*)(lds + OFF_WS) + wid * 64; float* li_l = ws; float* al_l = ws + 32;
  float m_reg = -1e30f, l_reg = 0; f32x16 o[4] = {}; bf16x8 qr[8];
  char* qp = lds + OFF_QP + wid * 4096 + lane * 16;
  const int q0 = qb * 256, tq = q0 + wid * QBLK + r32;
  const long rowbase = (long)b * SEQ;
  { const bf16_t* Qw = Qb + (rowbase + tq) * NQ + h * QKD + hi * 8;
#pragma unroll
    for (int d0 = 0; d0 < 8; ++d0) qr[d0] = *reinterpret_cast<const bf16x8*>(Qw + d0 * 16);
#pragma unroll
    for (int pr = 0; pr < 2; ++pr) {
      const float* cp = cosT + (long)tq * 32 + pr * 16 + hi * 8; const float* sp = sinT + (long)tq * 32 + pr * 16 + hi * 8;
      const f32x4 c0 = *(const f32x4*)cp, c1 = *(const f32x4*)(cp + 4), s0 = *(const f32x4*)sp, s1 = *(const f32x4*)(sp + 4);
      const u32x4 x1 = *reinterpret_cast<const u32x4*>(Qw + (8 + pr) * 16), x2 = *reinterpret_cast<const u32x4*>(Qw + (10 + pr) * 16);
      u32x4 y1, y2;
#pragma unroll
      for (int w = 0; w < 4; ++w) {
        const float ca = w < 2 ? c0[2 * w] : c1[2 * w - 4], cb = w < 2 ? c0[2 * w + 1] : c1[2 * w - 3];
        const float sa = w < 2 ? s0[2 * w] : s1[2 * w - 4], sb = w < 2 ? s0[2 * w + 1] : s1[2 * w - 3];
        const float a1 = bflo(x1[w]), b1 = bfhi(x1[w]), a2 = bflo(x2[w]), b2 = bfhi(x2[w]);
        y1[w] = cvtpk(a1 * ca - a2 * sa, b1 * cb - b2 * sb);
        y2[w] = cvtpk(a2 * ca + a1 * sa, b2 * cb + b1 * sb); }
      *reinterpret_cast<u32x4*>(qp + pr * 1024) = y1; *reinterpret_cast<u32x4*>(qp + (2 + pr) * 1024) = y2; }
    asm volatile("s_waitcnt lgkmcnt(0)" ::: "memory");
  }
  const bf16_t* Kh = KVb + rowbase * NKV + h * 256; const bf16_t* Vh = Kh + 128; const bf16_t* Ph = KPb + rowbase * 64;
  const int sr = tid >> 4, sc = (tid & 15) * 8, vst0 = v_st(sr, sc), vst1 = v_st(32 + sr, sc);
  const int pr_ = tid >> 3, pc_ = (tid & 7) * 8;
  const int vb0 = (int)(uintptr_t)V_lds + v_rd_base(lane);
  bf16x8 vs0, vs1, ks0, ks1, ps0;
#define SLOAD(k0) do { vs0 = *reinterpret_cast<const bf16x8*>(&Vh[(long)((k0) + sr) * NKV + sc]); vs1 = *reinterpret_cast<const bf16x8*>(&Vh[(long)((k0) + 32 + sr) * NKV + sc]); \
    ks0 = *reinterpret_cast<const bf16x8*>(&Kh[(long)((k0) + sr) * NKV + sc]); ks1 = *reinterpret_cast<const bf16x8*>(&Kh[(long)((k0) + 32 + sr) * NKV + sc]); \
    ps0 = *reinterpret_cast<const bf16x8*>(&Ph[(long)((k0) + pr_) * 64 + pc_]); } while (0)
#define SWRITE(bb) do { *(bf16x8*)(V_lds + (bb) * SHM_V + vst0) = vs0; *(bf16x8*)(V_lds + (bb) * SHM_V + vst1) = vs1; \
    *(bf16x8*)(KN_lds + (bb) * SHM_KN + KSWZ(sr, sc * 2)) = ks0; *(bf16x8*)(KN_lds + (bb) * SHM_KN + KSWZ(32 + sr, sc * 2)) = ks1; \
    *(bf16x8*)(KP_lds + (bb) * SHM_KP + PSWZ(pr_, pc_ * 2)) = ps0; } while (0)
#define SWAIT() asm volatile("s_waitcnt vmcnt(0)" ::: "memory")
#define RESC(a) do { if (__any((a) < 1.f)) { if (hi == 0) al_l[r32] = (a); asm volatile("s_waitcnt lgkmcnt(0)" ::: "memory"); \
    _Pragma("unroll") for (int d = 0; d < 4; ++d) _Pragma("unroll") for (int r = 0; r < 16; ++r) o[d][r] *= al_l[crow(r, hi)]; } } while (0)
  f32x16 pA0, pA1, pB0, pB1; float mnA, mnB, alA, alB; bf16x8 pa0, pa1, pa2, pa3;
  const int NT = 4 * qb + 4, cw = 4 * qb + (wid >> 1);
  SLOAD(0); SWAIT(); SWRITE(0); __syncthreads();
  qkt(pA0, pA1, KN_lds, KP_lds, qr, qp, r32, hi); partialSM(pA0, pA1, m_reg, mnA, alA);
  SLOAD(KVBLK);
  SWAIT(); SWRITE(1); __syncthreads();
  for (int j = 1; j + 1 < NT; j += 2) {
    SBAR(); qkt(pB0, pB1, KN_lds + SHM_KN, KP_lds + SHM_KP, qr, qp, r32, hi); maskt(pB0, pB1, j > cw);
    finishSM(pA0, pA1, alA, l_reg, pa0, pa1, pa2, pa3); SBAR();
    SLOAD((j + 1) * KVBLK); SBAR();
    pv_d0(o, vb0, pa0, pa1, pa2, pa3); partialSM(pB0, pB1, m_reg, mnB, alB);
    __syncthreads(); SWAIT(); SWRITE(0);
    RESC(alB); __syncthreads();
    SBAR(); qkt(pA0, pA1, KN_lds, KP_lds, qr, qp, r32, hi); maskt(pA0, pA1, j + 1 > cw);
    finishSM(pB0, pB1, alB, l_reg, pa0, pa1, pa2, pa3); SBAR();
    SLOAD((j + 2) * KVBLK); SBAR();
    pv_d0(o, vb0 + SHM_V, pa0, pa1, pa2, pa3); partialSM(pA0, pA1, m_reg, mnA, alA);
    __syncthreads(); SWAIT(); SWRITE(1);
    RESC(alA); __syncthreads();
  }
  SBAR(); qkt(pB0, pB1, KN_lds + SHM_KN, KP_lds + SHM_KP, qr, qp, r32, hi); maskt(pB0, pB1, NT - 1 > cw);
  finishSM(pA0, pA1, alA, l_reg, pa0, pa1, pa2, pa3); SBAR();
  pv_d0(o, vb0, pa0, pa1, pa2, pa3); partialSM(pB0, pB1, m_reg, mnB, alB);
  __syncthreads(); RESC(alB);
  finishSM(pB0, pB1, alB, l_reg, pa0, pa1, pa2, pa3); SBAR();
  pv_d0(o, vb0 + SHM_V, pa0, pa1, pa2, pa3);
  if (hi == 0) li_l[r32] = l_reg; asm volatile("s_waitcnt lgkmcnt(0)" ::: "memory");
#pragma unroll
  for (int r = 0; r < 16; ++r) { const float rl = __builtin_amdgcn_rcpf(li_l[crow(r, hi)]);
#pragma unroll
    for (int d0 = 0; d0 < 4; ++d0) o[d0][r] *= rl; }
  bf16_t* Ow = Ob + (rowbase + q0 + wid * QBLK) * DM + h * 128;
  { char* st = lds + OFF_QP + wid * 4096;
#pragma unroll
    for (int half = 0; half < 2; ++half) {
#pragma unroll
      for (int r = 0; r < 16; ++r) { const int orow = crow(r, hi);
#pragma unroll
        for (int dd = 0; dd < 2; ++dd) *reinterpret_cast<bf16_t*>(st + orow * 128 + (dd * 32 + r32) * 2) = (bf16_t)(cvtpk(o[2 * half + dd][r], 0.f) & 0xffffu); }
      asm volatile("s_waitcnt lgkmcnt(0)" ::: "memory");
#pragma unroll
      for (int i = 0; i < 4; ++i) { const int row = i * 8 + (lane >> 3), chn = lane & 7; const u32x4 v = *reinterpret_cast<const u32x4*>(st + row * 128 + chn * 16);
        *reinterpret_cast<u32x4*>(Ow + (long)row * DM + half * 64 + chn * 8) = v; }
      asm volatile("s_waitcnt lgkmcnt(0)" ::: "memory"); } }
  __syncthreads();
#undef SLOAD
#undef SWRITE
#undef SWAIT
#undef RESC
}
#undef SBAR
}

constexpr size_t MiB = 1u << 20;
constexpr size_t WS_CTL = 0, CTL_ZERO_BYTES = 1 * MiB;
constexpr size_t WS_MOD = 2 * MiB;
constexpr size_t WS_SCT = 7 * MiB;
constexpr size_t WS_DUMMY = 7 * MiB + 512 * 1024;
constexpr size_t WS_COS = 8 * MiB, WS_SIN = 8 * MiB + 512 * 1024;
constexpr size_t WS_W = 16 * MiB, W_LAYER = 96 * MiB;
constexpr size_t WO_IN = 0, WO_PE = 16 * MiB, WO_UQ = WO_PE + 256 * 1024, WO_UKV = WO_UQ + 1536 * 1024, WO_OUT = WO_UKV + 2 * MiB, WO_UP = WO_OUT + 8 * MiB, WO_DN = WO_UP + 32 * MiB, WO_QA = WO_DN + 32 * MiB;
static_assert(WO_QA + 4 * MiB <= W_LAYER, "weights per layer");
constexpr size_t WS_X = WS_W + DEPTH * W_LAYER;
constexpr size_t WS_H = WS_X + 130 * MiB;
constexpr size_t WS_R = WS_H + 66 * MiB;
constexpr size_t WS_Z = WS_R;
constexpr size_t WS_QN = WS_R + 98 * MiB;
constexpr size_t WS_CKV = WS_R + 115 * MiB;
constexpr size_t WS_KPE = WS_R + 164 * MiB;
constexpr size_t WS_Q = WS_R + 171 * MiB;
constexpr size_t WS_KV = WS_R + 220 * MiB;
constexpr size_t WS_MIX = WS_R + 414 * MiB;
constexpr size_t WS_HB = WS_R;
constexpr size_t WS_ZS = WS_R + 480 * MiB;
constexpr size_t WS_PS = WS_R + 488 * MiB;
constexpr size_t WS_END = WS_R + 496 * MiB;
static_assert((size_t)MR * DM * 4 <= 130 * MiB && (size_t)MR * DM * 2 <= 66 * MiB && (size_t)MR * ZW * 2 <= 98 * MiB && (size_t)MKV * 512 * 2 <= 49 * MiB && (size_t)MKV * 64 * 2 <= 7 * MiB
              && (size_t)MR * NQ * 2 <= 49 * MiB && (size_t)MKV * NKV * 2 <= 194 * MiB && (size_t)MR * DFF * 2 <= 414 * MiB, "d_ws map");
constexpr size_t O_Y = 0, O_CKVP = (size_t)MR * DM, O_KPEP = O_CKVP + (size_t)DEPTH * MP * 512, O_CONVP = O_KPEP + (size_t)DEPTH * MP * 64, O_CKVS = O_CONVP + (size_t)DEPTH * NBP * 2 * 1024,
                 O_KPES = O_CKVS + (size_t)DEPTH * MS * 512, O_CONVS = O_KPES + (size_t)DEPTH * MS * 64, O_END = O_CONVS + (size_t)DEPTH * NBS * 2 * 1024;
static_assert(O_END == 72613888, "output size");
constexpr int CW_BAR = 4096;
constexpr int KVROW_C = MP, KVROW_S = MP + MC;
constexpr int RING_BYTES = 135168;
constexpr int LDSCTL_OFF = RING_BYTES, MISC_OFF = LDSCTL_OFF + 320, LDS_BYTES = RING_BYTES + 1024;
constexpr int NWAVES = 8;
typedef float f32x8v __attribute__((ext_vector_type(8)));

template <int M> __device__ __forceinline__ float swz_xor(float v) { return __int_as_float(__builtin_amdgcn_ds_swizzle(__float_as_int(v), (M << 10) | 0x1f)); }
__device__ __forceinline__ float half_swap_add(float v) { auto rr = __builtin_amdgcn_permlane32_swap(__float_as_uint(v), __float_as_uint(v), false, false); return __uint_as_float(rr[0]) + __uint_as_float(rr[1]); }
__device__ __forceinline__ float half_swap_max(float v) { auto rr = __builtin_amdgcn_permlane32_swap(__float_as_uint(v), __float_as_uint(v), false, false); return fmaxf(__uint_as_float(rr[0]), __uint_as_float(rr[1])); }
__device__ __forceinline__ float wave_sum(float v) {
    v += swz_xor<1>(v); v += swz_xor<2>(v); v += swz_xor<4>(v); v += swz_xor<8>(v); v += swz_xor<16>(v);
    return half_swap_add(v);
}
__device__ __forceinline__ float wave_max(float v) {
    v = fmaxf(v, swz_xor<1>(v)); v = fmaxf(v, swz_xor<2>(v)); v = fmaxf(v, swz_xor<4>(v)); v = fmaxf(v, swz_xor<8>(v)); v = fmaxf(v, swz_xor<16>(v));
    return half_swap_max(v);
}
__device__ __forceinline__ float bf_lo(unsigned w) { return __uint_as_float(w << 16); }
__device__ __forceinline__ float bf_hi(unsigned w) { return __uint_as_float(w & 0xffff0000u); }
__device__ __forceinline__ unsigned pkbf(float lo, float hi) { return pg8::cvt_pk_bf16(lo, hi); }
__device__ __forceinline__ int row_batch(int row) { return row < MP ? (row >> 11) : NBP + ((row - MP) >> 4); }
__device__ __forceinline__ int row_pos(int row) { return row < MP ? (row & (SEQ - 1)) : PAST + ((row - MP) & (TS - 1)); }

struct TrItem { const float* src; bf16* dst; int N, K; };
__device__ __forceinline__ TrItem tr_item(const float* W, int K, int N, int src_col0, bf16* WT, int dst_row0, int kb, int lane) {
    TrItem d; d.src = W + (size_t)(64 * kb + (lane >> 5)) * N + src_col0 + (lane & 31); d.dst = WT + (size_t)dst_row0 * K + 64 * kb; d.N = N; d.K = K; return d; }
__device__ __forceinline__ void tr_load(const TrItem& d, float (&wv)[32]) {
#pragma unroll
    for (int i = 0; i < 32; ++i) wv[i] = d.src[(size_t)(2 * i) * d.N];
}
__device__ __forceinline__ void tr_store(const TrItem& d, const float (&wv)[32], LAS float* scr, int lane) {
#pragma unroll
    for (int i = 0; i < 32; ++i) scr[(2 * i + (lane >> 5)) * 33 + (lane & 31)] = wv[i];
    LDS_WAIT(); asm volatile("" ::: "memory");
    const int c = lane & 7;
#pragma unroll
    for (int j = 0; j < 4; ++j) { const int n = (lane >> 3) + 8 * j; const LAS float* s = scr + (8 * c) * 33 + n;
        v4u o; o.x = pkbf(s[0 * 33], s[1 * 33]); o.y = pkbf(s[2 * 33], s[3 * 33]); o.z = pkbf(s[4 * 33], s[5 * 33]); o.w = pkbf(s[6 * 33], s[7 * 33]);
        *(GAS v4u*)(d.dst + (size_t)n * d.K + 8 * c) = o; }
    LDS_WAIT(); asm volatile("" ::: "memory");
}
__device__ __forceinline__ int win_src_col(int v0) {
    if (v0 < 1024) return v0;
    if (v0 < 3072) { const int t = v0 - 1024, j = t >> 8, r = t & 255; return r < 128 ? 2112 + 128 * j + r : 3136 + 128 * j + (r - 128); }
    return 1088 + (v0 - 3072);
}
constexpr int IT_IN = 32 * 128, IT_PE = 32 * 2, IT_UQ = 8 * 48, IT_UKV = 8 * 64, IT_OUT = 32 * 64, IT_UP = 32 * 256, IT_DN = 128 * 64;
constexpr int IT_LAYER = IT_IN + IT_PE + IT_UQ + IT_UKV + IT_OUT + IT_UP + IT_DN;
__device__ __forceinline__ void p0_prep(const float* w_in, const float* w_uq, const float* w_ukv, const float* w_out, const float* w_up, const float* w_down, const float* c_p, const float* c_s, unsigned char* ws, LAS unsigned char* lds, int tid, int lane, int wave, int vcu, int G) {
    LAS float* scr = (LAS float*)(lds + wave * 16384);
    const int gw = vcu * NWAVES + wave, NGW = G * NWAVES;
    auto decode = [&](int it) -> TrItem {
        const int l = it / IT_LAYER; int r = it % IT_LAYER;
        unsigned char* wl = ws + WS_W + (size_t)l * W_LAYER;
        if (r < IT_IN) { const int kb = r / 128, nb = r % 128; return tr_item(w_in + (size_t)l * DM * INC, DM, INC, win_src_col(32 * nb), (bf16*)(wl + WO_IN), 32 * nb, kb, lane); } r -= IT_IN;
        if (r < IT_PE) { const int kb = r / 2, nb = r % 2; return tr_item(w_in + (size_t)l * DM * INC, DM, INC, 1024 + 32 * nb, (bf16*)(wl + WO_PE), 32 * nb, kb, lane); } r -= IT_PE;
        if (r < IT_UQ) { const int kb = r / 48, nb = r % 48; return tr_item(w_uq + (size_t)l * QLR * NQ, QLR, NQ, 32 * nb, (bf16*)(wl + WO_UQ), 32 * nb, kb, lane); } r -= IT_UQ;
        if (r < IT_UKV) { const int kb = r / 64, nb = r % 64; return tr_item(w_ukv + (size_t)l * KVLR * NKV, KVLR, NKV, 32 * nb, (bf16*)(wl + WO_UKV), 32 * nb, kb, lane); } r -= IT_UKV;
        if (r < IT_OUT) { const int kb = r / 64, nb = r % 64; return tr_item(w_out + (size_t)l * DM * DM, DM, DM, 32 * nb, (bf16*)(wl + WO_OUT), 32 * nb, kb, lane); } r -= IT_OUT;
        if (r < IT_UP) { const int kb = r / 256, nb = r % 256; return tr_item(w_up + (size_t)l * DM * DFF, DM, DFF, 32 * nb, (bf16*)(wl + WO_UP), 32 * nb, kb, lane); } r -= IT_UP;
        const int kb = r / 64, nb = r % 64; return tr_item(w_down + (size_t)l * DFF * DM, DFF, DM, 32 * nb, (bf16*)(wl + WO_DN), 32 * nb, kb, lane);
    };
    { int it = gw; float wa[32], wb[32]; TrItem cur, nxt;
      if (it < DEPTH * IT_LAYER) { cur = decode(it); tr_load(cur, wa); }
      while (it < DEPTH * IT_LAYER) {
          const int itn = it + NGW; const bool hn = itn < DEPTH * IT_LAYER;
          if (hn) { nxt = decode(itn); tr_load(nxt, wb); }
          tr_store(cur, wa, scr, lane);
          if (hn) {
#pragma unroll
              for (int i = 0; i < 32; ++i) wa[i] = wb[i];
              cur = nxt; }
          it = itn;
      }
    }
    const int gt = (vcu * NWAVES + wave) * 64 + lane, NGT = NGW * 64;
    float* sct = (float*)(ws + WS_SCT);
    for (int i = gt; i < NB * DM; i += NGT) { const int b = i / DM, k = i % DM; const float c = b < NBP ? c_p[b * DM + k] : c_s[(b - NBP) * DM + k];
        sct[k * 32 + b] = c / (1.0f + __expf(-c)); }
    for (int i = gt; i < DM * 8; i += NGT) sct[(i >> 3) * 32 + NB + (i & 7)] = 0.f;
    float* cosT = (float*)(ws + WS_COS); float* sinT = (float*)(ws + WS_SIN);
    for (int i = gt; i < NPOS * 32; i += NGT) { const int pos = i >> 5, fi = i & 31;
        double inv_d = 1.0; for (int q = 0; q < fi; ++q) inv_d *= 0.74989420933245582730;
        const float inv_f = (float)inv_d; const float ang = __fmul_rn((float)pos, inv_f);
        const double rev4 = (double)ang * 0.63661977236758134308;
        const double qd = __builtin_rint(rev4); const double y = (rev4 - qd) * 1.57079632679489661923;
        const double y2 = y * y;
        const double sy = y * (1.0 + y2 * (-1.0 / 6 + y2 * (1.0 / 120 + y2 * (-1.0 / 5040 + y2 * (1.0 / 362880 + y2 * (-1.0 / 39916800 + y2 * (1.0 / 6227020800.0)))))));
        const double cy = 1.0 + y2 * (-0.5 + y2 * (1.0 / 24 + y2 * (-1.0 / 720 + y2 * (1.0 / 40320 + y2 * (-1.0 / 3628800 + y2 * (1.0 / 479001600.0 + y2 * (-1.0 / 87178291200.0)))))));
        const int qi = ((int)qd) & 3;
        const double cv = qi == 0 ? cy : qi == 1 ? -sy : qi == 2 ? -cy : sy;
        const double sv = qi == 0 ? sy : qi == 1 ? cy : qi == 2 ? -sy : -cy;
        cosT[i] = (float)cv; sinT[i] = (float)sv; }
}
__device__ __forceinline__ void p1_mod(const float* w_ada, const float* b_ada, unsigned char* ws, LAS unsigned char* lds, int tid, int lane, int wave, int vcu, int G) {
    typedef float f32x16m __attribute__((ext_vector_type(16)));
    const float* sct = (const float*)(ws + WS_SCT); float* mod = (float*)(ws + WS_MOD);
    LAS float* Sl = (LAS float*)lds;
    const int n = lane & 31, kk = lane >> 5, ch = wave & 1, ks = wave >> 1;
    for (int it = (G == 256 ? ((vcu & 3) < 3 ? (vcu >> 2) * 3 + (vcu & 3) : DEPTH * (MODW / 256)) : vcu); it < DEPTH * (MODW / 256); it += G) {
        const int l = it / (MODW / 256), n0 = 256 * (it % (MODW / 256));
        f32x16m acc[4] = {};
        for (int q = 0; q < 4; ++q) {
            __syncthreads();
            { const GAS f32x4* src = (const GAS f32x4*)(sct + (size_t)q * 512 * 32) + tid; LAS f32x4* dst = (LAS f32x4*)Sl + tid;
#pragma unroll
              for (int j = 0; j < 8; ++j) dst[512 * j] = src[512 * j]; }
            __syncthreads();
            const float* wp = w_ada + ((size_t)l * DM + 512 * q + 128 * ks + kk) * MODW + n0 + 128 * ch + 4 * n;
            const LAS float* sp = Sl + (128 * ks + kk) * 32 + n;
#pragma unroll 1
            for (int i0 = 0; i0 < 64; i0 += 16) {
                f32x4 wv[16];
#pragma unroll
                for (int j = 0; j < 16; ++j) wv[j] = *(const GAS f32x4*)(wp + (size_t)(2 * (i0 + j)) * MODW);
                __builtin_amdgcn_sched_barrier(0);
#pragma unroll
                for (int j = 0; j < 16; ++j) { const float a = sp[2 * (i0 + j) * 32];
                    acc[0] = __builtin_amdgcn_mfma_f32_32x32x2f32(a, wv[j].x, acc[0], 0, 0, 0); acc[1] = __builtin_amdgcn_mfma_f32_32x32x2f32(a, wv[j].y, acc[1], 0, 0, 0);
                    acc[2] = __builtin_amdgcn_mfma_f32_32x32x2f32(a, wv[j].z, acc[2], 0, 0, 0); acc[3] = __builtin_amdgcn_mfma_f32_32x32x2f32(a, wv[j].w, acc[3], 0, 0, 0); }
            }
        }
        __syncthreads();
        LAS float* red = (LAS float*)lds;
#pragma unroll
        for (int t = 0; t < 4; ++t)
#pragma unroll
            for (int r = 0; r < 16; ++r) red[((wave * 4 + t) * 16 + r) * 64 + lane] = acc[t][r];
        __syncthreads();
        for (int i = tid; i < 8192; i += NWAVES * 64) { const int cch = i >> 12, t = (i >> 10) & 3, r = (i >> 6) & 15, L = i & 63; const int bb = (r & 3) + 8 * (r >> 2) + 4 * (L >> 5), c = n0 + 128 * cch + 4 * (L & 31) + t;
            if (bb < NB) { float sum = b_ada[(size_t)l * MODW + c];
#pragma unroll
                for (int k4 = 0; k4 < 4; ++k4) sum += red[(((2 * k4 + cch) * 4 + t) * 16 + r) * 64 + L];
                mod[((size_t)l * NB + bb) * MODW + c] = sum; } }
    }
    __syncthreads();
}
__device__ __forceinline__ void unpk8f(const v4u& w, f32x4& a, f32x4& b) {
    a = (f32x4){bf_lo(w.x), bf_hi(w.x), bf_lo(w.y), bf_hi(w.y)}; b = (f32x4){bf_lo(w.z), bf_hi(w.z), bf_lo(w.w), bf_hi(w.w)};
}
template <bool F32IN> __device__ __forceinline__ void norm_load(const void* xb, int row, int lane, f32x4 (&v)[8]) {
    if (F32IN) { const GAS f32x4* x4 = (const GAS f32x4*)((const float*)xb + (size_t)row * DM) + 2 * lane;
#pragma unroll
        for (int j = 0; j < 4; ++j) { v[2 * j] = x4[128 * j]; v[2 * j + 1] = x4[128 * j + 1]; } }
    else { const GAS v4u* x8 = (const GAS v4u*)((const bf16*)xb + (size_t)row * DM) + lane;
#pragma unroll
        for (int j = 0; j < 4; ++j) { const v4u w = x8[64 * j]; unpk8f(w, v[2 * j], v[2 * j + 1]); } }
}
template <bool F32IN> __device__ __forceinline__ void norm_rows(const void* xb, const float* modl, int sh_off, int sc_off, bf16* H, int lane, int gw, int NGW) {
    for (int r0 = gw * 8; r0 < MP; r0 += NGW * 8) {
        const int b = r0 >> 11;
        const GAS f32x4* sc4 = (const GAS f32x4*)(modl + (size_t)b * MODW + sc_off) + 2 * lane; const GAS f32x4* sh4 = (const GAS f32x4*)(modl + (size_t)b * MODW + sh_off) + 2 * lane;
        f32x4 sc[8], sh[8];
#pragma unroll
        for (int j = 0; j < 4; ++j) { sc[2 * j] = sc4[128 * j] + 1.f; sc[2 * j + 1] = sc4[128 * j + 1] + 1.f; sh[2 * j] = sh4[128 * j]; sh[2 * j + 1] = sh4[128 * j + 1]; }
        if constexpr (!F32IN) {
            const GAS v4u* x8 = (const GAS v4u*)((const bf16*)xb + (size_t)r0 * DM) + lane;
            v4u raw[4][4];
#pragma unroll
            for (int d = 0; d < 4; ++d)
#pragma unroll
                for (int j = 0; j < 4; ++j) raw[d][j] = x8[256 * d + 64 * j];
#pragma unroll
            for (int i = 0; i < 8; ++i) {
                f32x4 cur[8];
#pragma unroll
                for (int j = 0; j < 4; ++j) unpk8f(raw[i & 3][j], cur[2 * j], cur[2 * j + 1]);
                if (i + 4 < 8) {
#pragma unroll
                    for (int j = 0; j < 4; ++j) raw[i & 3][j] = x8[256 * (i + 4) + 64 * j]; }
                float s = 0.f;
#pragma unroll
                for (int j = 0; j < 8; ++j) s += (cur[j].x * cur[j].x + cur[j].y * cur[j].y) + (cur[j].z * cur[j].z + cur[j].w * cur[j].w);
                const float rstd = 1.0f / sqrtf(wave_sum(s) * (1.f / DM) + EPS);
                GAS v4u* o8 = (GAS v4u*)(H + (size_t)(r0 + i) * DM) + lane;
#pragma unroll
                for (int j = 0; j < 4; ++j) { const f32x4 y0 = cur[2 * j] * rstd * sc[2 * j] + sh[2 * j], y1 = cur[2 * j + 1] * rstd * sc[2 * j + 1] + sh[2 * j + 1];
                    v4u o; o.x = pkbf(y0.x, y0.y); o.y = pkbf(y0.z, y0.w); o.z = pkbf(y1.x, y1.y); o.w = pkbf(y1.z, y1.w); o8[64 * j] = o; }
            }
        } else if (true) {
            const GAS f32x4* x4 = (const GAS f32x4*)((const float*)xb + (size_t)r0 * DM) + 2 * lane;
            f32x4 raw[2][8];
#pragma unroll
            for (int d = 0; d < 2; ++d)
#pragma unroll
                for (int j = 0; j < 4; ++j) { raw[d][2 * j] = x4[512 * d + 128 * j]; raw[d][2 * j + 1] = x4[512 * d + 128 * j + 1]; }
#pragma unroll
            for (int i = 0; i < 8; ++i) {
                f32x4 cur[8];
#pragma unroll
                for (int j = 0; j < 8; ++j) cur[j] = raw[i & 1][j];
                if (i + 2 < 8) {
#pragma unroll
                    for (int j = 0; j < 4; ++j) { raw[i & 1][2 * j] = x4[512 * (i + 2) + 128 * j]; raw[i & 1][2 * j + 1] = x4[512 * (i + 2) + 128 * j + 1]; } }
                float s = 0.f;
#pragma unroll
                for (int j = 0; j < 8; ++j) s += (cur[j].x * cur[j].x + cur[j].y * cur[j].y) + (cur[j].z * cur[j].z + cur[j].w * cur[j].w);
                const float rstd = 1.0f / sqrtf(wave_sum(s) * (1.f / DM) + EPS);
                GAS v4u* o8 = (GAS v4u*)(H + (size_t)(r0 + i) * DM) + lane;
#pragma unroll
                for (int j = 0; j < 4; ++j) { const f32x4 y0 = cur[2 * j] * rstd * sc[2 * j] + sh[2 * j], y1 = cur[2 * j + 1] * rstd * sc[2 * j + 1] + sh[2 * j + 1];
                    v4u o; o.x = pkbf(y0.x, y0.y); o.y = pkbf(y0.z, y0.w); o.z = pkbf(y1.x, y1.y); o.w = pkbf(y1.z, y1.w); o8[64 * j] = o; }
            }
        } else {
        f32x4 cur[8], nxt[8];
        norm_load<F32IN>(xb, r0, lane, cur);
#pragma unroll 1
        for (int i = 0; i < 8; ++i) {
            const int row = r0 + i;
            norm_load<F32IN>(xb, i < 7 ? row + 1 : row, lane, nxt);
            float s = 0.f;
#pragma unroll
            for (int j = 0; j < 8; ++j) s += (cur[j].x * cur[j].x + cur[j].y * cur[j].y) + (cur[j].z * cur[j].z + cur[j].w * cur[j].w);
            const float rstd = 1.0f / sqrtf(wave_sum(s) * (1.f / DM) + EPS);
            GAS v4u* o8 = (GAS v4u*)(H + (size_t)row * DM) + lane;
#pragma unroll
            for (int j = 0; j < 4; ++j) { const f32x4 y0 = cur[2 * j] * rstd * sc[2 * j] + sh[2 * j], y1 = cur[2 * j + 1] * rstd * sc[2 * j + 1] + sh[2 * j + 1];
                v4u o; o.x = pkbf(y0.x, y0.y); o.y = pkbf(y0.z, y0.w); o.z = pkbf(y1.x, y1.y); o.w = pkbf(y1.z, y1.w); o8[64 * j] = o; }
#pragma unroll
            for (int j = 0; j < 8; ++j) cur[j] = nxt[j];
        }
        }
    }
}
__device__ __forceinline__ void final_norm_rows(const bf16* XB, const float* gain, float* out, int lane, int gw, int NGW) {
    const GAS f32x4* g4 = (const GAS f32x4*)gain + 2 * lane; f32x4 g[8];
#pragma unroll
    for (int j = 0; j < 4; ++j) { g[2 * j] = g4[128 * j]; g[2 * j + 1] = g4[128 * j + 1]; }
    for (int r0 = gw * 8; r0 < MP; r0 += NGW * 8) {
        f32x4 cur[8], nxt[8];
        norm_load<false>(XB, r0, lane, cur);
#pragma unroll 1
        for (int i = 0; i < 8; ++i) {
            const int row = r0 + i;
            norm_load<false>(XB, i < 7 ? row + 1 : row, lane, nxt);
            float s = 0.f;
#pragma unroll
            for (int j = 0; j < 8; ++j) s += (cur[j].x * cur[j].x + cur[j].y * cur[j].y) + (cur[j].z * cur[j].z + cur[j].w * cur[j].w);
            const float rstd = 1.0f / sqrtf(wave_sum(s) * (1.f / DM) + EPS);
            GAS f32x4* o4 = (GAS f32x4*)(out + (size_t)row * DM) + 2 * lane;
#pragma unroll
            for (int j = 0; j < 4; ++j) { o4[128 * j] = cur[2 * j] * rstd * g[2 * j]; o4[128 * j + 1] = cur[2 * j + 1] * rstd * g[2 * j + 1]; }
#pragma unroll
            for (int j = 0; j < 8; ++j) cur[j] = nxt[j];
        }
    }
}
__device__ __forceinline__ void elt_kpe(const bf16* H, const bf16* WPE, bf16* KPE, const float* cosT, const float* sinT, float* outp, float* outs, LAS unsigned char* lds,
                                        int tid, int lane, int wave, int vcu, int G) {
    typedef float f32x16 __attribute__((ext_vector_type(16)));
    constexpr int PITCH = 1040, WOFF = 64 * PITCH;
    LAS float* red = (LAS float*)lds;
    const int r32 = lane & 31, hi = lane >> 5, rt = wave & 1, ct = (wave >> 1) & 1, kh = wave >> 2;
    for (int it = vcu; it < MP / 64; it += G) {
        const int R0 = 64 * it;
        f32x16 acc = {};
        for (int kc = 0; kc < 4; ++kc) {
#pragma unroll
            for (int j = 0; j < 8; ++j) { const int i = wave + 8 * j;
                const bf16* hsrc = R0 < MP ? H + (size_t)(R0 + i) * DM + 512 * kc + lane * 8 : H + (size_t)MP * DM + ((size_t)(16 * kc + (lane >> 2)) * 256 + (R0 - MP + i)) * 32 + 8 * (lane & 3);
                __builtin_amdgcn_global_load_lds((const unsigned*)hsrc, (LAS unsigned*)(lds + i * PITCH), 16, 0, 0);
                __builtin_amdgcn_global_load_lds((const unsigned*)(WPE + (size_t)i * DM + 512 * kc + lane * 8), (LAS unsigned*)(lds + WOFF + i * PITCH), 16, 0, 0); }
            asm volatile("s_waitcnt vmcnt(0)" ::: "memory");
            __syncthreads();
            const LAS unsigned char* ap = lds + (32 * rt + r32) * PITCH + (256 * kh + 8 * hi) * 2;
            const LAS unsigned char* bp = lds + WOFF + (32 * ct + r32) * PITCH + (256 * kh + 8 * hi) * 2;
#pragma unroll
            for (int s = 0; s < 16; ++s) acc = __builtin_amdgcn_mfma_f32_32x32x16_bf16(*(const LAS bf16x8*)(ap + 32 * s), *(const LAS bf16x8*)(bp + 32 * s), acc, 0, 0, 0);
            __syncthreads();
        }
#pragma unroll
        for (int r = 0; r < 16; ++r) red[(wave * 16 + r) * 64 + lane] = acc[r];
        __syncthreads();
        if (wave < 2) {
#pragma unroll
            for (int r = 0; r < 16; ++r) {
                const float x1 = red[((rt + 0) * 16 + r) * 64 + lane] + red[((rt + 4) * 16 + r) * 64 + lane];
                const float x2 = red[((rt + 2) * 16 + r) * 64 + lane] + red[((rt + 6) * 16 + r) * 64 + lane];
                const int row = R0 + 32 * rt + (r & 3) + 8 * (r >> 2) + 4 * hi, pos = row_pos(row);
                const float cs = cosT[pos * 32 + r32], sn = sinT[pos * 32 + r32];
                const float o1 = x1 * cs - x2 * sn, o2 = x2 * cs + x1 * sn;
                float* of = row < MP ? outp + (size_t)row * 64 : outs + (size_t)(row - MP) * 64;
                of[r32] = o1; of[32 + r32] = o2;
                const size_t kr = row < MP ? (size_t)row : (size_t)KVROW_S + (row - MP);
                KPE[kr * 64 + r32] = (bf16)(pkbf(o1, 0.f) & 0xffffu); KPE[kr * 64 + 32 + r32] = (bf16)(pkbf(o2, 0.f) & 0xffffu); }
        }
        __syncthreads();
    }
}
struct EltRow { v4u q, kv, c0a, c0b, c1a, c1b, c2a, c2b, ba, bb; };
__device__ __forceinline__ EltRow elt_load(const bf16* Z, int row, int lane) {
    const bf16* zr = Z + (size_t)row * ZW; const int t = row & (SEQ - 1), c0 = 16 * lane;
    const bf16* z1 = t >= 1 ? zr - ZW : zr; const bf16* z2 = t >= 2 ? zr - 2 * ZW : zr;
    EltRow r;
    r.q = *(const GAS v4u*)(zr + 8 * lane); r.kv = *(const GAS v4u*)(zr + 512 + 8 * lane);
    r.c0a = *(const GAS v4u*)(zr + 1024 + c0); r.c0b = *(const GAS v4u*)(zr + 1024 + c0 + 8);
    r.c1a = *(const GAS v4u*)(z1 + 1024 + c0); r.c1b = *(const GAS v4u*)(z1 + 1024 + c0 + 8);
    r.c2a = *(const GAS v4u*)(z2 + 1024 + c0); r.c2b = *(const GAS v4u*)(z2 + 1024 + c0 + 8);
    r.ba = *(const GAS v4u*)(zr + 2048 + c0); r.bb = *(const GAS v4u*)(zr + 2048 + c0 + 8);
    return r;
}
__device__ __forceinline__ void unpk8(const v4u& w, float* x) {
#pragma unroll
    for (int i = 0; i < 4; ++i) { x[2 * i] = bf_lo(w[i]); x[2 * i + 1] = bf_hi(w[i]); }
}
__device__ __forceinline__ void elt_rows(const bf16* Z, const float* q_norm, const float* kv_norm, const float* conv_w, const float* conv_norm, const float* state_conv_l,
                                         bf16* QN, bf16* CKV, bf16* MIX, float* ockv_p, float* ockv_s, float* oconv_p, float* oconv_s, const float* ckv_cache_l, int lane, int gw  , int NGW  , int rend = MP  ) {
    (void)state_conv_l; (void)ockv_s; (void)oconv_s; (void)ckv_cache_l;
    if (gw >= rend) return;
    const int c0 = 16 * lane;
    const f32x4 qg0 = *(const GAS f32x4*)(q_norm + 8 * lane), qg1 = *(const GAS f32x4*)(q_norm + 8 * lane + 4);
    const f32x4 kg0 = *(const GAS f32x4*)(kv_norm + 8 * lane), kg1 = *(const GAS f32x4*)(kv_norm + 8 * lane + 4);
    EltRow cur = elt_load(Z, gw, lane);
    for (int row = gw; row < rend; row += NGW) {
        const int nrow = row + NGW < rend ? row + NGW : row;
        const EltRow nxt = elt_load(Z, nrow, lane);
        const int t = row & (SEQ - 1), b = row >> 11;
        { float x[8]; unpk8(cur.q, x); float s = 0.f;
#pragma unroll
          for (int i = 0; i < 8; ++i) s += x[i] * x[i];
          const float rstd = 1.0f / sqrtf(wave_sum(s) * (1.f / QLR) + EPS);
          v4u o; o.x = pkbf(x[0] * rstd * qg0.x, x[1] * rstd * qg0.y); o.y = pkbf(x[2] * rstd * qg0.z, x[3] * rstd * qg0.w); o.z = pkbf(x[4] * rstd * qg1.x, x[5] * rstd * qg1.y); o.w = pkbf(x[6] * rstd * qg1.z, x[7] * rstd * qg1.w);
          *(GAS v4u*)(QN + (size_t)row * QLR + 8 * lane) = o; }
        { float x[8]; unpk8(cur.kv, x); float s = 0.f;
#pragma unroll
          for (int i = 0; i < 8; ++i) s += x[i] * x[i];
          const float rstd = 1.0f / sqrtf(wave_sum(s) * (1.f / KVLR) + EPS);
          const f32x4 y0 = {x[0] * rstd * kg0.x, x[1] * rstd * kg0.y, x[2] * rstd * kg0.z, x[3] * rstd * kg0.w}, y1 = {x[4] * rstd * kg1.x, x[5] * rstd * kg1.y, x[6] * rstd * kg1.z, x[7] * rstd * kg1.w};
          float* of = ockv_p + (size_t)row * KVLR;
          *(GAS f32x4*)(of + 8 * lane) = y0; *(GAS f32x4*)(of + 8 * lane + 4) = y1;
          v4u o; o.x = pkbf(y0.x, y0.y); o.y = pkbf(y0.z, y0.w); o.z = pkbf(y1.x, y1.y); o.w = pkbf(y1.z, y1.w);
          *(GAS v4u*)(CKV + (size_t)row * KVLR + 8 * lane) = o; }
        { float cu[16], f1[16], f0[16], gb[16];
          unpk8(cur.c0a, cu); unpk8(cur.c0b, cu + 8); unpk8(cur.c1a, f1); unpk8(cur.c1b, f1 + 8); unpk8(cur.c2a, f0); unpk8(cur.c2b, f0 + 8); unpk8(cur.ba, gb); unpk8(cur.bb, gb + 8);
          const float m1 = t >= 1 ? 1.f : 0.f, m0 = t >= 2 ? 1.f : 0.f;
          float o[16]; float s = 0.f;
#pragma unroll
          for (int i = 0; i < 16; ++i) { const float y = conv_w[c0 + i] * (f0[i] * m0) + conv_w[DCONV + c0 + i] * (f1[i] * m1) + conv_w[2 * DCONV + c0 + i] * cu[i]; o[i] = gb[i] * y; s += o[i] * o[i]; }
          const float rstd = 1.0f / sqrtf(wave_sum(s) * (1.f / DCONV) + EPS);
          v4u p0, p1;
#pragma unroll
          for (int i = 0; i < 4; ++i) { p0[i] = pkbf(o[2 * i] * rstd * conv_norm[c0 + 2 * i], o[2 * i + 1] * rstd * conv_norm[c0 + 2 * i + 1]);
                                        p1[i] = pkbf(o[8 + 2 * i] * rstd * conv_norm[c0 + 8 + 2 * i], o[8 + 2 * i + 1] * rstd * conv_norm[c0 + 8 + 2 * i + 1]); }
          *(GAS v4u*)(MIX + (size_t)row * DM + DATT + c0) = p0; *(GAS v4u*)(MIX + (size_t)row * DM + DATT + c0 + 8) = p1;
          if (t >= SEQ - 2) { float* oc = oconv_p + ((size_t)b * 2 + (t - (SEQ - 2))) * DCONV + c0;
#pragma unroll
            for (int i = 0; i < 4; ++i) *(GAS f32x4*)(oc + 4 * i) = (f32x4){cu[4 * i], cu[4 * i + 1], cu[4 * i + 2], cu[4 * i + 3]}; }
        }
        cur = nxt;
    }
}
__device__ __forceinline__ void elt_cache(const float* kpe_l, bf16* KPE, int gt, int NGT) {
    constexpr int N2 = MC * 64 / 8;
    for (int i = gt; i < N2; i += NGT) { const f32x8v x = *(const GAS f32x8v*)(kpe_l + (size_t)i * 8);
        v4u o; o.x = pkbf(x[0], x[1]); o.y = pkbf(x[2], x[3]); o.z = pkbf(x[4], x[5]); o.w = pkbf(x[6], x[7]); *(GAS v4u*)(KPE + (size_t)KVROW_C * 64 + (size_t)i * 8) = o; }
}
__device__ __forceinline__ void anorm_rows(bf16* MIX, const float* gain, int lane, int row0, int stride, int rend) {
    float gn[16];
#pragma unroll
    for (int i = 0; i < 4; ++i) { const f32x4 g4 = *(const GAS f32x4*)(gain + 16 * lane + 4 * i); gn[4 * i] = g4.x; gn[4 * i + 1] = g4.y; gn[4 * i + 2] = g4.z; gn[4 * i + 3] = g4.w; }
    if (row0 >= rend) return;
    const size_t rs = (size_t)stride * DM;
    bf16* mr = MIX + (size_t)row0 * DM + 16 * lane;
    v4u a0 = *(const GAS v4u*)mr, a1 = *(const GAS v4u*)(mr + 8), b0 = a0, b1 = a1;
    if (row0 + stride < rend) { b0 = *(const GAS v4u*)(mr + rs); b1 = *(const GAS v4u*)(mr + rs + 8); }
    for (int row = row0; row < rend; row += stride) {
        v4u c0 = b0, c1 = b1;
        if (row + 2 * stride < rend) { c0 = *(const GAS v4u*)(mr + 2 * rs); c1 = *(const GAS v4u*)(mr + 2 * rs + 8); }
        float x[16];
#pragma unroll
        for (int i = 0; i < 4; ++i) { x[2 * i] = bf_lo(a0[i]); x[2 * i + 1] = bf_hi(a0[i]); x[8 + 2 * i] = bf_lo(a1[i]); x[8 + 2 * i + 1] = bf_hi(a1[i]); }
        float s = 0.f;
#pragma unroll
        for (int i = 0; i < 16; ++i) s += x[i] * x[i];
        const float rstd = 1.0f / sqrtf(wave_sum(s) * (1.f / DATT) + EPS);
        v4u p0, p1;
#pragma unroll
        for (int i = 0; i < 4; ++i) { p0[i] = pkbf(x[2 * i] * rstd * gn[2 * i], x[2 * i + 1] * rstd * gn[2 * i + 1]);
                                      p1[i] = pkbf(x[8 + 2 * i] * rstd * gn[8 + 2 * i], x[8 + 2 * i + 1] * rstd * gn[8 + 2 * i + 1]); }
        *(GAS v4u*)mr = p0; *(GAS v4u*)(mr + 8) = p1;
        a0 = b0; a1 = b1; b0 = c0; b1 = c1; mr += rs;
    }
}
__device__ __forceinline__ void sattn_unit(int b, int h, const bf16* Qs  , const bf16* KVb, const bf16* KVn  , const bf16* KPb, bf16* Ob, const float* cosT, const float* sinT, LAS unsigned char* lds, int tid, int lane, int wave) {
    constexpr int NKEY = PAST + TS;
    LAS float* S = (LAS float*)lds; LAS float* invl = (LAS float*)(lds + NKEY * 64);
    const int qi = lane & 15, g = lane >> 4;
    const int qrow0 = MP + b * TS;
    bf16x8 qf[6];
#if defined(SQ_RM) && !defined(SQ_QKB)
    { const bf16* qp = Qs + (size_t)(b * TS + qi) * NQ + h * QKD + 8 * g;
#pragma unroll
      for (int s = 0; s < 6; ++s) qf[s] = *(const bf16x8*)(qp + 32 * s);
#else
    { const bf16* qp = Qs + ((size_t)(h * 6) * 256 + b * TS + qi) * 32 + 8 * g;
#pragma unroll
      for (int s = 0; s < 6; ++s) qf[s] = *(const bf16x8*)(qp + s * 8192);
#endif
      const int pos = PAST + qi; const float* cp = cosT + pos * 32 + 8 * g; const float* sp = sinT + pos * 32 + 8 * g;
      const v4u x1 = *reinterpret_cast<const v4u*>(&qf[4]), x2 = *reinterpret_cast<const v4u*>(&qf[5]); v4u y1, y2;
#pragma unroll
      for (int w = 0; w < 4; ++w) { const float ca = cp[2 * w], cb = cp[2 * w + 1], sa = sp[2 * w], sb = sp[2 * w + 1];
          const float a1 = bf_lo(x1[w]), b1 = bf_hi(x1[w]), a2 = bf_lo(x2[w]), b2 = bf_hi(x2[w]);
          y1[w] = pkbf(a1 * ca - a2 * sa, b1 * cb - b2 * sb); y2[w] = pkbf(a2 * ca + a1 * sa, b2 * cb + b1 * sb); }
      qf[4] = *reinterpret_cast<const bf16x8*>(&y1); qf[5] = *reinterpret_cast<const bf16x8*>(&y2); }
#pragma unroll 1
    for (int i0 = 0; i0 < 16; i0 += 2) {
        bf16x8 kf[2][6];
#pragma unroll
        for (int u = 0; u < 2; ++u) { const int key = 16 * (wave + 8 * (i0 + u)) + qi; const size_t krow = (size_t)KVROW_C + (size_t)b * PAST + key;
            const bf16* kn = KVb + krow * NKV + h * 256 + 8 * g; const bf16* kp = KPb + krow * 64 + 8 * g;
#pragma unroll
            for (int s = 0; s < 4; ++s) kf[u][s] = *(const GAS bf16x8*)(kn + 32 * s);
            kf[u][4] = *(const GAS bf16x8*)kp; kf[u][5] = *(const GAS bf16x8*)(kp + 32); }
#pragma unroll
        for (int u = 0; u < 2; ++u) { const int tt = wave + 8 * (i0 + u); f32x4 acc = {0.f, 0.f, 0.f, 0.f};
#pragma unroll
            for (int s = 0; s < 6; ++s) acc = __builtin_amdgcn_mfma_f32_16x16x32_bf16(kf[u][s], qf[s], acc, 0, 0, 0);
#pragma unroll
            for (int r = 0; r < 4; ++r) S[(16 * tt + 4 * g + r) * 16 + qi] = acc[r] * (ATTN_SCALE * LOG2E); }
    }
    if (wave == 0) {
        const bf16* kn = KVn + ((size_t)(h * 8) * 256 + b * TS + qi) * 32 + 8 * g; const bf16* kp = KPb + ((size_t)KVROW_S + b * TS + qi) * 64 + 8 * g;
        f32x4 acc = {0.f, 0.f, 0.f, 0.f};
#pragma unroll
        for (int s = 0; s < 4; ++s) acc = __builtin_amdgcn_mfma_f32_16x16x32_bf16(*(const GAS bf16x8*)(kn + 8192 * s), qf[s], acc, 0, 0, 0);
#pragma unroll
        for (int s = 0; s < 2; ++s) acc = __builtin_amdgcn_mfma_f32_16x16x32_bf16(*(const GAS bf16x8*)(kp + 32 * s), qf[4 + s], acc, 0, 0, 0);
#pragma unroll
        for (int r = 0; r < 4; ++r) S[(PAST + 4 * g + r) * 16 + qi] = acc[r] * (ATTN_SCALE * LOG2E);
    }
    __syncthreads();
    for (int q = 2 * wave; q < 2 * wave + 2; ++q) {
        float m = -INFINITY;
        for (int k = lane; k < NKEY; k += 64) m = fmaxf(m, S[k * 16 + q]);
        m = wave_max(m);
        float s = 0.f;
        for (int k = lane; k < NKEY; k += 64) { const float p = __builtin_amdgcn_exp2f(S[k * 16 + q] - m); S[k * 16 + q] = p; s += p; }
        s = wave_sum(s);
        if (lane == 0) invl[q] = 1.0f / s;
    }
    __syncthreads();
    { const int vc4 = tid & 31, ks = tid >> 5;
      float o[16][4];
#pragma unroll
      for (int q = 0; q < 16; ++q)
#pragma unroll
          for (int c = 0; c < 4; ++c) o[q][c] = 0.f;
#define SPV_FMA(W_, KEY_) do { float v[4]; v[0] = bf_lo((unsigned)(W_)); v[1] = bf_hi((unsigned)(W_)); v[2] = bf_lo((unsigned)((W_) >> 32)); v[3] = bf_hi((unsigned)((W_) >> 32)); \
          const LAS f32x4* p4 = (const LAS f32x4*)(S + (KEY_) * 16); \
          _Pragma("unroll") for (int qq = 0; qq < 4; ++qq) { const f32x4 p = p4[qq]; \
              _Pragma("unroll") for (int c = 0; c < 4; ++c) { o[4 * qq][c] = fmaf(p.x, v[c], o[4 * qq][c]); o[4 * qq + 1][c] = fmaf(p.y, v[c], o[4 * qq + 1][c]); o[4 * qq + 2][c] = fmaf(p.z, v[c], o[4 * qq + 2][c]); o[4 * qq + 3][c] = fmaf(p.w, v[c], o[4 * qq + 3][c]); } } } while (0)
      {
        const __amdgpu_buffer_rsrc_t rs = __builtin_amdgcn_make_buffer_rsrc((void*)KVb, 0, (unsigned)((size_t)MKV * NKV * 2), 0x00020000);
        const unsigned voff = (unsigned)((ks * NKV + 4 * vc4) * 2);
        const unsigned sb0 = (unsigned)((((size_t)KVROW_C + (size_t)b * PAST) * NKV + h * 256 + 128) * 2);
        typedef unsigned u32x2v __attribute__((ext_vector_type(2)));
#pragma unroll 1
        for (int i0 = 0; i0 < 128; i0 += 4) {
            unsigned long long w[4];
#pragma unroll
            for (int u = 0; u < 4; ++u) w[u] = __builtin_bit_cast(unsigned long long, __builtin_amdgcn_raw_buffer_load_b64(rs, voff, sb0 + (unsigned)(16 * (i0 + u)) * (NKV * 2), 0));
#pragma unroll
            for (int u = 0; u < 4; ++u) { SPV_FMA(w[u], ks + 16 * (i0 + u)); if (u & 1) __builtin_amdgcn_sched_barrier(0); }
        }
        int vcl = vc4; asm volatile("" : "+v"(vcl));
        const unsigned long long wn = *(const GAS unsigned long long*)(KVn + ((size_t)(h * 8 + 4 + (vcl >> 3)) * 256 + b * TS + ks) * 32 + ((4 * vcl) & 31));
        SPV_FMA(wn, PAST + ks); }
#undef SPV_FMA
      int ln2; asm volatile("v_mbcnt_lo_u32_b32 %0, -1, 0\n\tv_mbcnt_hi_u32_b32 %0, -1, %0" : "=v"(ln2)); const int tid2 = wave * 64 + ln2, vc4b = tid2 & 31;
#pragma unroll
      for (int q = 0; q < 16; ++q)
#pragma unroll
          for (int c = 0; c < 4; ++c) o[q][c] = half_swap_add(o[q][c]);
      __syncthreads();
      LAS float* red = (LAS float*)lds;
      if (ln2 < 32) {
#pragma unroll
          for (int q = 0; q < 16; ++q) *(LAS f32x4*)(red + (wave * 16 + q) * 128 + 4 * vc4b) = (f32x4){o[q][0], o[q][1], o[q][2], o[q][3]}; }
      const float il = invl[tid2 >> 5];
      __syncthreads();
      { int tl2 = tid2; const int q = tl2 >> 5, c4 = (tl2 & 31) * 4; f32x4 acc = {0.f, 0.f, 0.f, 0.f};
#pragma unroll
        for (int w = 0; w < NWAVES; ++w) acc += *(const LAS f32x4*)(red + (w * 16 + q) * 128 + c4);
        acc = acc * il;
        unsigned long long pk = (unsigned long long)pkbf(acc.x, acc.y) | ((unsigned long long)pkbf(acc.z, acc.w) << 32);
        *(GAS unsigned long long*)(Ob + ((size_t)(4 * h + (c4 >> 5)) * 256 + b * TS + q) * 32 + (c4 & 31)) = pk; }
    }
    __syncthreads();
}

typedef float f32x16v __attribute__((ext_vector_type(16)));
struct SEpiPart {
    float* P; int ldp;
    __device__ __forceinline__ void operator()(const f32x16v& acc, int wave, int r32, int hi, int n0) const {
#pragma unroll
        for (int r = 0; r < 16; ++r) { const int row = 32 * wave + (r & 3) + 8 * (r >> 2) + 4 * hi; P[(size_t)row * ldp + n0 + r32] = acc[r]; }
    }
};
template <int ACT> struct SEpiBf {
    bf16* O; int badd = 0;
    __device__ __forceinline__ void operator()(const f32x16v& acc, int wave, int r32, int hi, int n0) const {
        bf16* ob = O + (size_t)((n0 >> 5) + badd) * (256 * 32) + r32;
#pragma unroll
        for (int r = 0; r < 16; ++r) { const int row = 32 * wave + (r & 3) + 8 * (r >> 2) + 4 * hi; float v = acc[r]; if (ACT == 1) { v = v > 0.f ? v : 0.f; v = v * v; }
            ob[row * 32] = (bf16)(pkbf(v, 0.f) & 0xffffu); }
    }
};
__device__ __forceinline__ size_t kb32(int row, int k) { return ((size_t)(k >> 5) * 256 + row) * 32 + (k & 31); }
template <class Epi> __device__ __forceinline__ void sgemm_unit(LAS unsigned char* lds, const bf16* A  , const bf16* Bt, int ldb, int n0, int k0, int Kc, const Epi& E, int lane, int wave) {
    const int r32 = lane & 31, hi = lane >> 5;
    const int rowB = Kc * 2 + 16, cpr = Kc / 512;
    const __amdgpu_buffer_rsrc_t arsrc = __builtin_amdgcn_make_buffer_rsrc((void*)A, 0, 0x7fffffff, 0x00020000);
    const unsigned avoff = (unsigned)((r32 * 32 + 8 * hi) * 2);
    const unsigned asoff = (unsigned)((((k0 >> 5) * 256 + 32 * wave) * 32) * 2);
#define SG_ALOAD(i) __builtin_bit_cast(bf16x8, __builtin_amdgcn_raw_buffer_load_b128(arsrc, avoff, asoff + (unsigned)(((i) >> 1) * 16384 + ((i) & 1) * 32), 0))
    bf16x8 a0[8], a1[8];
#pragma unroll
    for (int i = 0; i < 8; ++i) a0[i] = SG_ALOAD(i);
    for (int ch = wave; ch < 32 * cpr; ch += NWAVES) { const int c = ch / cpr, qd = ch % cpr;
        __builtin_amdgcn_global_load_lds((const unsigned*)(Bt + (size_t)(n0 + c) * ldb + k0 + qd * 512 + lane * 8), (LAS unsigned*)(lds + c * rowB + qd * 1024), 16, 0, 0); }
    asm volatile("s_waitcnt vmcnt(0)" ::: "memory");
    __syncthreads();
    f32x16v acc = {};
    const LAS unsigned char* Bp = lds + r32 * rowB + 16 * hi;
    for (int s = 0; s < Kc / 16; s += 16) {
#pragma unroll
        for (int i = 0; i < 8; ++i) a1[i] = SG_ALOAD(s + 8 + i);
#pragma unroll
        for (int i = 0; i < 8; ++i) acc = __builtin_amdgcn_mfma_f32_32x32x16_bf16(a0[i], *(const LAS bf16x8*)(Bp + 32 * (s + i)), acc, 0, 0, 0);
        if (s + 16 < Kc / 16) {
#pragma unroll
            for (int i = 0; i < 8; ++i) a0[i] = SG_ALOAD(s + 16 + i); }
#pragma unroll
        for (int i = 0; i < 8; ++i) acc = __builtin_amdgcn_mfma_f32_32x32x16_bf16(a1[i], *(const LAS bf16x8*)(Bp + 32 * (s + 8 + i)), acc, 0, 0, 0);
    }
    E(acc, wave, r32, hi, n0);
#undef SG_ALOAD
    __syncthreads();
}
__device__ __forceinline__ void elt_rows_s(const float* ZS, const float* q_norm, const float* kv_norm, const float* conv_w, const float* conv_norm, const float* state_conv_l,
                                           bf16* QNs, bf16* CKVs, bf16* MIXs  , float* ockv_s, float* oconv_s, int lane, int gw, int NGW,
                                           const float* KS  , bf16* KPEs  , float* okpe_s, const float* cosT, const float* sinT,
                                           int part = -1  ) {
    for (int r = gw; r < MS; r += NGW) {
        const int t = r & (TS - 1), b = r >> 4;
        if (lane < 32 && (part < 0 || part == 0)) {
            const float* k0 = KS + (size_t)r * 64; const float* k1 = k0 + (size_t)MS * 64; const float* k2 = k1 + (size_t)MS * 64; const float* k3 = k2 + (size_t)MS * 64;
            const float x1 = (k0[lane] + k1[lane]) + (k2[lane] + k3[lane]), x2 = (k0[32 + lane] + k1[32 + lane]) + (k2[32 + lane] + k3[32 + lane]);
            const float cs = cosT[(PAST + t) * 32 + lane], sn = sinT[(PAST + t) * 32 + lane];
            const float o1 = x1 * cs - x2 * sn, o2 = x2 * cs + x1 * sn;
            okpe_s[(size_t)r * 64 + lane] = o1; okpe_s[(size_t)r * 64 + 32 + lane] = o2;
            KPEs[(size_t)r * 64 + lane] = (bf16)(pkbf(o1, 0.f) & 0xffffu); KPEs[(size_t)r * 64 + 32 + lane] = (bf16)(pkbf(o2, 0.f) & 0xffffu); }
        const float* z0 = ZS + (size_t)r * 4096; const float* z1 = z0 + (size_t)MS * 4096;
        if (part < 0 || part == 1) {
            const f32x4 a0 = *(const GAS f32x4*)(z0 + 8 * lane) + *(const GAS f32x4*)(z1 + 8 * lane), a1 = *(const GAS f32x4*)(z0 + 8 * lane + 4) + *(const GAS f32x4*)(z1 + 8 * lane + 4);
            const float s = (a0.x * a0.x + a0.y * a0.y) + (a0.z * a0.z + a0.w * a0.w) + (a1.x * a1.x + a1.y * a1.y) + (a1.z * a1.z + a1.w * a1.w);
            const float rstd = 1.0f / sqrtf(wave_sum(s) * (1.f / QLR) + EPS);
            const f32x4 g0 = *(const GAS f32x4*)(q_norm + 8 * lane), g1 = *(const GAS f32x4*)(q_norm + 8 * lane + 4);
            v4u o; o.x = pkbf(a0.x * rstd * g0.x, a0.y * rstd * g0.y); o.y = pkbf(a0.z * rstd * g0.z, a0.w * rstd * g0.w); o.z = pkbf(a1.x * rstd * g1.x, a1.y * rstd * g1.y); o.w = pkbf(a1.z * rstd * g1.z, a1.w * rstd * g1.w);
            *(GAS v4u*)(QNs + kb32(r, 8 * lane)) = o; }
        if (part < 0 || part == 2) {
            const f32x4 a0 = *(const GAS f32x4*)(z0 + 512 + 8 * lane) + *(const GAS f32x4*)(z1 + 512 + 8 * lane), a1 = *(const GAS f32x4*)(z0 + 512 + 8 * lane + 4) + *(const GAS f32x4*)(z1 + 512 + 8 * lane + 4);
            const float s = (a0.x * a0.x + a0.y * a0.y) + (a0.z * a0.z + a0.w * a0.w) + (a1.x * a1.x + a1.y * a1.y) + (a1.z * a1.z + a1.w * a1.w);
            const float rstd = 1.0f / sqrtf(wave_sum(s) * (1.f / KVLR) + EPS);
            const f32x4 g0 = *(const GAS f32x4*)(kv_norm + 8 * lane), g1 = *(const GAS f32x4*)(kv_norm + 8 * lane + 4);
            const f32x4 y0 = a0 * rstd * g0, y1 = a1 * rstd * g1;
            *(GAS f32x4*)(ockv_s + (size_t)r * KVLR + 8 * lane) = y0; *(GAS f32x4*)(ockv_s + (size_t)r * KVLR + 8 * lane + 4) = y1;
            v4u o; o.x = pkbf(y0.x, y0.y); o.y = pkbf(y0.z, y0.w); o.z = pkbf(y1.x, y1.y); o.w = pkbf(y1.z, y1.w);
            *(GAS v4u*)(CKVs + kb32(r, 8 * lane)) = o; }
        if (part < 0 || part == 3) {
            const int c0 = 16 * lane, vC = 1024 + 256 * (c0 >> 7) + (c0 & 127), vU = vC + 128, vB = 3072 + c0;
            float cu[16], f1[16], f0[16], gb[16];
#pragma unroll
            for (int i = 0; i < 16; ++i) { cu[i] = (z0[vC + i] + z1[vC + i]) * (z0[vU + i] + z1[vU + i]); gb[i] = z0[vB + i] + z1[vB + i]; }
            if (t >= 1) {
#pragma unroll
                for (int i = 0; i < 16; ++i) f1[i] = (z0[vC + i - 4096] + z1[vC + i - 4096]) * (z0[vU + i - 4096] + z1[vU + i - 4096]); }
            else {
#pragma unroll
                for (int i = 0; i < 16; ++i) f1[i] = state_conv_l[((size_t)b * 2 + 1) * DCONV + c0 + i]; }
            if (t >= 2) {
#pragma unroll
                for (int i = 0; i < 16; ++i) f0[i] = (z0[vC + i - 8192] + z1[vC + i - 8192]) * (z0[vU + i - 8192] + z1[vU + i - 8192]); }
            else {
#pragma unroll
                for (int i = 0; i < 16; ++i) f0[i] = state_conv_l[((size_t)b * 2 + t) * DCONV + c0 + i]; }
            float o[16]; float s = 0.f;
#pragma unroll
            for (int i = 0; i < 16; ++i) { const float y = conv_w[c0 + i] * f0[i] + conv_w[DCONV + c0 + i] * f1[i] + conv_w[2 * DCONV + c0 + i] * cu[i]; o[i] = gb[i] * y; s += o[i] * o[i]; }
            const float rstd = 1.0f / sqrtf(wave_sum(s) * (1.f / DCONV) + EPS);
            v4u p0, p1;
#pragma unroll
            for (int i = 0; i < 4; ++i) { p0[i] = pkbf(o[2 * i] * rstd * conv_norm[c0 + 2 * i], o[2 * i + 1] * rstd * conv_norm[c0 + 2 * i + 1]);
                                          p1[i] = pkbf(o[8 + 2 * i] * rstd * conv_norm[c0 + 8 + 2 * i], o[8 + 2 * i + 1] * rstd * conv_norm[c0 + 8 + 2 * i + 1]); }
            *(GAS v4u*)(MIXs + kb32(r, DATT + c0)) = p0; *(GAS v4u*)(MIXs + kb32(r, DATT + c0 + 8)) = p1;
            if (t >= TS - 2) { float* oc = oconv_s + ((size_t)b * 2 + (t - (TS - 2))) * DCONV + c0;
#pragma unroll
                for (int i = 0; i < 4; ++i) *(GAS f32x4*)(oc + 4 * i) = (f32x4){cu[4 * i], cu[4 * i + 1], cu[4 * i + 2], cu[4 * i + 3]}; }
        }
    }
}
template <bool FINAL> __device__ __forceinline__ void norm_rows_s(const float* xs, float* X, bool first, const float* PS, int np, const float* gatel  ,
                                                                  const float* modl, int sh_off, int sc_off, bf16* H, const float* gain, float* yout, int lane, int gw, int NGW, const float* ssa = nullptr  ) {
    for (int r = gw; r < MS; r += NGW) {
        const int row = MP + r, b = NBP + (r >> 4);
        float ra = 1.f;
        if (ssa) { float t = 0.f;
#pragma unroll
            for (int hh = 0; hh < NH; ++hh) t += ssa[hh * 256 + r];
            ra = 1.0f / sqrtf(t * (1.f / DATT) + EPS); }
        const GAS f32x4* x4 = (const GAS f32x4*)(first ? xs + (size_t)r * DM : X + (size_t)row * DM) + lane;
        f32x4 v[8]; float s = 0.f;
#pragma unroll
        for (int j = 0; j < 8; ++j) { v[j] = x4[64 * j];
            if (np > 0) { f32x4 p = {0.f, 0.f, 0.f, 0.f};
                for (int k = 0; k < np; ++k) { const f32x4 pk = ((const GAS f32x4*)(PS + ((size_t)k * MS + r) * DM) + lane)[64 * j]; p += (k < 2) ? pk * ra : pk; }
                v[j] += ((const GAS f32x4*)(gatel + (size_t)b * MODW) + lane)[64 * j] * p; }
            s += (v[j].x * v[j].x + v[j].y * v[j].y) + (v[j].z * v[j].z + v[j].w * v[j].w); }
        if (!FINAL && (np > 0 || first)) { GAS f32x4* xc = (GAS f32x4*)(X + (size_t)row * DM) + lane;
#pragma unroll
            for (int j = 0; j < 8; ++j) xc[64 * j] = v[j]; }
        const float rstd = 1.0f / sqrtf(wave_sum(s) * (1.f / DM) + EPS);
        if (FINAL) { const GAS f32x4* g4 = (const GAS f32x4*)gain + lane; GAS f32x4* o4 = (GAS f32x4*)(yout + (size_t)row * DM) + lane;
#pragma unroll
            for (int j = 0; j < 8; ++j) o4[64 * j] = v[j] * rstd * g4[64 * j]; }
        else { const GAS f32x4* sc4 = (const GAS f32x4*)(modl + (size_t)b * MODW + sc_off) + lane; const GAS f32x4* sh4 = (const GAS f32x4*)(modl + (size_t)b * MODW + sh_off) + lane;
#pragma unroll
            for (int j = 0; j < 8; ++j) { const f32x4 sc = sc4[64 * j], sh = sh4[64 * j]; GAS unsigned long long* o8 = (GAS unsigned long long*)(H + kb32(r, 4 * lane + 256 * j));
                const float a = v[j].x * rstd * (1.f + sc.x) + sh.x, bq = v[j].y * rstd * (1.f + sc.y) + sh.y, c = v[j].z * rstd * (1.f + sc.z) + sh.z, d = v[j].w * rstd * (1.f + sc.w) + sh.w;
                *o8 = (unsigned long long)pkbf(a, bq) | ((unsigned long long)pkbf(c, d) << 32); } }
    }
}

template <bool FINAL> __device__ __forceinline__ void norm_rows_s_coop(const float* xs, float* X, bool first, const float* PS, int np, const float* gatel, const float* modl, int sh_off, int sc_off, bf16* H,
                                                                       const float* gain, float* yout, LAS float* red, int lane, int wave, int vcu, int G, const float* ssa = nullptr) {
    for (int r = vcu; r < MS; r += G) {
        const int row = MP + r, b = NBP + (r >> 4), j = wave;
        float ra = 1.f;
        if (ssa) { float t = 0.f;
#pragma unroll
            for (int hh = 0; hh < NH; ++hh) t += ssa[hh * 256 + r];
            ra = 1.0f / sqrtf(t * (1.f / DATT) + EPS); }
        f32x4 v = ((const GAS f32x4*)(first ? xs + (size_t)r * DM : X + (size_t)row * DM) + lane)[64 * j];
        if (np > 0) { f32x4 p = {0.f, 0.f, 0.f, 0.f};
            for (int k = 0; k < np; ++k) { const f32x4 pk = ((const GAS f32x4*)(PS + ((size_t)k * MS + r) * DM) + lane)[64 * j]; p += (k < 2) ? pk * ra : pk; }
            v += ((const GAS f32x4*)(gatel + (size_t)b * MODW) + lane)[64 * j] * p; }
        const float sw = wave_sum((v.x * v.x + v.y * v.y) + (v.z * v.z + v.w * v.w));
        if (lane == 0) red[wave] = sw;
        if (!FINAL && (np > 0 || first)) ((GAS f32x4*)(X + (size_t)row * DM) + lane)[64 * j] = v;
        __syncthreads();
        float s = 0.f;
#pragma unroll
        for (int w = 0; w < NWAVES; ++w) s += red[w];
        const float rstd = 1.0f / sqrtf(s * (1.f / DM) + EPS);
        if (FINAL) ((GAS f32x4*)(yout + (size_t)row * DM) + lane)[64 * j] = v * rstd * ((const GAS f32x4*)gain + lane)[64 * j];
        else { const f32x4 sc = ((const GAS f32x4*)(modl + (size_t)b * MODW + sc_off) + lane)[64 * j], sh = ((const GAS f32x4*)(modl + (size_t)b * MODW + sh_off) + lane)[64 * j];
            const float a = v.x * rstd * (1.f + sc.x) + sh.x, bq = v.y * rstd * (1.f + sc.y) + sh.y, c = v.z * rstd * (1.f + sc.z) + sh.z, d = v.w * rstd * (1.f + sc.w) + sh.w;
            *(GAS unsigned long long*)(H + kb32(r, 4 * lane + 256 * j)) = (unsigned long long)pkbf(a, bq) | ((unsigned long long)pkbf(c, d) << 32); }
        __syncthreads();
    }
}
constexpr size_t WS_SA = WS_KV + 64 * MiB;
constexpr size_t WS_QA = WS_SA, WS_PO = WS_SA + 4 * MiB, WS_PML = WS_SA + 40 * MiB, WS_SSA = WS_SA + 41 * MiB;
constexpr int SCH = 17;
static_assert((size_t)NBS * SCH * 8 * 32 * 256 * 2 <= 36 * MiB && WS_SSA + 8192 <= WS_MIX, "absorbed-attention scratch");
typedef short s16x4v __attribute__((ext_vector_type(4)));
template <int OFF> __device__ __forceinline__ s16x4v sa_tr(int vb) { s16x4v r; asm volatile("ds_read_b64_tr_b16 %0, %1 offset:%2" : "=&v"(r) : "v"(vb), "i"(OFF) : "memory"); return r; }
__device__ __forceinline__ bf16x8 cvt8_f32(const float* p) { const f32x4 a = *(const GAS f32x4*)p, b = *(const GAS f32x4*)(p + 4); v4u o; o.x = pkbf(a.x, a.y); o.y = pkbf(a.z, a.w); o.z = pkbf(b.x, b.y); o.w = pkbf(b.z, b.w);
    return __builtin_bit_cast(bf16x8, o); }
__device__ __forceinline__ void prep_qabs(const float* w_uq, const float* w_ukv, unsigned char* ws, LAS unsigned char* lds, int tid, int lane, int wave, int first, int stride) {
    constexpr int PITCH = 272, BOFF = 128 * PITCH;
    const int i32 = lane & 31, hi = lane >> 5, ct = wave & 3, kq = wave >> 2;
    for (int it = first; it < DEPTH * NH * 8; it += stride) {
        const int kh = it & 1, cq = (it >> 1) & 3, h = (it >> 3) & 7, l = it >> 6;
        __syncthreads();
        { const float* asrc = w_ukv + ((size_t)l * KVLR + 128 * cq) * NKV + h * 256;
          const float* bsrc = w_uq + ((size_t)l * QLR + 256 * kh) * NQ + h * QKD;
          bf16x8 av[4], bv[8];
#pragma unroll
          for (int i = 0; i < 4; ++i) { const int id = tid + 512 * i; av[i] = cvt8_f32(asrc + (size_t)(id >> 4) * NKV + 8 * (id & 15)); }
#pragma unroll
          for (int i = 0; i < 8; ++i) { const int id = tid + 512 * i; bv[i] = cvt8_f32(bsrc + (size_t)(id >> 4) * NQ + 8 * (id & 15)); }
#pragma unroll
          for (int i = 0; i < 4; ++i) { const int id = tid + 512 * i; *(LAS bf16x8*)(lds + (id >> 4) * PITCH + 16 * (id & 15)) = av[i]; }
#pragma unroll
          for (int i = 0; i < 8; ++i) { const int id = tid + 512 * i; *(LAS bf16x8*)(lds + BOFF + (id >> 4) * PITCH + 16 * (id & 15)) = bv[i]; } }
        __syncthreads();
        const LAS unsigned char* ap = lds + (32 * ct + i32) * PITCH + 16 * hi;
        const LAS unsigned char* bp = lds + BOFF + (128 * kq + i32) * PITCH + 16 * hi;
        bf16* o = (bf16*)(ws + WS_W + (size_t)l * W_LAYER + WO_QA) + (size_t)(h * 512 + 128 * cq + 32 * ct) * QLR + 256 * kh + 128 * kq + i32;
#pragma unroll
        for (int kt = 0; kt < 4; ++kt) { f32x16v acc = {};
#pragma unroll
            for (int s = 0; s < 8; ++s) acc = __builtin_amdgcn_mfma_f32_32x32x16_bf16(*(const LAS bf16x8*)(ap + 32 * s), *(const LAS bf16x8*)(bp + kt * 32 * PITCH + 32 * s), acc, 0, 0, 0);
#pragma unroll
            for (int r = 0; r < 16; ++r) o[(size_t)((r & 3) + 8 * (r >> 2) + 4 * hi) * QLR + 32 * kt] = (bf16)(pkbf(acc[r], 0.f) & 0xffffu); }
    }
    __syncthreads();
}
__device__ __forceinline__ void sabs_unit(int b, int ch, const bf16* QAs  , const bf16* CKV, const bf16* KPE, const float* ckv_l  , const float* kpe_l  , const float* cosT, const float* sinT, bf16* PO, float* PML,
                                          LAS unsigned char* lds, int lane, int wave) {
    const int qi = lane & 15, g = lane >> 4, h = wave;
    const bool isnew = ch == SCH - 1;
    __syncthreads();
    bf16x8 qf[18];
    { const bf16* pp = QAs + ((size_t)(128 + 2 * h) * 256 + b * TS + qi) * 32 + 8 * g;
      qf[16] = *(const GAS bf16x8*)pp; qf[17] = *(const GAS bf16x8*)(pp + 8192);
      const int pos = PAST + qi; const float* cp = cosT + pos * 32 + 8 * g; const float* sp = sinT + pos * 32 + 8 * g;
      const v4u x1 = __builtin_bit_cast(v4u, qf[16]), x2 = __builtin_bit_cast(v4u, qf[17]); v4u y1, y2;
#pragma unroll
      for (int w = 0; w < 4; ++w) { const float ca = cp[2 * w], cb = cp[2 * w + 1], sa = sp[2 * w], sb = sp[2 * w + 1];
          const float a1 = bf_lo(x1[w]), b1 = bf_hi(x1[w]), a2 = bf_lo(x2[w]), b2 = bf_hi(x2[w]);
          y1[w] = pkbf(a1 * ca - a2 * sa, b1 * cb - b2 * sb); y2[w] = pkbf(a2 * ca + a1 * sa, b2 * cb + b1 * sb); }
      qf[16] = __builtin_bit_cast(bf16x8, y1); qf[17] = __builtin_bit_cast(bf16x8, y2); }
    f32x4 sc[8];
#pragma unroll
    for (int T = 0; T < 8; ++T) sc[T] = (f32x4){0.f, 0.f, 0.f, 0.f};
    if (!isnew) {
        const float* src = ckv_l + ((size_t)b * PAST + 128 * ch + wave) * KVLR + 8 * lane;
        const float* kf = kpe_l + ((size_t)b * PAST + 128 * ch + qi) * 64 + 8 * g;
        const int cbk = lane >> 4, c16 = lane & 15;
        f32x4 v0[8], v1[8], kq[4][4];
#define SA_SLOAD(HB) do { _Pragma("unroll") for (int j = 0; j < 8; ++j) { const float* p = src + (size_t)(8 * (8 * (HB) + j)) * KVLR; v0[j] = *(const GAS f32x4*)p; v1[j] = *(const GAS f32x4*)(p + 4); } } while (0)
#define SA_SWRITE(HB) do { _Pragma("unroll") for (int j = 0; j < 8; ++j) { const int key = 8 * (8 * (HB) + j) + wave, row = key & 31, xr = ((row & 3) << 2) | ((row >> 2) & 3); \
            v4u o; o.x = pkbf(v0[j].x, v0[j].y); o.y = pkbf(v0[j].z, v0[j].w); o.z = pkbf(v1[j].x, v1[j].y); o.w = pkbf(v1[j].z, v1[j].w); \
            *(LAS v4u*)(lds + ((key >> 5) * 4 + cbk) * 8192 + 256 * row + 16 * (c16 ^ xr)) = o; } } while (0)
#define SA_KLOAD(T0) do { _Pragma("unroll") for (int t = 0; t < 4; ++t) { const float* p = kf + (size_t)(16 * ((T0) + t)) * 64; kq[t][0] = *(const GAS f32x4*)p; kq[t][1] = *(const GAS f32x4*)(p + 4); kq[t][2] = *(const GAS f32x4*)(p + 32); kq[t][3] = *(const GAS f32x4*)(p + 36); } } while (0)
#define SA_KMMA(T0) do { _Pragma("unroll") for (int t = 0; t < 4; ++t) { v4u a, c; a.x = pkbf(kq[t][0].x, kq[t][0].y); a.y = pkbf(kq[t][0].z, kq[t][0].w); a.z = pkbf(kq[t][1].x, kq[t][1].y); a.w = pkbf(kq[t][1].z, kq[t][1].w); \
            c.x = pkbf(kq[t][2].x, kq[t][2].y); c.y = pkbf(kq[t][2].z, kq[t][2].w); c.z = pkbf(kq[t][3].x, kq[t][3].y); c.w = pkbf(kq[t][3].z, kq[t][3].w); \
            sc[(T0) + t] = __builtin_amdgcn_mfma_f32_16x16x32_bf16(__builtin_bit_cast(bf16x8, a), qf[16], sc[(T0) + t], 0, 0, 0); sc[(T0) + t] = __builtin_amdgcn_mfma_f32_16x16x32_bf16(__builtin_bit_cast(bf16x8, c), qf[17], sc[(T0) + t], 0, 0, 0); } } while (0)
        SA_SLOAD(0); SA_KLOAD(0); __builtin_amdgcn_sched_barrier(0);
        SA_SWRITE(0); __builtin_amdgcn_sched_barrier(0);
        SA_SLOAD(1); __builtin_amdgcn_sched_barrier(0);
        SA_KMMA(0); __builtin_amdgcn_sched_barrier(0);
        SA_KLOAD(4); __builtin_amdgcn_sched_barrier(0);
        SA_SWRITE(1); __builtin_amdgcn_sched_barrier(0);
        SA_KMMA(4);
#undef SA_SLOAD
#undef SA_SWRITE
#undef SA_KLOAD
#undef SA_KMMA
    } else {
        const int row = 4 * wave + g; const int chk = (lane & 15) ^ (((row & 3) << 2) | ((row >> 2) & 3));
        const bf16* src = CKV + (size_t)KVROW_S * KVLR + ((size_t)(chk >> 2) * 256 + b * TS + (row & 15)) * 32 + (chk & 3) * 8;
#pragma unroll
        for (int cbk = 0; cbk < 4; ++cbk) __builtin_amdgcn_global_load_lds((const unsigned*)(src + (size_t)cbk * 4 * 8192), (LAS unsigned*)(lds + cbk * 8192 + wave * 1024), 16, 0, 0);
        const bf16* kp = KPE + ((size_t)KVROW_S + b * TS + qi) * 64 + 8 * g;
        sc[0] = __builtin_amdgcn_mfma_f32_16x16x32_bf16(*(const GAS bf16x8*)kp, qf[16], sc[0], 0, 0, 0); sc[0] = __builtin_amdgcn_mfma_f32_16x16x32_bf16(*(const GAS bf16x8*)(kp + 32), qf[17], sc[0], 0, 0, 0);
    }
    { const bf16* qp = QAs + ((size_t)(h * 16) * 256 + b * TS + qi) * 32 + 8 * g;
#pragma unroll
      for (int s = 0; s < 16; ++s) qf[s] = *(const GAS bf16x8*)(qp + (size_t)s * 8192); }
    asm volatile("s_waitcnt vmcnt(0)" ::: "memory");
    __syncthreads();
    { const int ab = 256 * qi + 16 * (g ^ ((qi >> 2) & 3));
      int o4[4];
#pragma unroll
      for (int s4 = 0; s4 < 4; ++s4) o4[s4] = 64 * (s4 ^ (qi & 3));
#pragma unroll
      for (int T = 0; T < 8; ++T) {
          if (T < 1 || !isnew) {
              f32x4 acc = sc[T];
              const LAS unsigned char* ip = lds + (T >> 1) * 32768 + (T & 1) * 4096 + ab;
#pragma unroll
              for (int s = 0; s < 16; ++s) acc = __builtin_amdgcn_mfma_f32_16x16x32_bf16(*(const LAS bf16x8*)(ip + (s >> 2) * 8192 + o4[s & 3]), qf[s], acc, 0, 0, 0);
              sc[T] = acc * (ATTN_SCALE * LOG2E);
          } else sc[T] = (f32x4){-INFINITY, -INFINITY, -INFINITY, -INFINITY};
      }
    }
    float m = sc[0][0];
#pragma unroll
    for (int T = 0; T < 8; ++T)
#pragma unroll
        for (int r = 0; r < 4; ++r) m = fmaxf(m, sc[T][r]);
    m = fmaxf(m, swz_xor<16>(m)); m = half_swap_max(m);
    float lsum = 0.f;
#pragma unroll
    for (int T = 0; T < 8; ++T)
#pragma unroll
        for (int r = 0; r < 4; ++r) { sc[T][r] = __builtin_amdgcn_exp2f(sc[T][r] - m); lsum += sc[T][r]; }
    lsum += swz_xor<16>(lsum); lsum = half_swap_add(lsum);
    const size_t unit = (size_t)b * SCH + ch;
    if (g == 0) { float* mp = PML + ((unit * 8 + h) * 16 + qi) * 2; mp[0] = m; mp[1] = lsum; }
    bf16x8 pf[4];
#pragma unroll
    for (int kb = 0; kb < 4; ++kb) { v4u o; o.x = pkbf(sc[2 * kb][0], sc[2 * kb][1]); o.y = pkbf(sc[2 * kb][2], sc[2 * kb][3]); o.z = pkbf(sc[2 * kb + 1][0], sc[2 * kb + 1][1]); o.w = pkbf(sc[2 * kb + 1][2], sc[2 * kb + 1][3]);
        pf[kb] = __builtin_bit_cast(bf16x8, o); }
    f32x4 oacc[32];
#pragma unroll
    for (int t = 0; t < 32; ++t) oacc[t] = (f32x4){0.f, 0.f, 0.f, 0.f};
    { const int q4 = qi >> 2, p = lane & 3;
      const int trb = (int)(unsigned)(size_t)lds + 256 * (4 * g + q4) + 16 * ((p >> 1) ^ (g & 1)) + 8 * (p & 1);
      const int x3 = (q4 << 1) | (g >> 1);
      int vb[8];
#pragma unroll
      for (int c = 0; c < 8; ++c) vb[c] = trb + 32 * (c ^ x3);
#define SA_BLK(KB, CBK, VBA) do { \
          const s16x4v a0 = sa_tr<((KB) & 1) * 32768 + (CBK) * 8192>(VBA[0]), b0 = sa_tr<((KB) & 1) * 32768 + (CBK) * 8192 + 4096>(VBA[0]); \
          const s16x4v a1 = sa_tr<((KB) & 1) * 32768 + (CBK) * 8192>(VBA[1]), b1 = sa_tr<((KB) & 1) * 32768 + (CBK) * 8192 + 4096>(VBA[1]); \
          const s16x4v a2 = sa_tr<((KB) & 1) * 32768 + (CBK) * 8192>(VBA[2]), b2 = sa_tr<((KB) & 1) * 32768 + (CBK) * 8192 + 4096>(VBA[2]); \
          const s16x4v a3 = sa_tr<((KB) & 1) * 32768 + (CBK) * 8192>(VBA[3]), b3 = sa_tr<((KB) & 1) * 32768 + (CBK) * 8192 + 4096>(VBA[3]); \
          const s16x4v a4 = sa_tr<((KB) & 1) * 32768 + (CBK) * 8192>(VBA[4]), b4 = sa_tr<((KB) & 1) * 32768 + (CBK) * 8192 + 4096>(VBA[4]); \
          const s16x4v a5 = sa_tr<((KB) & 1) * 32768 + (CBK) * 8192>(VBA[5]), b5 = sa_tr<((KB) & 1) * 32768 + (CBK) * 8192 + 4096>(VBA[5]); \
          const s16x4v a6 = sa_tr<((KB) & 1) * 32768 + (CBK) * 8192>(VBA[6]), b6 = sa_tr<((KB) & 1) * 32768 + (CBK) * 8192 + 4096>(VBA[6]); \
          const s16x4v a7 = sa_tr<((KB) & 1) * 32768 + (CBK) * 8192>(VBA[7]), b7 = sa_tr<((KB) & 1) * 32768 + (CBK) * 8192 + 4096>(VBA[7]); \
          asm volatile("s_waitcnt lgkmcnt(0)" ::: "memory"); __builtin_amdgcn_sched_barrier(0); \
          oacc[(CBK) * 8 + 0] = __builtin_amdgcn_mfma_f32_16x16x32_bf16(SA_PK(a0, b0), pf[KB], oacc[(CBK) * 8 + 0], 0, 0, 0); oacc[(CBK) * 8 + 1] = __builtin_amdgcn_mfma_f32_16x16x32_bf16(SA_PK(a1, b1), pf[KB], oacc[(CBK) * 8 + 1], 0, 0, 0); \
          oacc[(CBK) * 8 + 2] = __builtin_amdgcn_mfma_f32_16x16x32_bf16(SA_PK(a2, b2), pf[KB], oacc[(CBK) * 8 + 2], 0, 0, 0); oacc[(CBK) * 8 + 3] = __builtin_amdgcn_mfma_f32_16x16x32_bf16(SA_PK(a3, b3), pf[KB], oacc[(CBK) * 8 + 3], 0, 0, 0); \
          oacc[(CBK) * 8 + 4] = __builtin_amdgcn_mfma_f32_16x16x32_bf16(SA_PK(a4, b4), pf[KB], oacc[(CBK) * 8 + 4], 0, 0, 0); oacc[(CBK) * 8 + 5] = __builtin_amdgcn_mfma_f32_16x16x32_bf16(SA_PK(a5, b5), pf[KB], oacc[(CBK) * 8 + 5], 0, 0, 0); \
          oacc[(CBK) * 8 + 6] = __builtin_amdgcn_mfma_f32_16x16x32_bf16(SA_PK(a6, b6), pf[KB], oacc[(CBK) * 8 + 6], 0, 0, 0); oacc[(CBK) * 8 + 7] = __builtin_amdgcn_mfma_f32_16x16x32_bf16(SA_PK(a7, b7), pf[KB], oacc[(CBK) * 8 + 7], 0, 0, 0); \
          __builtin_amdgcn_sched_barrier(0); } while (0)
#define SA_PK(L, H) ((bf16x8){L[0], L[1], L[2], L[3], H[0], H[1], H[2], H[3]})
#define SA_KB(KB, VBA) do { SA_BLK(KB, 0, VBA); SA_BLK(KB, 1, VBA); SA_BLK(KB, 2, VBA); SA_BLK(KB, 3, VBA); } while (0)
      SA_KB(0, vb);
      if (!isnew) { SA_KB(1, vb);
          int vc[8];
#pragma unroll
          for (int c = 0; c < 8; ++c) vc[c] = vb[c] + 65536;
          SA_KB(2, vc); SA_KB(3, vc); }
#undef SA_KB
#undef SA_BLK
#undef SA_PK
    }
    { bf16* po = PO + ((unit * 8 + h) * 32) * 256 + lane * 4;
#pragma unroll
      for (int t = 0; t < 32; ++t) *(GAS unsigned long long*)(po + t * 256) = (unsigned long long)pkbf(oacc[t][0], oacc[t][1]) | ((unsigned long long)pkbf(oacc[t][2], oacc[t][3]) << 32); }
    __syncthreads();
}
__device__ __forceinline__ void scomb_unit(int b, int h, const bf16* PO, const float* PML, const bf16* WUKVt  , const float* gain, bf16* MIXs  , float* SSA,
                                           LAS unsigned char* lds, int lane, int wave) {
    const int qi = lane & 15, g = lane >> 4;
    __syncthreads();
    const float* ml0 = PML + (((size_t)b * SCH * 8 + h) * 16 + qi) * 2;
    const bf16* po0 = PO + (((size_t)b * SCH * 8 + h) * 32 + 4 * wave) * 256 + lane * 4;
    const bf16* wp = WUKVt + (size_t)(h * 256 + 128 + qi) * KVLR + 64 * wave + 4 * g;
    pg8::f32x2 ml[SCH]; unsigned long long wl_[8][2][2], pa[6][4], pb[6][4];
#pragma unroll
    for (int ch = 0; ch < SCH; ++ch) ml[ch] = *(const GAS pg8::f32x2*)(ml0 + ch * 256);
#pragma unroll
    for (int c = 0; c < 6; ++c)
#pragma unroll
        for (int t = 0; t < 4; ++t) pa[c][t] = *(const GAS unsigned long long*)(po0 + (size_t)c * 65536 + t * 256);
#pragma unroll
    for (int c = 0; c < 6; ++c)
#pragma unroll
        for (int t = 0; t < 4; ++t) pb[c][t] = *(const GAS unsigned long long*)(po0 + (size_t)(6 + c) * 65536 + t * 256);
#pragma unroll
    for (int vt = 0; vt < 8; ++vt)
#pragma unroll
        for (int k2 = 0; k2 < 2; ++k2) { wl_[vt][k2][0] = *(const GAS unsigned long long*)(wp + (size_t)vt * 16 * KVLR + 32 * k2); wl_[vt][k2][1] = *(const GAS unsigned long long*)(wp + (size_t)vt * 16 * KVLR + 32 * k2 + 16); }
    __builtin_amdgcn_sched_barrier(0);
    float M = ml[0].x;
#pragma unroll
    for (int ch = 1; ch < SCH; ++ch) M = fmaxf(M, ml[ch].x);
    float L = 0.f; f32x4 acc[4];
#pragma unroll
    for (int t = 0; t < 4; ++t) acc[t] = (f32x4){0.f, 0.f, 0.f, 0.f};
#define SC_ACC(PV, C0, NC) do { _Pragma("unroll") for (int c = 0; c < NC; ++c) { const float w = __builtin_amdgcn_exp2f(ml[(C0) + c].x - M); L += w * ml[(C0) + c].y; \
            _Pragma("unroll") for (int t = 0; t < 4; ++t) { const unsigned lo = (unsigned)PV[c][t], hi2 = (unsigned)(PV[c][t] >> 32); acc[t] += w * (f32x4){bf_lo(lo), bf_hi(lo), bf_lo(hi2), bf_hi(hi2)}; } } } while (0)
    SC_ACC(pa, 0, 6);
    __builtin_amdgcn_sched_barrier(0);
#pragma unroll
    for (int c = 0; c < 5; ++c)
#pragma unroll
        for (int t = 0; t < 4; ++t) pa[c][t] = *(const GAS unsigned long long*)(po0 + (size_t)(12 + c) * 65536 + t * 256);
    __builtin_amdgcn_sched_barrier(0);
    SC_ACC(pb, 6, 6);
    __builtin_amdgcn_sched_barrier(0);
    SC_ACC(pa, 12, 5);
#undef SC_ACC
    const float inv = 1.0f / L;
    bf16x8 afr[2];
#pragma unroll
    for (int k2 = 0; k2 < 2; ++k2) { v4u o; o.x = pkbf(acc[2 * k2][0] * inv, acc[2 * k2][1] * inv); o.y = pkbf(acc[2 * k2][2] * inv, acc[2 * k2][3] * inv);
        o.z = pkbf(acc[2 * k2 + 1][0] * inv, acc[2 * k2 + 1][1] * inv); o.w = pkbf(acc[2 * k2 + 1][2] * inv, acc[2 * k2 + 1][3] * inv); afr[k2] = __builtin_bit_cast(bf16x8, o); }
    LAS f32x4* red = (LAS f32x4*)lds;
    {
      __builtin_amdgcn_sched_barrier(0);
#pragma unroll
      for (int vt = 0; vt < 8; ++vt) { f32x4 o = {0.f, 0.f, 0.f, 0.f};
#pragma unroll
          for (int k2 = 0; k2 < 2; ++k2) { v4u bw; bw.x = (unsigned)wl_[vt][k2][0]; bw.y = (unsigned)(wl_[vt][k2][0] >> 32); bw.z = (unsigned)wl_[vt][k2][1]; bw.w = (unsigned)(wl_[vt][k2][1] >> 32);
              o = __builtin_amdgcn_mfma_f32_16x16x32_bf16(afr[k2], __builtin_bit_cast(bf16x8, bw), o, 0, 0, 0); }
          red[(wave * 8 + vt) * 64 + lane] = o; } }
    __syncthreads();
    f32x4 s = {0.f, 0.f, 0.f, 0.f};
#pragma unroll
    for (int w = 0; w < 8; ++w) s += red[(w * 8 + wave) * 64 + lane];
    f32x4 ss = s * s;
#pragma unroll
    for (int r = 0; r < 4; ++r) { float t = ss[r]; t += swz_xor<1>(t); t += swz_xor<2>(t); t += swz_xor<4>(t); t += swz_xor<8>(t); ss[r] = t; }
    LAS float* sq = (LAS float*)(lds + 65536);
    if (qi == 0) {
#pragma unroll
        for (int r = 0; r < 4; ++r) sq[wave * 16 + 4 * g + r] = ss[r]; }
    const int col = h * 128 + 16 * wave + qi; const float gn = gain[col];
#pragma unroll
    for (int r = 0; r < 4; ++r) MIXs[kb32(b * TS + 4 * g + r, col)] = (bf16)(pkbf(s[r] * gn, 0.f) & 0xffffu);
    __syncthreads();
    if (wave == 0 && lane < 16) { float t = 0.f;
#pragma unroll
        for (int w = 0; w < 8; ++w) t += sq[w * 16 + lane];
        SSA[h * 256 + b * TS + lane] = t; }
    __syncthreads();
}

#ifndef MK_MULTI
#define MK_MULTI 0
#endif
#ifndef REP_PREP
#define REP_PREP 1
#endif
#ifndef REP_MOD
#define REP_MOD 1
#endif
#ifndef REP_DN
#define REP_DN 1
#endif
#ifndef REP_OUT
#define REP_OUT 1
#endif
#ifndef REP_N1
#define REP_N1 1
#endif
#ifndef REP_SATT
#define REP_SATT 1
#endif
#ifndef REP_UP
#define REP_UP 1
#endif
#ifndef REP_IN
#define REP_IN 1
#endif
#ifndef REP_QKV
#define REP_QKV 1
#endif
#ifndef REP_ATT
#define REP_ATT 1
#endif
#ifndef REP_QABS
#define REP_QABS 1
#endif
#ifndef REP_SABS
#define REP_SABS 1
#endif
#ifndef REP_COMB
#define REP_COMB 1
#endif
#ifndef REP_ELT
#define REP_ELT 1
#endif
constexpr int PH_PREP = 0, PH_MOD = 1, PH_L0 = 2, PH_PER_LAYER = 10, PH_FINAL = PH_L0 + DEPTH * PH_PER_LAYER, N_PHASES = PH_FINAL + 1;
struct Args { const float* in[21]; float* out; unsigned char* ws; int ph_lo, ph_hi; };
static_assert(sizeof(Args) == 21 * 8 + 8 + 8 + 8, "Args has no padding");

__global__ void __launch_bounds__(NWAVES * 64, 2) trunk_fwd(Args args) {
    extern __shared__ __attribute__((aligned(16))) unsigned char lds_raw[];
    LAS unsigned char* lds = (LAS unsigned char*)lds_raw;
    volatile LAS unsigned* MISC = (volatile LAS unsigned*)(lds + MISC_OFF);
    const int wave0 = __builtin_amdgcn_readfirstlane((int)threadIdx.x >> 6);
    const int G = gridDim.x; const int bx = blockIdx.x; const int vcu = (G % 8 == 0) ? (bx % 8) * (G / 8) + bx / 8 : bx;
    { const int t0 = threadIdx.x; for (int u = t0; u < (LDS_BYTES - LDSCTL_OFF) / 4; u += NWAVES * 64) ((LAS unsigned*)(lds + LDSCTL_OFF))[u] = 0u; }
    __syncthreads();
#if MK_MULTI
#define GRID_BAR() do { } while (0)
#else
    XcdBarrier bar = xcd_barrier_post((unsigned*)((gu32*)(args.ws + WS_CTL) + CW_BAR), MISC + 8);
#define GRID_BAR() xcd_barrier(bar)
#endif
    const int lo = args.ph_lo, hi = args.ph_hi;
#define IN(k) (lo <= (k) && (k) < hi)
#ifndef REP_SG
#define REP_SG 1
#endif
#ifndef REP_KPE
#define REP_KPE 1
#endif
#ifndef REP_ROWS
#define REP_ROWS 1
#endif
#ifndef REP_BAR
#define REP_BAR 1
#endif
#define SEAM(k) do { if ((k) + 1 < hi) { for (int rb_ = 0; rb_ < REP_BAR; ++rb_) GRID_BAR(); } } while (0)
#define PHASE_ENV() int ln_; asm volatile("v_mbcnt_lo_u32_b32 %0, -1, 0\n\tv_mbcnt_hi_u32_b32 %0, -1, %0" : "=v"(ln_)); int wv_ = wave0; asm volatile("" : "+s"(wv_)); const int wave = wv_, lane = ln_, tid = wave * 64 + lane; \
    const int SGW_ = (wave == 0) ? vcu : (1 << 20); (void)SGW_; const int PGW_ = (G == 256) ? (wave * 256 + vcu) : (vcu * NWAVES + wave); (void)PGW_;         \
    const int gw = vcu * NWAVES + wave, NGW = G * NWAVES, gt = gw * 64 + lane, NGT = NGW * 64; (void)gt; (void)NGT; (void)gw; (void)NGW; (void)tid; (void)lane; \
    size_t zoff_ = 0; asm volatile("" : "+s"(zoff_)); unsigned char* ws = args.ws + zoff_; float* out = args.out; (void)out; \
    float* X = (float*)(ws + WS_X); bf16* XB = (bf16*)(ws + WS_X); (void)XB; bf16* H = (bf16*)(ws + WS_H); bf16* Z = (bf16*)(ws + WS_Z); bf16* QN = (bf16*)(ws + WS_QN); bf16* CKV = (bf16*)(ws + WS_CKV); \
    bf16* KPE = (bf16*)(ws + WS_KPE); bf16* Qb = (bf16*)(ws + WS_Q); bf16* KVb = (bf16*)(ws + WS_KV); bf16* MIX = (bf16*)(ws + WS_MIX); bf16* HB = (bf16*)(ws + WS_HB); \
    const float* cosT = (const float*)(ws + WS_COS); const float* sinT = (const float*)(ws + WS_SIN); \
    const unsigned char* wl = ws + WS_W + (size_t)l * W_LAYER; const float* modl = (const float*)(ws + WS_MOD) + (size_t)l * NB * MODW; \
    float* ZS = (float*)(ws + WS_ZS); float* PS = (float*)(ws + WS_PS); const int rbx = G - 1 - bx; const bool sg_first_ = (bx & 1) != 0; (void)ZS; (void)PS; (void)rbx; (void)sg_first_; \
    (void)X; (void)H; (void)Z; (void)QN; (void)CKV; (void)KPE; (void)Qb; (void)KVb; (void)MIX; (void)HB; (void)cosT; (void)sinT; (void)wl; (void)modl;

    if (IN(PH_PREP)) for (int rep_ = 0; rep_ < REP_PREP; ++rep_) { const int l = 0; PHASE_ENV(); p0_prep(args.in[9], args.in[11], args.in[13], args.in[17], args.in[18], args.in[19], args.in[2], args.in[3], ws, lds, tid, lane, wave, vcu, G);
        if (G != 256) prep_qabs(args.in[11], args.in[13], ws, lds, tid, lane, wave, vcu, G);
        SEAM(PH_PREP); }
    if (IN(PH_MOD)) for (int rep_ = 0; rep_ < REP_MOD; ++rep_) { const int l = 0; PHASE_ENV(); p1_mod(args.in[7], args.in[8], ws, lds, tid, lane, wave, vcu, G);
        if (G == 256 && (vcu & 3) == 3) prep_qabs(args.in[11], args.in[13], ws, lds, tid, lane, wave, vcu >> 2, 64);
        SEAM(PH_MOD); }

    for (int l = 0; l < DEPTH; ++l) {
        const int pb = PH_L0 + l * PH_PER_LAYER;
        if (hi <= pb || lo >= pb + PH_PER_LAYER) continue;
        if (IN(pb + 0)) { PHASE_ENV(); for (int rep_ = 0; rep_ < REP_N1; ++rep_) { if (l == 0) norm_rows<true>(args.in[0], modl, 0, DM, H, lane, PGW_, NGW); else norm_rows<false>(XB, modl, 0, DM, H, lane, PGW_, NGW); }
            norm_rows_s_coop<false>(args.in[1], X, l == 0, PS, l == 0 ? 0 : 4, modl - (size_t)NB * MODW + 5 * DM, modl, 0, DM, H + (size_t)MP * DM, nullptr, nullptr, (LAS float*)lds, lane, wave, vcu, G);
            SEAM(pb + 0); }
        if (IN(pb + 1)) for (int rep_ = 0; rep_ < REP_IN; ++rep_) { PHASE_ENV();
            if (sg_first_) {
            for (int u = rbx; u < 264; u += G) {
                const bool pe = u >= 256; const int cb = pe ? (u & 1) : (u & 127), ks = pe ? ((u - 256) >> 1) : (u >> 7);
                SEpiPart Es{pe ? (float*)(ws + WS_SSA + 65536) + (size_t)ks * MS * 64 : ZS + (size_t)ks * MS * 4096, pe ? 64 : 4096};
                sgemm_unit(lds, H + (size_t)MP * DM, (const bf16*)(wl + (pe ? WO_PE : WO_IN)), DM, 32 * cb, pe ? 512 * ks : 1024 * ks, pe ? 512 : 1024, Es, lane, wave); }
            }
            pg8::Gemm g{H, (const bf16*)(wl + WO_IN), MP, 4096, DM, (pg8::bf16_t*)(ws + WS_DUMMY)}; pg8::StaticOrder S; S.init(MP, 4096, G, bx);
            pg8::EpiZ E{Z};
            pg8::gemm_phase<pg8::EpiZ, pg8::StaticOrder, true, true>(lds, g, S, E, wave0);
            __syncthreads();
            if (!sg_first_) {
            for (int u = rbx; u < 264; u += G) {
                const bool pe = u >= 256; const int cb = pe ? (u & 1) : (u & 127), ks = pe ? ((u - 256) >> 1) : (u >> 7);
                SEpiPart Es{pe ? (float*)(ws + WS_SSA + 65536) + (size_t)ks * MS * 64 : ZS + (size_t)ks * MS * 4096, pe ? 64 : 4096};
                sgemm_unit(lds, H + (size_t)MP * DM, (const bf16*)(wl + (pe ? WO_PE : WO_IN)), DM, 32 * cb, pe ? 512 * ks : 1024 * ks, pe ? 512 : 1024, Es, lane, wave); }
            }
            SEAM(pb + 1);
        }
        if (IN(pb + 2)) for (int rep_ = 0; rep_ < REP_ELT; ++rep_) {
#pragma unroll 1
            for (int slot = 0; slot < 2; ++slot) { PHASE_ENV();
                if ((slot == 0) != sg_first_) elt_kpe(H, (const bf16*)(wl + WO_PE), KPE, cosT, sinT, out + O_KPEP + (size_t)l * MP * 64, out + O_KPES + (size_t)l * MS * 64, lds, tid, lane, wave, vcu, G);
                else elt_rows(Z, args.in[10] + l * QLR, args.in[12] + l * KVLR, args.in[14] + l * 3 * DCONV, args.in[16] + l * DCONV, args.in[6] + (size_t)l * NBS * 2 * DCONV,
                     QN, CKV, MIX, out + O_CKVP + (size_t)l * MP * 512, out + O_CKVS + (size_t)l * MS * 512, out + O_CONVP + (size_t)l * NBP * 2 * DCONV, out + O_CONVS + (size_t)l * NBS * 2 * DCONV, args.in[4] + (size_t)l * MC * 512, lane, gw, NGW);
            }
            PHASE_ENV();
            elt_rows_s(ZS, args.in[10] + l * QLR, args.in[12] + l * KVLR, args.in[14] + l * 3 * DCONV, args.in[16] + l * DCONV, args.in[6] + (size_t)l * NBS * 2 * DCONV,
                       QN + (size_t)MP * QLR, CKV + (size_t)KVROW_S * KVLR, MIX + (size_t)MP * DM, out + O_CKVS + (size_t)l * MS * 512, out + O_CONVS + (size_t)l * NBS * 2 * DCONV, lane, wave < 4 ? vcu : (1 << 20), G,
                       (const float*)(ws + WS_SSA + 65536), KPE + (size_t)KVROW_S * 64, out + O_KPES + (size_t)l * MS * 64, cosT, sinT, wave);
            SEAM(pb + 2);
        }
        if (IN(pb + 3)) for (int rep_ = 0; rep_ < REP_QKV; ++rep_) { PHASE_ENV();
            { pg8::Gemm g{QN, (const bf16*)(wl + WO_UQ), MP, NQ, QLR, (pg8::bf16_t*)(ws + WS_DUMMY)}; pg8::StaticOrder S; S.init(MP, NQ, G, bx);
              pg8::EpiStore<0> E{Qb, NQ};
              pg8::gemm_phase<pg8::EpiStore<0>, pg8::StaticOrder, true, true>(lds, g, S, E, wave0); }
            __syncthreads();
            { pg8::Gemm g{CKV, (const bf16*)(wl + WO_UKV), MP, NKV, KVLR, (pg8::bf16_t*)(ws + WS_DUMMY)}; pg8::StaticOrder S; S.init(MP, NKV, G, bx);
              pg8::EpiStore<0> E{KVb, NKV};
              pg8::gemm_phase<pg8::EpiStore<0>, pg8::StaticOrder, true, true>(lds, g, S, E, wave0); }
            __syncthreads();
            if (G != 256 || rbx < 128) for (int u = rbx; u < 144; u += (G == 256 ? 128 : G)) {
                if (u < 128) { SEpiBf<0> Es{(bf16*)(ws + WS_QA)}; sgemm_unit(lds, QN + (size_t)MP * QLR, (const bf16*)(wl + WO_QA), QLR, 32 * u, 0, 512, Es, lane, wave); }
                else { const int hh = (u - 128) >> 1, hf = (u - 128) & 1; SEpiBf<0> Es{(bf16*)(ws + WS_QA), 124 - 4 * hh};
                    sgemm_unit(lds, QN + (size_t)MP * QLR, (const bf16*)(wl + WO_UQ), QLR, hh * QKD + 128 + 32 * hf, 0, 512, Es, lane, wave); } }
            SEAM(pb + 3);
        }
        if (IN(pb + 4)) for (int rep_ = 0; rep_ < REP_ATT; ++rep_) {
#pragma unroll 1
            for (int slot = 0; slot < 3; ++slot) { PHASE_ENV();
                const int bh = vcu >> 2, role = vcu & 3;
                const int kind = sg_first_ ? (slot == 0 ? 2 : slot - 1) : (slot == 2 ? 2 : slot);
                if (kind == 2) {
                    const int su2_ = (G == 256) ? (((vcu & 15) == 0) ? 256 + (vcu >> 4) : NBS * SCH) : vcu + G;
#pragma unroll 1
                    for (int su = vcu, ns_ = 0; su < NBS * SCH; su = (ns_++ == 0 ? su2_ : su + G)) { const int sb = su < 256 ? (su >> 4) : su - 256, sc_ = su < 256 ? (su & 15) : 16;
                        sabs_unit(sb, sc_, (const bf16*)(ws + WS_QA), CKV, KPE, args.in[4] + (size_t)l * MC * 512, args.in[5] + (size_t)l * MC * 64, cosT, sinT, (bf16*)(ws + WS_PO), (float*)(ws + WS_PML), lds, lane, wave); }
                } else if (G == NBP * NH * 4) att::attn_unit(bh >> 3, bh & 7, kind == 0 ? 7 - role : role, Qb, KVb, KPE, MIX, cosT, sinT, (char*)lds_raw, wave0);
            }
            if (G != NBP * NH * 4) { PHASE_ENV(); (void)lane;
                for (int pu = vcu; pu < NBP * NH * 4; pu += G) { const int bh = pu >> 2, s = pu & 3;
#pragma unroll 1
                    for (int k = 0; k < 2; ++k) att::attn_unit(bh >> 3, bh & 7, k == 0 ? 7 - s : s, Qb, KVb, KPE, MIX, cosT, sinT, (char*)lds_raw, wave0); } }
            SEAM(pb + 4);
        }
        if (IN(pb + 5)) { PHASE_ENV();
#pragma unroll 1
            for (int cu = (G == 256 ? ((vcu & 1) ? NBS * NH : (vcu >> 1)) : vcu); cu < NBS * NH; cu += G) scomb_unit((cu & 127) >> 3, cu & 7, (const bf16*)(ws + WS_PO), (const float*)(ws + WS_PML), (const bf16*)(wl + WO_UKV), args.in[15] + l * DATT, MIX + (size_t)MP * DM, (float*)(ws + WS_SSA), lds, lane, wave);
            if (G == 256) { const int hw_ = (vcu >> 1) * NWAVES + wave; if ((vcu & 1) == 0) anorm_rows(MIX, args.in[15] + l * DATT, lane, hw_, 1024, 4096); else anorm_rows(MIX, args.in[15] + l * DATT, lane, 4096 + hw_, 1024, MP); }
            else anorm_rows(MIX, args.in[15] + l * DATT, lane, gw, NGW, MP);
            SEAM(pb + 5); }
        if (IN(pb + 6)) { PHASE_ENV();
            if (sg_first_) {
            for (int u = rbx; u < 256 * REP_SG; u += G) { const int uu = u & 255; const int cb = uu & 63, ks = uu >> 6; SEpiPart Es{PS + (size_t)ks * MS * DM, DM};
                sgemm_unit(lds, MIX + (size_t)MP * DM, (const bf16*)(wl + WO_OUT), DM, 32 * cb, 512 * ks, 512, Es, lane, wave); }
            }
            pg8::Gemm g{MIX, (const bf16*)(wl + WO_OUT), MP, DM, DM, (pg8::bf16_t*)(ws + WS_DUMMY)}; pg8::StaticOrder S; S.init(MP, DM, G, bx);
            for (int rep_ = 1; rep_ < REP_OUT; ++rep_) { pg8::EpiResid Ed{l == 0 ? args.in[0] : nullptr, XB, (bf16*)(ws + WS_END), modl + 2 * DM}; pg8::gemm_phase<pg8::EpiResid, pg8::StaticOrder, true, true>(lds, g, S, Ed, wave0); __syncthreads(); }
            pg8::EpiResid E{l == 0 ? args.in[0] : nullptr, XB, XB, modl + 2 * DM};
            pg8::gemm_phase<pg8::EpiResid, pg8::StaticOrder, true, true>(lds, g, S, E, wave0);
            __syncthreads();
            if (!sg_first_) {
            for (int u = rbx; u < 256 * REP_SG; u += G) { const int uu = u & 255; const int cb = uu & 63, ks = uu >> 6; SEpiPart Es{PS + (size_t)ks * MS * DM, DM};
                sgemm_unit(lds, MIX + (size_t)MP * DM, (const bf16*)(wl + WO_OUT), DM, 32 * cb, 512 * ks, 512, Es, lane, wave); }
            }
            SEAM(pb + 6);
        }
        if (IN(pb + 7)) { PHASE_ENV(); norm_rows<false>(XB, modl, 3 * DM, 4 * DM, H, lane, PGW_, NGW);
            norm_rows_s_coop<false>(nullptr, X, false, PS, 4, modl + 2 * DM, modl, 3 * DM, 4 * DM, H + (size_t)MP * DM, nullptr, nullptr, (LAS float*)lds, lane, wave, vcu, G, (const float*)(ws + WS_SSA));
            SEAM(pb + 7); }
        if (IN(pb + 8)) for (int rep_ = 0; rep_ < REP_UP; ++rep_) { PHASE_ENV();
            if (sg_first_) {
            for (int u = rbx; u < 256 * REP_SG; u += G) { SEpiBf<1> Es{HB + (size_t)MP * DFF};
                sgemm_unit(lds, H + (size_t)MP * DM, (const bf16*)(wl + WO_UP), DM, 32 * (u & 255), 0, 2048, Es, lane, wave); }
            }
            pg8::Gemm g{H, (const bf16*)(wl + WO_UP), MP, DFF, DM, (pg8::bf16_t*)(ws + WS_DUMMY)}; pg8::StaticOrder S; S.init(MP, DFF, G, bx);
            pg8::EpiStore<1> E{HB, DFF};
            pg8::gemm_phase<pg8::EpiStore<1>, pg8::StaticOrder, true, true>(lds, g, S, E, wave0);
            __syncthreads();
            if (!sg_first_) {
            for (int u = rbx; u < 256 * REP_SG; u += G) { SEpiBf<1> Es{HB + (size_t)MP * DFF};
                sgemm_unit(lds, H + (size_t)MP * DM, (const bf16*)(wl + WO_UP), DM, 32 * (u & 255), 0, 2048, Es, lane, wave); }
            }
            SEAM(pb + 8);
        }
        if (IN(pb + 9)) { PHASE_ENV();
            if (sg_first_) {
            for (int u = rbx; u < 256 * REP_SG; u += G) { const int uu = u & 255; const int cb = uu & 63, ks = uu >> 6; SEpiPart Es{PS + (size_t)ks * MS * DM, DM};
                sgemm_unit(lds, HB + (size_t)MP * DFF, (const bf16*)(wl + WO_DN), DFF, 32 * cb, 2048 * ks, 2048, Es, lane, wave); }
            }
            pg8::Gemm g{HB, (const bf16*)(wl + WO_DN), MP, DM, DFF, (pg8::bf16_t*)(ws + WS_DUMMY)}; pg8::StaticOrder S; S.init(MP, DM, G, bx);
            for (int rep_ = 1; rep_ < REP_DN; ++rep_) { pg8::EpiResid Ed{nullptr, XB, (bf16*)(ws + WS_END), modl + 5 * DM}; pg8::gemm_phase<pg8::EpiResid, pg8::StaticOrder, true, true>(lds, g, S, Ed, wave0); __syncthreads(); }
            pg8::EpiResid E{nullptr, XB, XB, modl + 5 * DM};
            pg8::gemm_phase<pg8::EpiResid, pg8::StaticOrder, true, true>(lds, g, S, E, wave0);
            __syncthreads();
            if (!sg_first_) {
            for (int u = rbx; u < 256 * REP_SG; u += G) { const int uu = u & 255; const int cb = uu & 63, ks = uu >> 6; SEpiPart Es{PS + (size_t)ks * MS * DM, DM};
                sgemm_unit(lds, HB + (size_t)MP * DFF, (const bf16*)(wl + WO_DN), DFF, 32 * cb, 2048 * ks, 2048, Es, lane, wave); }
            }
            SEAM(pb + 9);
        }
    }
    int lo_f = args.ph_lo, hi_f = args.ph_hi; asm volatile("" : "+s"(lo_f), "+s"(hi_f));
    if (lo_f <= PH_FINAL && PH_FINAL < hi_f) { const int l = 0; PHASE_ENV(); final_norm_rows(XB, args.in[20], out, lane, gw, NGW);
        norm_rows_s_coop<true>(nullptr, X, false, PS, 4, (const float*)(ws + WS_MOD) + (size_t)(DEPTH - 1) * NB * MODW + 5 * DM, nullptr, 0, 0, nullptr, args.in[20], out, (LAS float*)lds, lane, wave, vcu, G); }
#undef IN
#undef SEAM
}

extern "C" void kernel_launch(void* const* d_in, const int* in_sizes, int n_in, void* d_out, int out_size, void* d_ws, size_t ws_size, hipStream_t stream) {
    static int grid = 0;
    if (grid == 0) {
        if (n_in != 21 || in_sizes[0] != MP * DM || (size_t)out_size != O_END || ws_size < WS_END + ((REP_DN > 1 || REP_OUT > 1) ? (size_t)MP * DM * 4 : 0)) {
            fprintf(stderr, "kernel_launch: shape mismatch: n_in %d in0 %d out %d ws %zu (need %zu); nothing launched\n", n_in, n_in > 0 ? in_sizes[0] : -1, out_size, ws_size, (size_t)WS_END); grid = -1; return; }
        int dev = 0, cus = 0, per_cu = 0;
        if (hipGetDevice(&dev) != hipSuccess || hipDeviceGetAttribute(&cus, hipDeviceAttributeMultiprocessorCount, dev) != hipSuccess) { fprintf(stderr, "kernel_launch: device query failed\n"); grid = -1; return; }
        if (hipFuncSetAttribute((const void*)trunk_fwd, hipFuncAttributeMaxDynamicSharedMemorySize, LDS_BYTES) != hipSuccess) { fprintf(stderr, "kernel_launch: hipFuncSetAttribute failed\n"); grid = -1; return; }
        if (hipOccupancyMaxActiveBlocksPerMultiprocessor(&per_cu, (const void*)trunk_fwd, NWAVES * 64, LDS_BYTES) != hipSuccess || per_cu < 1)
            fprintf(stderr, "kernel_launch: note: occupancy query reports %d workgroups per CU\n", per_cu);
        (void)hipGetLastError();
        grid = cus;
    }
    if (grid < 0) return;
    if (hipMemsetAsync((char*)d_ws + WS_CTL, 0, CTL_ZERO_BYTES, stream) != hipSuccess) { fprintf(stderr, "kernel_launch: memset failed\n"); return; }
    Args a{};
    for (int i = 0; i < 21; ++i) a.in[i] = (const float*)d_in[i];
    a.out = (float*)d_out; a.ws = (unsigned char*)d_ws;
#if MK_MULTI
    for (int p = 0; p < N_PHASES; ++p) { a.ph_lo = p; a.ph_hi = p + 1; hipLaunchKernelGGL(trunk_fwd, dim3(grid), dim3(NWAVES * 64), LDS_BYTES, stream, a); }
#else
    a.ph_lo = 0; a.ph_hi = N_PHASES;
    hipLaunchKernelGGL(trunk_fwd, dim3(grid), dim3(NWAVES * 64), LDS_BYTES, stream, a);
#endif
    const hipError_t le = hipPeekAtLastError();
    if (le != hipSuccess) fprintf(stderr, "kernel_launch: launch failed: %s\n", hipGetErrorName(le));
}
```

```cpp
#include <hip/hip_runtime.h>
#include <cstdio>
#include <cstdint>
namespace pg8 {
#define PG8_LAS __attribute__((address_space(3)))
typedef unsigned short bf16_t;
typedef short bf16x8 __attribute__((ext_vector_type(8)));
typedef float f32x4 __attribute__((ext_vector_type(4)));
typedef unsigned u32x4 __attribute__((ext_vector_type(4)));
constexpr int BM = 256, BK = 64, HALF = 128, HTB = HALF * BK * 2  , STAGE_BYTES = 8 * HTB, NXCD = 8, WGM = 8;

__host__ __device__ __forceinline__ int lds_byte(int r, int c) { const int st = (r >> 4) * 2 + (c >> 5), rr = r & 15, cc = c & 31, ob = rr * 64 + cc * 2; return st * 1024 + (ob ^ (((ob >> 9) & 1) << 5)); }
__host__ __device__ __forceinline__ void stage_rc(int b, int& R, int& C) { const int st = b / 1024, sb = b % 1024, swz = sb ^ (((sb >> 9) & 1) << 5); R = (st >> 1) * 16 + swz / 64; C = (st & 1) * 32 + (swz % 64) / 2; }
__host__ __device__ __forceinline__ int perm32(int rho) { const int n = rho >> 4, i = rho & 15; return 8 * (i >> 2) + 4 * n + (i & 3); }

struct Unit { int pm, pn; };
struct Gemm { const bf16_t* A; const bf16_t* Bt; int M, N, K; bf16_t* dummy; };

struct StaticOrder {
    int nM, nN, nwg, G, c;
    __host__ __device__ void init(int M, int N, int G_, int c_) { nM = M / BM; nN = N / BM; nwg = nM * nN; G = G_; c = c_; }
    __host__ __device__ bool next(int i, Unit& u) const {
        const long L = (long)i * G + c; if (L >= nwg) return false;
        int wgid = (int)L; { const int q = nwg / NXCD, r = nwg % NXCD, xcd = wgid % NXCD, off = wgid / NXCD; wgid = (xcd < r ? xcd * (q + 1) : r * (q + 1) + (xcd - r) * q) + off; }
        const int nig = WGM * nN, gid = wgid / nig, fm = gid * WGM, gsz = (nM - fm) < WGM ? (nM - fm) : WGM;
        u.pm = fm + ((wgid % nig) % gsz); u.pn = (wgid % nig) / gsz; return true;
    }
    __device__ __forceinline__ void a_ready(const Unit&) const {}
    __device__ __forceinline__ void done(const Unit&) const {}
};

typedef float f32x2pk __attribute__((ext_vector_type(2))); typedef __bf16 bf16x2pk __attribute__((ext_vector_type(2)));
__device__ __forceinline__ unsigned cvt_pk_bf16(float lo, float hi) { const f32x2pk v = {lo, hi}; const bf16x2pk b = __builtin_convertvector(v, bf16x2pk); return __builtin_bit_cast(unsigned, b); }
typedef float f32x2 __attribute__((ext_vector_type(2)));
template <class Epi, class Sched, bool ALIGN_EPI = false, bool SP2 = false>
__device__ __forceinline__ void gemm_phase(PG8_LAS unsigned char* lds, const Gemm g, const Sched& S, const Epi& E, const int wave_s  ) {
    int tid_l; asm volatile("v_mbcnt_lo_u32_b32 %0, -1, 0\n\tv_mbcnt_hi_u32_b32 %0, -1, %0" : "=v"(tid_l)); tid_l += wave_s * 64;
    const int tid = tid_l, wid = wave_s, lane = tid & 63, wr = wid >> 2, wc = wid & 3, fr = lane & 15, fq = lane >> 4;
    const int K = g.K, nt = K / BK;
    unsigned voffA[2], voffB[2];
#pragma unroll
    for (int i = 0; i < 2; ++i) { int R, C; stage_rc(tid * 16 + i * 8192, R, C); const int Rb = Epi::PERM ? ((R & ~31) + perm32(R & 31)) : R;
        voffA[i] = (unsigned)(R * K + C) * 2u; voffB[i] = (unsigned)(Rb * K + C) * 2u; }
    const size_t kstep = (size_t)(BK * 2);
    const size_t hstep = (size_t)HALF * K * 2;
    const size_t tstep = 2 * hstep;
    const unsigned ldsw = (unsigned)wid * 1024u;
    const int aoff = lds_byte(wr * 64 + fr, fq * 8), boff = lds_byte(wc * 32 + fr, fq * 8);
#define PG8_SA(b, h) (((b) * 2 + (h)) * HTB)
#define PG8_SB(b, h) ((4 + (b) * 2 + (h)) * HTB)
#define PG8_STAGE(bufoff, gbase, voff) do { _Pragma("unroll") for (int _i = 0; _i < 2; ++_i) \
        __builtin_amdgcn_global_load_lds((const unsigned*)((const char*)(gbase) + (voff)[_i]), (PG8_LAS unsigned*)(lds + (bufoff) + ldsw + _i * 8192), 16, 0, 0); } while (0)
#define PG8_LDA(dst, b, h) do { _Pragma("unroll") for (int m = 0; m < 4; ++m) _Pragma("unroll") for (int k = 0; k < 2; ++k) dst[m][k] = *(const PG8_LAS bf16x8*)(lds + PG8_SA(b, h) + aoff + m * 2048 + k * 1024); } while (0)
#define PG8_LDB(dst, b, h) do { _Pragma("unroll") for (int n = 0; n < 2; ++n) _Pragma("unroll") for (int k = 0; k < 2; ++k) dst[n][k] = *(const PG8_LAS bf16x8*)(lds + PG8_SB(b, h) + boff + n * 2048 + k * 1024); } while (0)
#define PG8_MMA(ai, bj, At, Bt) do { __builtin_amdgcn_s_setprio(1); _Pragma("unroll") for (int m = 0; m < 4; ++m) _Pragma("unroll") for (int n = 0; n < 2; ++n) _Pragma("unroll") for (int k = 0; k < 2; ++k) \
        acc[ai][bj][m][n] = __builtin_amdgcn_mfma_f32_16x16x32_bf16(Bt[n][k], At[m][k], acc[ai][bj][m][n], 0, 0, 0); __builtin_amdgcn_s_setprio(0); } while (0)
#define PG8_WAIT_V(n) asm volatile("s_waitcnt vmcnt(" #n ")" ::: "memory")
#define PG8_WAIT_L(n) asm volatile("s_waitcnt lgkmcnt(" #n ")" ::: "memory")
#define PG8_WAIT_VR(flag, n) asm volatile("s_cmp_eq_u32 %0, 0\n\ts_cbranch_scc0 .Lpg8w%=\n\ts_waitcnt vmcnt(8)\n.Lpg8w%=:\n\ts_waitcnt vmcnt(%1)" :: "s"(flag), "n"(n) : "memory", "scc")
#define PG8_BAR __builtin_amdgcn_s_barrier()
#define PG8_SCHED __builtin_amdgcn_sched_barrier(0)
    Unit cur, nxt; int ui = 0;
    if (!S.next(0, cur)) return;
    f32x4 acc[2][2][4][2];
#pragma unroll
    for (int a = 0; a < 2; ++a)
#pragma unroll
        for (int b = 0; b < 2; ++b)
#pragma unroll
            for (int m = 0; m < 4; ++m)
#pragma unroll
                for (int n = 0; n < 2; ++n) acc[a][b][m][n] = (f32x4){0.f, 0.f, 0.f, 0.f};
    bf16x8 At[4][2], B0[2][2], B1[2][2];
    const char* cA = (const char*)g.A + (size_t)cur.pm * tstep; const char* cB = (const char*)g.Bt + (size_t)cur.pn * tstep;
    S.a_ready(cur);
    if constexpr (SP2) {
        PG8_STAGE(PG8_SB(0, 0), cB, voffB); PG8_STAGE(PG8_SB(0, 1), cB + hstep, voffB); PG8_STAGE(PG8_SA(0, 0), cA, voffA); PG8_STAGE(PG8_SA(0, 1), cA + hstep, voffA);
        if (wr == 1) PG8_BAR;
        PG8_WAIT_V(2); PG8_BAR;
        PG8_STAGE(PG8_SB(1, 0), cB + kstep, voffB); PG8_STAGE(PG8_SA(1, 0), cA + kstep, voffA); PG8_STAGE(PG8_SB(1, 1), cB + hstep + kstep, voffB);
        PG8_WAIT_V(6); PG8_BAR;
    } else {
        PG8_STAGE(PG8_SB(0, 0), cB, voffB); PG8_STAGE(PG8_SA(0, 0), cA, voffA); PG8_STAGE(PG8_SB(0, 1), cB + hstep, voffB); PG8_STAGE(PG8_SA(0, 1), cA + hstep, voffA);
        if (wr == 1) PG8_BAR;
        PG8_WAIT_V(4); PG8_BAR;
        PG8_STAGE(PG8_SB(1, 0), cB + kstep, voffB); PG8_STAGE(PG8_SA(1, 0), cA + kstep, voffA); PG8_STAGE(PG8_SB(1, 1), cB + hstep + kstep, voffB);
        PG8_WAIT_V(6); PG8_BAR;
    }
    for (;;) {
        const bool has_next = S.next(ui + 1, nxt);
        const char* nA = has_next ? (const char*)g.A + (size_t)nxt.pm * tstep : cA; const char* nB = has_next ? (const char*)g.Bt + (size_t)nxt.pn * tstep : cB;
        for (int t = 0; t < nt; t += 2) {
            const bool last = (t == nt - 2);
            const char* a1 = cA + (size_t)(t + 1) * kstep;
            const char* a2 = last ? nA : cA + (size_t)(t + 2) * kstep; const char* b2 = last ? nB : cB + (size_t)(t + 2) * kstep;
            const char* a3 = a2 + kstep; const char* b3 = b2 + kstep;
            if (last && has_next) S.a_ready(nxt);
            if constexpr (SP2) {
            PG8_LDB(B0, 0, 0); PG8_LDB(B1, 0, 1); PG8_SCHED; PG8_LDA(At, 0, 0); PG8_STAGE(PG8_SA(1, 1), a1 + hstep, voffA);
            PG8_WAIT_V(8); PG8_WAIT_L(0); PG8_BAR; PG8_MMA(0, 0, At, B0); PG8_MMA(0, 1, At, B1); PG8_BAR; PG8_SCHED;
            PG8_LDA(At, 0, 1); PG8_STAGE(PG8_SB(0, 0), b2, voffB); PG8_STAGE(PG8_SB(0, 1), b2 + hstep, voffB); PG8_STAGE(PG8_SA(0, 0), a2, voffA);
            PG8_WAIT_V(8); PG8_WAIT_L(0); PG8_BAR; PG8_MMA(1, 0, At, B0); PG8_MMA(1, 1, At, B1); PG8_BAR; PG8_SCHED;
            PG8_LDB(B0, 1, 0); PG8_LDB(B1, 1, 1); PG8_SCHED; PG8_LDA(At, 1, 0); PG8_STAGE(PG8_SA(0, 1), a2 + hstep, voffA);
            PG8_WAIT_V(8); PG8_WAIT_L(0); PG8_BAR; PG8_MMA(0, 0, At, B0); PG8_MMA(0, 1, At, B1); PG8_BAR; PG8_SCHED;
            PG8_LDA(At, 1, 1); PG8_STAGE(PG8_SB(1, 0), b3, voffB); PG8_STAGE(PG8_SB(1, 1), b3 + hstep, voffB); PG8_STAGE(PG8_SA(1, 0), a3, voffA);
            PG8_WAIT_V(8); PG8_WAIT_L(0); PG8_BAR; PG8_MMA(1, 0, At, B0); PG8_MMA(1, 1, At, B1); PG8_BAR; PG8_SCHED;
            } else {
            PG8_LDB(B0, 0, 0); PG8_SCHED; PG8_LDA(At, 0, 0); PG8_STAGE(PG8_SA(1, 1), a1 + hstep, voffA);
            PG8_WAIT_L(8); PG8_BAR; PG8_WAIT_L(0); PG8_MMA(0, 0, At, B0); PG8_BAR; PG8_SCHED;
            PG8_LDB(B1, 0, 1); PG8_STAGE(PG8_SB(0, 0), b2, voffB);
            PG8_BAR; PG8_WAIT_L(0); PG8_MMA(0, 1, At, B1); PG8_BAR;
            PG8_LDA(At, 0, 1); PG8_STAGE(PG8_SA(0, 0), a2, voffA);
            PG8_BAR; PG8_WAIT_L(0); PG8_MMA(1, 0, At, B0); PG8_BAR; PG8_SCHED;
            PG8_STAGE(PG8_SB(0, 1), b2 + hstep, voffB);
            PG8_WAIT_V(6); PG8_BAR; PG8_MMA(1, 1, At, B1); PG8_BAR;
            PG8_LDB(B0, 1, 0); PG8_SCHED; PG8_LDA(At, 1, 0); PG8_STAGE(PG8_SA(0, 1), a2 + hstep, voffA);
            PG8_WAIT_L(8); PG8_BAR; PG8_WAIT_L(0); PG8_MMA(0, 0, At, B0); PG8_BAR; PG8_SCHED;
            PG8_LDB(B1, 1, 1); PG8_STAGE(PG8_SB(1, 0), b3, voffB);
            PG8_BAR; PG8_WAIT_L(0); PG8_MMA(0, 1, At, B1); PG8_BAR;
            PG8_LDA(At, 1, 1); PG8_STAGE(PG8_SA(1, 0), a3, voffA);
            PG8_BAR; PG8_WAIT_L(0); PG8_MMA(1, 0, At, B0); PG8_BAR; PG8_SCHED;
            PG8_STAGE(PG8_SB(1, 1), b3 + hstep, voffB);
            PG8_WAIT_V(6); PG8_BAR; PG8_MMA(1, 1, At, B1); PG8_BAR;
            }
        }
        if constexpr (ALIGN_EPI) { if (wr == 0) PG8_BAR; }
        if constexpr (!Epi::AFTER_DRAIN) { E(acc, cur, wr, wc, fr, fq); S.done(cur); }
        if (!has_next) break;
#pragma unroll
        for (int a = 0; a < 2; ++a)
#pragma unroll
            for (int b = 0; b < 2; ++b)
#pragma unroll
                for (int m = 0; m < 4; ++m)
#pragma unroll
                    for (int n = 0; n < 2; ++n) acc[a][b][m][n] = (f32x4){0.f, 0.f, 0.f, 0.f};
        cur = nxt; cA = nA; cB = nB; ++ui;
        if constexpr (ALIGN_EPI) { if (wr == 1) PG8_BAR; }
    }
    PG8_WAIT_V(0);
    if constexpr (!ALIGN_EPI) { if (wr == 0) PG8_BAR; }
    PG8_BAR;
    if constexpr (Epi::AFTER_DRAIN) { E.fused(acc, cur, wr, wc, fr, fq, lds, wid, lane); S.done(cur); }
#undef PG8_SA
#undef PG8_SB
#undef PG8_STAGE
#undef PG8_LDA
#undef PG8_LDB
#undef PG8_MMA
#undef PG8_WAIT_V
#undef PG8_WAIT_L
#undef PG8_WAIT_VR
#undef PG8_BAR
#undef PG8_SCHED
}
}
#define GAS __attribute__((address_space(1)))
#define LAS __attribute__((address_space(3)))
typedef unsigned short bf16;
typedef unsigned v4u __attribute__((ext_vector_type(4)));
typedef float f32x4 __attribute__((ext_vector_type(4)));
typedef short bf16x8 __attribute__((ext_vector_type(8)));
typedef GAS unsigned gu32;
typedef GAS unsigned long long gu64;
#define RLX_AGENT __ATOMIC_RELAXED, __HIP_MEMORY_SCOPE_AGENT
#define LDS_WAIT() asm volatile("s_waitcnt lgkmcnt(0)" ::: "memory")
#define VM_WAIT() asm volatile("s_waitcnt vmcnt(0)" ::: "memory")
__device__ __forceinline__ unsigned long long rt() { return __builtin_amdgcn_s_memrealtime(); }
__device__ __forceinline__ unsigned f2bf(float f) { unsigned u = __builtin_bit_cast(unsigned, f); return (u + 0x7fffu + ((u >> 16) & 1u)) >> 16; }
__device__ __forceinline__ unsigned pk2(float lo, float hi) { return f2bf(lo) | (f2bf(hi) << 16); }
#define XB_TMO      128
#define XB_XCNT(j)  (256  + 64 * (j))
#define XB_XSUB(j)  (1280 + 64 * (j))
#define XB_XGEN(j)  (2304 + 64 * (j))
#define XB_TOP      3328
#define XB_TOPGEN   3392
#define XCD_BAR_WORDS 3456
#define XB_SPIN_CAP (1u << 18)

__device__ __forceinline__ unsigned xb_ld(unsigned* p)              { return __hip_atomic_load(p, __ATOMIC_RELAXED, __HIP_MEMORY_SCOPE_AGENT); }
__device__ __forceinline__ unsigned xb_add(unsigned* p, unsigned v) { return __hip_atomic_fetch_add(p, v, __ATOMIC_RELAXED, __HIP_MEMORY_SCOPE_AGENT); }
__device__ __forceinline__ unsigned xb_xcc_id() { return (unsigned)__builtin_amdgcn_s_getreg((3 << 11) | 20) & 0xFu; }
#define XB_SPIN(cond, bar) do { unsigned _sp = 0; while (cond) { __builtin_amdgcn_s_sleep(1); \
    if ((++_sp & 255u) == 0u) { if (xb_ld(&(bar)[XB_TMO])) break; if (_sp > XB_SPIN_CAP) { atomicAdd(&(bar)[XB_TMO], 1u); break; } } } } while (0)

struct XcdBarrier {
    unsigned* bar; unsigned x;
    volatile LAS unsigned* st;
};

__device__ __forceinline__ XcdBarrier xcd_barrier_post(unsigned* bar, volatile LAS unsigned* st) {
    XcdBarrier b; b.bar = bar; b.x = xb_xcc_id(); b.st = st;
    if (threadIdx.x == 0) (void)xb_add(&bar[XB_XCNT(b.x)], 1u);
    return b;
}
__device__ __forceinline__ void xcd_barrier_complete(unsigned* bar, unsigned x, unsigned& nloc, unsigned& nx) {
    const unsigned G = gridDim.x * gridDim.y * gridDim.z;
    unsigned sum, cnt, mine, sp = 0u;
    for (;;) {
        sum = 0u; cnt = 0u; mine = 0u;
#pragma unroll
        for (unsigned j = 0; j < 16; ++j) { const unsigned c = xb_ld(&bar[XB_XCNT(j)]); sum += c; cnt += (c > 0u) ? 1u : 0u; mine = (j == x) ? c : mine; }
        if (sum == G) break;
        __builtin_amdgcn_s_sleep(1);
        if ((++sp & 255u) == 0u) { if (xb_ld(&bar[XB_TMO])) break; if (sp > XB_SPIN_CAP) { atomicAdd(&bar[XB_TMO], 1u); break; } }
    }
    nloc = mine > 0u ? mine : 1u; nx = cnt > 0u ? cnt : 1u;
}

__device__ __forceinline__ void xcd_barrier(const XcdBarrier& b) {
    asm volatile("s_waitcnt vmcnt(0)" ::: "memory");
    __syncthreads();
    if (threadIdx.x == 0) {
        unsigned* bar = b.bar;
        __builtin_amdgcn_s_waitcnt(0);
        unsigned nloc = b.st[0], nx = b.st[1];
        if (nloc == 0u) { xcd_barrier_complete(bar, b.x, nloc, nx); b.st[0] = nloc; b.st[1] = nx; }
        const unsigned old = xb_add(&bar[XB_XSUB(b.x)], 1u);
        const unsigned gen = old / nloc;
        if (old + 1u == (gen + 1u) * nloc) {
            __builtin_amdgcn_fence(__ATOMIC_RELEASE, "agent");
            asm volatile("s_waitcnt vmcnt(0)" ::: "memory");
            const unsigned og = xb_add(&bar[XB_TOP], 1u);
            const unsigned tg = og / nx;
            if (og + 1u == (tg + 1u) * nx) xb_add(&bar[XB_TOPGEN], 1u);
            else XB_SPIN(xb_ld(&bar[XB_TOPGEN]) == tg, bar);
            __builtin_amdgcn_fence(__ATOMIC_ACQUIRE, "agent");
            xb_add(&bar[XB_XGEN(b.x)], 1u);
            asm volatile("s_waitcnt vmcnt(0)" ::: "memory");
        } else {
            XB_SPIN(xb_ld(&bar[XB_XGEN(b.x)]) == gen, bar);
            __builtin_amdgcn_fence(__ATOMIC_ACQUIRE, "agent");
            asm volatile("s_waitcnt vmcnt(0)" ::: "memory");
        }
    }
    __syncthreads();
}

constexpr int DM = 2048, SEQ = 2048, NBP = 8, NBS = 16, TS = 16, PAST = 2048, DEPTH = 4;
constexpr int MP = NBP * SEQ, MS = NBS * TS, MR = MP + MS, MC = NBS * PAST, MKV = MR + MC;
constexpr int NH = 8, QKD = 192, QLR = 512, KVLR = 512, DATT = 1024, DCONV = 1024, DFF = 8192, INC = 4160;
constexpr int ZW = 3072, NQ = NH * QKD, NKV = NH * 256, MODW = 6 * DM, NB = NBP + NBS;
constexpr int NPOS = PAST + TS;
constexpr float EPS = 1e-6f;
constexpr float ATTN_SCALE = 0.07216878364870322f;
constexpr float LOG2E = 1.4426950408889634f;

namespace pg8 {
template <int ACT> struct EpiStore {
    static constexpr bool PERM = true, AFTER_DRAIN = false; static constexpr int NST = 16;
    bf16_t* O; int ldc;
    __device__ __forceinline__ void operator()(const f32x4 (&acc)[2][2][4][2], const Unit& u, int wr, int wc, int fr, int fq) const {
        const int row0 = u.pm * BM + wr * 64 + fr, col0 = u.pn * BM + wc * 32 + 8 * fq;
#pragma unroll
        for (int ai = 0; ai < 2; ++ai)
#pragma unroll
            for (int m = 0; m < 4; ++m) { bf16_t* rowp = O + (size_t)(row0 + ai * HALF + m * 16) * ldc + col0;
#pragma unroll
                for (int bj = 0; bj < 2; ++bj) { f32x4 v0 = acc[ai][bj][m][0], v1 = acc[ai][bj][m][1];
                    if (ACT == 1) {
#pragma unroll
                        for (int e = 0; e < 4; ++e) { const float a = v0[e] > 0.f ? v0[e] : 0.f, b = v1[e] > 0.f ? v1[e] : 0.f; v0[e] = a * a; v1[e] = b * b; } }
                    u32x4 w; w.x = cvt_pk_bf16(v0[0], v0[1]); w.y = cvt_pk_bf16(v0[2], v0[3]); w.z = cvt_pk_bf16(v1[0], v1[1]); w.w = cvt_pk_bf16(v1[2], v1[3]);
                    *(u32x4*)(rowp + bj * HALF) = w; } }
    }
};
struct EpiZ {
    static constexpr bool PERM = true, AFTER_DRAIN = false; static constexpr int NST = 8;
    bf16_t* O;
    __device__ __forceinline__ void operator()(const f32x4 (&acc)[2][2][4][2], const Unit& u, int wr, int wc, int fr, int fq) const {
        const int row0 = u.pm * BM + wr * 64 + fr, lc = wc * 32 + 8 * fq;
        const bool prod = (u.pn >= 4 && u.pn < 12);
        const int colb = prod ? 1024 + 128 * (u.pn - 4) : (u.pn < 4 ? 256 * u.pn : 2048 + 256 * (u.pn - 12));
#pragma unroll
        for (int ai = 0; ai < 2; ++ai)
#pragma unroll
            for (int m = 0; m < 4; ++m) { bf16_t* rowp = O + (size_t)(row0 + ai * HALF + m * 16) * ZW + colb + lc;
                if (prod) { const f32x4 v0 = acc[ai][0][m][0] * acc[ai][1][m][0], v1 = acc[ai][0][m][1] * acc[ai][1][m][1];
                    u32x4 w; w.x = cvt_pk_bf16(v0[0], v0[1]); w.y = cvt_pk_bf16(v0[2], v0[3]); w.z = cvt_pk_bf16(v1[0], v1[1]); w.w = cvt_pk_bf16(v1[2], v1[3]);
                    *(u32x4*)(rowp) = w; }
                else {
#pragma unroll
                    for (int bj = 0; bj < 2; ++bj) { const f32x4 v0 = acc[ai][bj][m][0], v1 = acc[ai][bj][m][1];
                        u32x4 w; w.x = cvt_pk_bf16(v0[0], v0[1]); w.y = cvt_pk_bf16(v0[2], v0[3]); w.z = cvt_pk_bf16(v1[0], v1[1]); w.w = cvt_pk_bf16(v1[2], v1[3]);
                        *(u32x4*)(rowp + bj * HALF) = w; } } }
    }
};
struct EpiResid {
    static constexpr bool PERM = true, AFTER_DRAIN = false; static constexpr int NST = 0;
    const float* xin32; const bf16_t* xin16; bf16_t* xout; const float* gate;
    __device__ __forceinline__ void operator()(const f32x4 (&acc)[2][2][4][2], const Unit& u, int wr, int wc, int fr, int fq) const {
        const int col0 = u.pn * BM + wc * 32 + 8 * fq;
        const float* g = gate + (size_t)(u.pm >> 3) * MODW + col0;
#pragma unroll
        for (int ai = 0; ai < 2; ++ai)
#pragma unroll
            for (int m = 0; m < 4; ++m) { const size_t off = (size_t)(u.pm * BM + ai * HALF + wr * 64 + m * 16 + fr) * DM + col0;
#pragma unroll
                for (int bj = 0; bj < 2; ++bj) { f32x4 x0, x1;
                    if (xin32) { x0 = *(const f32x4*)(xin32 + off + bj * HALF); x1 = *(const f32x4*)(xin32 + off + bj * HALF + 4); }
                    else { const u32x4 w = *(const u32x4*)(xin16 + off + bj * HALF);
                        x0 = (f32x4){__uint_as_float(w.x << 16), __uint_as_float(w.x & 0xffff0000u), __uint_as_float(w.y << 16), __uint_as_float(w.y & 0xffff0000u)};
                        x1 = (f32x4){__uint_as_float(w.z << 16), __uint_as_float(w.z & 0xffff0000u), __uint_as_float(w.w << 16), __uint_as_float(w.w & 0xffff0000u)}; }
                    const f32x4 y0 = x0 + *(const f32x4*)(g + bj * HALF) * acc[ai][bj][m][0], y1 = x1 + *(const f32x4*)(g + bj * HALF + 4) * acc[ai][bj][m][1];
                    u32x4 o; o.x = cvt_pk_bf16(y0[0], y0[1]); o.y = cvt_pk_bf16(y0[2], y0[3]); o.z = cvt_pk_bf16(y1[0], y1[1]); o.w = cvt_pk_bf16(y1[2], y1[3]);
                    *(u32x4*)(xout + off + bj * HALF) = o; } }
    }
};
}

namespace att {
using bf16x8 = __attribute__((ext_vector_type(8))) short;
using s16x4  = __attribute__((ext_vector_type(4))) short;
using f32x16 = __attribute__((ext_vector_type(16))) float;
using f32x4  = __attribute__((ext_vector_type(4))) float;
using u32x4  = __attribute__((ext_vector_type(4))) unsigned;
typedef unsigned short bf16_t;
constexpr int NW = 8, QBLK = 32, KVBLK = 64;
constexpr int SHM_V = KVBLK * 128 * 2, SHM_KN = KVBLK * 128 * 2, SHM_KP = KVBLK * 64 * 2;
constexpr int OFF_V = 0, OFF_KN = 2 * SHM_V, OFF_KP = OFF_KN + 2 * SHM_KN, OFF_WS = OFF_KP + 2 * SHM_KP, OFF_QP = OFF_WS + NW * 64 * 4, ATT_LDS = OFF_QP + NW * 4 * 1024;
constexpr float THR = 8.f;
constexpr float CSC = ATTN_SCALE * LOG2E;
#define KSWZ(row, colB) ((row) * 256 + ((colB) ^ (((row) & 7) << 4)))
#define PSWZ(row, colB) ((row) * 128 + ((colB) ^ (((row) & 7) << 4)))
#define SBAR() __builtin_amdgcn_sched_barrier(0)
__device__ __forceinline__ int crow(int r, int hi) { return (r & 3) + 8 * (r >> 2) + 4 * hi; }
__device__ __forceinline__ unsigned cvtpk(float lo, float hi) { unsigned r; asm volatile("v_cvt_pk_bf16_f32 %0, %1, %2" : "=v"(r) : "v"(lo), "v"(hi)); return r; }
__device__ __forceinline__ float bflo(unsigned w) { return __uint_as_float(w << 16); }
__device__ __forceinline__ float bfhi(unsigned w) { return __uint_as_float(w & 0xffff0000u); }

__device__ __forceinline__ void partialSM(f32x16& p0, f32x16& p1, float& m_reg, float& mn, float& alpha) {
  float pmax = p0[0];
#pragma unroll
  for (int r = 1; r < 16; ++r) pmax = fmaxf(pmax, p0[r]);
#pragma unroll
  for (int r = 0; r < 16; ++r) pmax = fmaxf(pmax, p1[r]);
  { auto rr = __builtin_amdgcn_permlane32_swap(__float_as_uint(pmax), __float_as_uint(pmax), false, false);
    pmax = fmaxf(__uint_as_float(rr[0]), __uint_as_float(rr[1])); }
  if (__builtin_expect(__all(pmax - m_reg <= THR / ATTN_SCALE), 1)) { mn = m_reg; alpha = 1.f; }
  else { mn = fmaxf(m_reg, pmax); alpha = __builtin_amdgcn_exp2f((m_reg - mn) * CSC); m_reg = mn; }
  const float mnC = -mn * CSC;
#pragma unroll
  for (int r = 0; r < 16; ++r) p0[r] = fmaf(p0[r], CSC, mnC);
#pragma unroll
  for (int r = 0; r < 16; ++r) p1[r] = fmaf(p1[r], CSC, mnC);
#pragma unroll
  for (int r = 0; r < 16; ++r) p0[r] = __builtin_amdgcn_exp2f(p0[r]);
}
__device__ __forceinline__ void finishSM(f32x16& p0, f32x16& p1, float alpha, float& l_reg, bf16x8& pa0, bf16x8& pa1, bf16x8& pa2, bf16x8& pa3) {
#pragma unroll
  for (int r = 0; r < 16; ++r) p1[r] = __builtin_amdgcn_exp2f(p1[r]);
  float ps = 0;
#pragma unroll
  for (int r = 0; r < 16; ++r) ps += p0[r];
#pragma unroll
  for (int r = 0; r < 16; ++r) ps += p1[r];
  { auto rr = __builtin_amdgcn_permlane32_swap(__float_as_uint(ps), __float_as_uint(ps), false, false);
    ps = __uint_as_float(rr[0]) + __uint_as_float(rr[1]); }
  l_reg = l_reg * alpha + ps;
#define PK4(P, BASE, OUT) do { unsigned a0 = cvtpk(P[BASE + 0], P[BASE + 1]), a1 = cvtpk(P[BASE + 2], P[BASE + 3]);   \
    unsigned b0 = cvtpk(P[BASE + 4], P[BASE + 5]), b1 = cvtpk(P[BASE + 6], P[BASE + 7]);                              \
    auto r0 = __builtin_amdgcn_permlane32_swap(a0, b0, false, false); auto r1 = __builtin_amdgcn_permlane32_swap(a1, b1, false, false); \
    u32x4 w = {r0[0], r1[0], r0[1], r1[1]}; OUT = *reinterpret_cast<bf16x8*>(&w); } while (0)
  PK4(p0, 0, pa0); PK4(p0, 8, pa1); PK4(p1, 0, pa2); PK4(p1, 8, pa3);
#undef PK4
}
__device__ __forceinline__ void qkt(f32x16& p0, f32x16& p1, const char* Kn, const char* Kp, const bf16x8* qr, const char* qp, int r32, int hi) {
  p0 = f32x16{}; p1 = f32x16{};
#pragma unroll
  for (int d0 = 0; d0 < 8; ++d0) { const int cb = (d0 * 16 + hi * 8) * 2;
    const bf16x8 b0 = *reinterpret_cast<const bf16x8*>(Kn + KSWZ(r32, cb));
    const bf16x8 b1 = *reinterpret_cast<const bf16x8*>(Kn + KSWZ(32 + r32, cb));
    p0 = __builtin_amdgcn_mfma_f32_32x32x16_bf16(b0, qr[d0], p0, 0, 0, 0);
    p1 = __builtin_amdgcn_mfma_f32_32x32x16_bf16(b1, qr[d0], p1, 0, 0, 0); }
#pragma unroll
  for (int d0 = 0; d0 < 4; ++d0) { const int cb = (d0 * 16 + hi * 8) * 2;
    const bf16x8 b0 = *reinterpret_cast<const bf16x8*>(Kp + PSWZ(r32, cb));
    const bf16x8 b1 = *reinterpret_cast<const bf16x8*>(Kp + PSWZ(32 + r32, cb));
    const bf16x8 qd = *reinterpret_cast<const bf16x8*>(qp + d0 * 1024);
    p0 = __builtin_amdgcn_mfma_f32_32x32x16_bf16(b0, qd, p0, 0, 0, 0);
    p1 = __builtin_amdgcn_mfma_f32_32x32x16_bf16(b1, qd, p1, 0, 0, 0); }
}
__device__ __forceinline__ void maskt(f32x16& p0, f32x16& p1, bool hide) {
  if (hide) {
#pragma unroll
    for (int r = 0; r < 16; ++r) { p0[r] = -INFINITY; p1[r] = -INFINITY; } }
}
__device__ __forceinline__ int v_st(int k, int c) { const int kk = (k & ~0xC) | ((k & 4) << 1) | ((k & 8) >> 1); return ((kk >> 3) * 4 + (c >> 5)) * 512 + ((kk & 7) * 32 + (c & 31)) * 2; }
__device__ __forceinline__ int v_rd_base(int lane) { return ((lane & 3) << 3) | (((lane >> 2) & 3) << 6) | (((lane >> 4) & 1) << 5) | (((lane >> 5) & 1) << 8); }
constexpr int v_rd_off(int d0, int ks, int half) { return d0 * 512 + ks * 4096 + half * 2048; }
template <int OFF> __device__ __forceinline__ s16x4 tr_read(int vb) {
  s16x4 r; asm volatile("ds_read_b64_tr_b16 %0, %1 offset:%2" : "=&v"(r) : "v"(vb), "i"(OFF) : "memory"); return r;
}
template <int D0> __device__ __forceinline__ void pv_one(f32x16& od, int vb, bf16x8 pa0, bf16x8 pa1, bf16x8 pa2, bf16x8 pa3) {
  const s16x4 l0 = tr_read<v_rd_off(D0, 0, 0)>(vb), h0 = tr_read<v_rd_off(D0, 0, 1)>(vb), l1 = tr_read<v_rd_off(D0, 1, 0)>(vb), h1 = tr_read<v_rd_off(D0, 1, 1)>(vb);
  const s16x4 l2 = tr_read<v_rd_off(D0, 2, 0)>(vb), h2 = tr_read<v_rd_off(D0, 2, 1)>(vb), l3 = tr_read<v_rd_off(D0, 3, 0)>(vb), h3 = tr_read<v_rd_off(D0, 3, 1)>(vb);
  asm volatile("s_waitcnt lgkmcnt(0)" ::: "memory"); SBAR();
#define PK(L, H) (bf16x8){L[0], L[1], L[2], L[3], H[0], H[1], H[2], H[3]}
  od = __builtin_amdgcn_mfma_f32_32x32x16_bf16(pa0, PK(l0, h0), od, 0, 0, 0);
  od = __builtin_amdgcn_mfma_f32_32x32x16_bf16(pa1, PK(l1, h1), od, 0, 0, 0);
  od = __builtin_amdgcn_mfma_f32_32x32x16_bf16(pa2, PK(l2, h2), od, 0, 0, 0);
  od = __builtin_amdgcn_mfma_f32_32x32x16_bf16(pa3, PK(l3, h3), od, 0, 0, 0);
#undef PK
}
__device__ __forceinline__ void pv_d0(f32x16* o, int vb, bf16x8 pa0, bf16x8 pa1, bf16x8 pa2, bf16x8 pa3) {
  pv_one<0>(o[0], vb, pa0, pa1, pa2, pa3); pv_one<1>(o[1], vb, pa0, pa1, pa2, pa3); pv_one<2>(o[2], vb, pa0, pa1, pa2, pa3); pv_one<3>(o[3], vb, pa0, pa1, pa2, pa3);
}

__device__ __forceinline__ void attn_unit(int b, int h, int qb, const bf16_t* __restrict__ Qb, const bf16_t* __restrict__ KVb, const bf16_t* __restrict__ KPb, bf16_t* __restrict__ Ob,
                                          const float* __restrict__ cosT, const float* __restrict__ sinT, char* lds, const int wave_s) {
  int tid_l; asm volatile("v_mbcnt_lo_u32_b32 %0, -1, 0\n\tv_mbcnt_hi_u32_b32 %0, -1, %0" : "=v"(tid_l)); tid_l += wave_s * 64;
  const int tid = tid_l, wid = wave_s, lane = tid & 63, r32 = lane & 31, hi = lane >> 5;
  char* V_lds = lds + OFF_V; char* KN_lds = lds + OFF_KN; char* KP_lds = lds + OFF_KP;
  float* ws = (float*)(lds + OFF_WS) + wid * 64; float* li_l = ws; float* al_l = ws + 32;
  float m_reg = -1e30f, l_reg = 0; f32x16 o[4] = {}; bf16x8 qr[8];
  char* qp = lds + OFF_QP + wid * 4096 + lane * 16;
  const int q0 = qb * 256, tq = q0 + wid * QBLK + r32;
  const long rowbase = (long)b * SEQ;
  { const bf16_t* Qw = Qb + (rowbase + tq) * NQ + h * QKD + hi * 8;
#pragma unroll
    for (int d0 = 0; d0 < 8; ++d0) qr[d0] = *reinterpret_cast<const bf16x8*>(Qw + d0 * 16);
#pragma unroll
    for (int pr = 0; pr < 2; ++pr) {
      const float* cp = cosT + (long)tq * 32 + pr * 16 + hi * 8; const float* sp = sinT + (long)tq * 32 + pr * 16 + hi * 8;
      const f32x4 c0 = *(const f32x4*)cp, c1 = *(const f32x4*)(cp + 4), s0 = *(const f32x4*)sp, s1 = *(const f32x4*)(sp + 4);
      const u32x4 x1 = *reinterpret_cast<const u32x4*>(Qw + (8 + pr) * 16), x2 = *reinterpret_cast<const u32x4*>(Qw + (10 + pr) * 16);
      u32x4 y1, y2;
#pragma unroll
      for (int w = 0; w < 4; ++w) {
        const float ca = w < 2 ? c0[2 * w] : c1[2 * w - 4], cb = w < 2 ? c0[2 * w + 1] : c1[2 * w - 3];
        const float sa = w < 2 ? s0[2 * w] : s1[2 * w - 4], sb = w < 2 ? s0[2 * w + 1] : s1[2 * w - 3];
        const float a1 = bflo(x1[w]), b1 = bfhi(x1[w]), a2 = bflo(x2[w]), b2 = bfhi(x2[w]);
        y1[w] = cvtpk(a1 * ca - a2 * sa, b1 * cb - b2 * sb);
        y2[w] = cvtpk(a2 * ca + a1 * sa, b2 * cb + b1 * sb); }
      *reinterpret_cast<u32x4*>(qp + pr * 1024) = y1; *reinterpret_cast<u32x4*>(qp + (2 + pr) * 1024) = y2; }
    asm volatile("s_waitcnt lgkmcnt(0)" ::: "memory");
  }
  const bf16_t* Kh = KVb + rowbase * NKV + h * 256; const bf16_t* Vh = Kh + 128; const bf16_t* Ph = KPb + rowbase * 64;
  const int sr = tid >> 4, sc = (tid & 15) * 8, vst0 = v_st(sr, sc), vst1 = v_st(32 + sr, sc);
  const int pr_ = tid >> 3, pc_ = (tid & 7) * 8;
  const int vb0 = (int)(uintptr_t)V_lds + v_rd_base(lane);
  bf16x8 vs0, vs1, ks0, ks1, ps0;
#define SLOAD(k0) do { vs0 = *reinterpret_cast<const bf16x8*>(&Vh[(long)((k0) + sr) * NKV + sc]); vs1 = *reinterpret_cast<const bf16x8*>(&Vh[(long)((k0) + 32 + sr) * NKV + sc]); \
    ks0 = *reinterpret_cast<const bf16x8*>(&Kh[(long)((k0) + sr) * NKV + sc]); ks1 = *reinterpret_cast<const bf16x8*>(&Kh[(long)((k0) + 32 + sr) * NKV + sc]); \
    ps0 = *reinterpret_cast<const bf16x8*>(&Ph[(long)((k0) + pr_) * 64 + pc_]); } while (0)
#define SWRITE(bb) do { *(bf16x8*)(V_lds + (bb) * SHM_V + vst0) = vs0; *(bf16x8*)(V_lds + (bb) * SHM_V + vst1) = vs1; \
    *(bf16x8*)(KN_lds + (bb) * SHM_KN + KSWZ(sr, sc * 2)) = ks0; *(bf16x8*)(KN_lds + (bb) * SHM_KN + KSWZ(32 + sr, sc * 2)) = ks1; \
    *(bf16x8*)(KP_lds + (bb) * SHM_KP + PSWZ(pr_, pc_ * 2)) = ps0; } while (0)
#define SWAIT() asm volatile("s_waitcnt vmcnt(0)" ::: "memory")
#define RESC(a) do { if (__any((a) < 1.f)) { if (hi == 0) al_l[r32] = (a); asm volatile("s_waitcnt lgkmcnt(0)" ::: "memory"); \
    _Pragma("unroll") for (int d = 0; d < 4; ++d) _Pragma("unroll") for (int r = 0; r < 16; ++r) o[d][r] *= al_l[crow(r, hi)]; } } while (0)
  f32x16 pA0, pA1, pB0, pB1; float mnA, mnB, alA, alB; bf16x8 pa0, pa1, pa2, pa3;
  const int NT = 4 * qb + 4, cw = 4 * qb + (wid >> 1);
  SLOAD(0); SWAIT(); SWRITE(0); __syncthreads();
  qkt(pA0, pA1, KN_lds, KP_lds, qr, qp, r32, hi); partialSM(pA0, pA1, m_reg, mnA, alA);
  SLOAD(KVBLK);
  SWAIT(); SWRITE(1); __syncthreads();
  for (int j = 1; j + 1 < NT; j += 2) {
    SBAR(); qkt(pB0, pB1, KN_lds + SHM_KN, KP_lds + SHM_KP, qr, qp, r32, hi); maskt(pB0, pB1, j > cw);
    finishSM(pA0, pA1, alA, l_reg, pa0, pa1, pa2, pa3); SBAR();
    SLOAD((j + 1) * KVBLK); SBAR();
    pv_d0(o, vb0, pa0, pa1, pa2, pa3); partialSM(pB0, pB1, m_reg, mnB, alB);
    __syncthreads(); SWAIT(); SWRITE(0);
    RESC(alB); __syncthreads();
    SBAR(); qkt(pA0, pA1, KN_lds, KP_lds, qr, qp, r32, hi); maskt(pA0, pA1, j + 1 > cw);
    finishSM(pB0, pB1, alB, l_reg, pa0, pa1, pa2, pa3); SBAR();
    SLOAD((j + 2) * KVBLK); SBAR();
    pv_d0(o, vb0 + SHM_V, pa0, pa1, pa2, pa3); partialSM(pA0, pA1, m_reg, mnA, alA);
    __syncthreads(); SWAIT(); SWRITE(1);
    RESC(alA); __syncthreads();
  }
  SBAR(); qkt(pB0, pB1, KN_lds + SHM_KN, KP_lds + SHM_KP, qr, qp, r32, hi); maskt(pB0, pB1, NT - 1 > cw);
  finishSM(pA0, pA1, alA, l_reg, pa0, pa1, pa2, pa3); SBAR();
  pv_d0(o, vb0, pa0, pa1, pa2, pa3); partialSM(pB0, pB1, m_reg, mnB, alB);
  __syncthreads(); RESC(alB);
  finishSM(pB0, pB1, alB, l_reg, pa0, pa1, pa2, pa3); SBAR();
  pv_d0(o, vb0 + SHM_V, pa0, pa1, pa2, pa3);
  if (hi == 0) li_l[r32] = l_reg; asm volatile("s_waitcnt lgkmcnt(0)" ::: "memory");
#pragma unroll
  for (int r = 0; r < 16; ++r) { const float rl = __builtin_amdgcn_rcpf(li_l[crow(r, hi)]);
#pragma unroll
    for (int d0 = 0; d0 < 4; ++d0) o[d0][r] *= rl; }
  bf16_t* Ow = Ob + (rowbase + q0 + wid * QBLK) * DM + h * 128;
  { char* st = lds + OFF_QP + wid * 4096;
#pragma unroll
    for (int half = 0; half < 2; ++half) {
#pragma unroll
      for (int r = 0; r < 16; ++r) { const int orow = crow(r, hi);
#pragma unroll
        for (int dd = 0; dd < 2; ++dd) *reinterpret_cast<bf16_t*>(st + orow * 128 + (dd * 32 + r32) * 2) = (bf16_t)(cvtpk(o[2 * half + dd][r], 0.f) & 0xffffu); }
      asm volatile("s_waitcnt lgkmcnt(0)" ::: "memory");
#pragma unroll
      for (int i = 0; i < 4; ++i) { const int row = i * 8 + (lane >> 3), chn = lane & 7; const u32x4 v = *reinterpret_cast<const u32x4*>(st + row * 128 + chn * 16);
        *reinterpret_cast<u32x4*>(Ow + (long)row * DM + half * 64 + chn * 8) = v; }
      asm volatile("s_waitcnt lgkmcnt(0)" ::: "memory"); } }
  __syncthreads();
#undef SLOAD
#undef SWRITE
#undef SWAIT
#undef RESC
}
#undef SBAR
}

constexpr size_t MiB = 1u << 20;
constexpr size_t WS_CTL = 0, CTL_ZERO_BYTES = 1 * MiB;
constexpr size_t WS_MOD = 2 * MiB;
constexpr size_t WS_SCT = 7 * MiB;
constexpr size_t WS_DUMMY = 7 * MiB + 512 * 1024;
constexpr size_t WS_COS = 8 * MiB, WS_SIN = 8 * MiB + 512 * 1024;
constexpr size_t WS_W = 16 * MiB, W_LAYER = 96 * MiB;
constexpr size_t WO_IN = 0, WO_PE = 16 * MiB, WO_UQ = WO_PE + 256 * 1024, WO_UKV = WO_UQ + 1536 * 1024, WO_OUT = WO_UKV + 2 * MiB, WO_UP = WO_OUT + 8 * MiB, WO_DN = WO_UP + 32 * MiB, WO_QA = WO_DN + 32 * MiB;
static_assert(WO_QA + 4 * MiB <= W_LAYER, "weights per layer");
constexpr size_t WS_X = WS_W + DEPTH * W_LAYER;
constexpr size_t WS_H = WS_X + 130 * MiB;
constexpr size_t WS_R = WS_H + 66 * MiB;
constexpr size_t WS_Z = WS_R;
constexpr size_t WS_QN = WS_R + 98 * MiB;
constexpr size_t WS_CKV = WS_R + 115 * MiB;
constexpr size_t WS_KPE = WS_R + 164 * MiB;
constexpr size_t WS_Q = WS_R + 171 * MiB;
constexpr size_t WS_KV = WS_R + 220 * MiB;
constexpr size_t WS_MIX = WS_R + 414 * MiB;
constexpr size_t WS_HB = WS_R;
constexpr size_t WS_ZS = WS_R + 480 * MiB;
constexpr size_t WS_PS = WS_R + 488 * MiB;
constexpr size_t WS_END = WS_R + 496 * MiB;
static_assert((size_t)MR * DM * 4 <= 130 * MiB && (size_t)MR * DM * 2 <= 66 * MiB && (size_t)MR * ZW * 2 <= 98 * MiB && (size_t)MKV * 512 * 2 <= 49 * MiB && (size_t)MKV * 64 * 2 <= 7 * MiB
              && (size_t)MR * NQ * 2 <= 49 * MiB && (size_t)MKV * NKV * 2 <= 194 * MiB && (size_t)MR * DFF * 2 <= 414 * MiB, "d_ws map");
constexpr size_t O_Y = 0, O_CKVP = (size_t)MR * DM, O_KPEP = O_CKVP + (size_t)DEPTH * MP * 512, O_CONVP = O_KPEP + (size_t)DEPTH * MP * 64, O_CKVS = O_CONVP + (size_t)DEPTH * NBP * 2 * 1024,
                 O_KPES = O_CKVS + (size_t)DEPTH * MS * 512, O_CONVS = O_KPES + (size_t)DEPTH * MS * 64, O_END = O_CONVS + (size_t)DEPTH * NBS * 2 * 1024;
static_assert(O_END == 72613888, "output size");
constexpr int CW_BAR = 4096;
constexpr int KVROW_C = MP, KVROW_S = MP + MC;
constexpr int RING_BYTES = 135168;
constexpr int LDSCTL_OFF = RING_BYTES, MISC_OFF = LDSCTL_OFF + 320, LDS_BYTES = RING_BYTES + 1024;
constexpr int NWAVES = 8;
typedef float f32x8v __attribute__((ext_vector_type(8)));

template <int M> __device__ __forceinline__ float swz_xor(float v) { return __int_as_float(__builtin_amdgcn_ds_swizzle(__float_as_int(v), (M << 10) | 0x1f)); }
__device__ __forceinline__ float half_swap_add(float v) { auto rr = __builtin_amdgcn_permlane32_swap(__float_as_uint(v), __float_as_uint(v), false, false); return __uint_as_float(rr[0]) + __uint_as_float(rr[1]); }
__device__ __forceinline__ float half_swap_max(float v) { auto rr = __builtin_amdgcn_permlane32_swap(__float_as_uint(v), __float_as_uint(v), false, false); return fmaxf(__uint_as_float(rr[0]), __uint_as_float(rr[1])); }
__device__ __forceinline__ float wave_sum(float v) {
    v += swz_xor<1>(v); v += swz_xor<2>(v); v += swz_xor<4>(v); v += swz_xor<8>(v); v += swz_xor<16>(v);
    return half_swap_add(v);
}
__device__ __forceinline__ float wave_max(float v) {
    v = fmaxf(v, swz_xor<1>(v)); v = fmaxf(v, swz_xor<2>(v)); v = fmaxf(v, swz_xor<4>(v)); v = fmaxf(v, swz_xor<8>(v)); v = fmaxf(v, swz_xor<16>(v));
    return half_swap_max(v);
}
__device__ __forceinline__ float bf_lo(unsigned w) { return __uint_as_float(w << 16); }
__device__ __forceinline__ float bf_hi(unsigned w) { return __uint_as_float(w & 0xffff0000u); }
__device__ __forceinline__ unsigned pkbf(float lo, float hi) { return pg8::cvt_pk_bf16(lo, hi); }
__device__ __forceinline__ int row_batch(int row) { return row < MP ? (row >> 11) : NBP + ((row - MP) >> 4); }
__device__ __forceinline__ int row_pos(int row) { return row < MP ? (row & (SEQ - 1)) : PAST + ((row - MP) & (TS - 1)); }

struct TrItem { const float* src; bf16* dst; int N, K; };
__device__ __forceinline__ TrItem tr_item(const float* W, int K, int N, int src_col0, bf16* WT, int dst_row0, int kb, int lane) {
    TrItem d; d.src = W + (size_t)(64 * kb + (lane >> 5)) * N + src_col0 + (lane & 31); d.dst = WT + (size_t)dst_row0 * K + 64 * kb; d.N = N; d.K = K; return d; }
__device__ __forceinline__ void tr_load(const TrItem& d, float (&wv)[32]) {
#pragma unroll
    for (int i = 0; i < 32; ++i) wv[i] = d.src[(size_t)(2 * i) * d.N];
}
__device__ __forceinline__ void tr_store(const TrItem& d, const float (&wv)[32], LAS float* scr, int lane) {
#pragma unroll
    for (int i = 0; i < 32; ++i) scr[(2 * i + (lane >> 5)) * 33 + (lane & 31)] = wv[i];
    LDS_WAIT(); asm volatile("" ::: "memory");
    const int c = lane & 7;
#pragma unroll
    for (int j = 0; j < 4; ++j) { const int n = (lane >> 3) + 8 * j; const LAS float* s = scr + (8 * c) * 33 + n;
        v4u o; o.x = pkbf(s[0 * 33], s[1 * 33]); o.y = pkbf(s[2 * 33], s[3 * 33]); o.z = pkbf(s[4 * 33], s[5 * 33]); o.w = pkbf(s[6 * 33], s[7 * 33]);
        *(GAS v4u*)(d.dst + (size_t)n * d.K + 8 * c) = o; }
    LDS_WAIT(); asm volatile("" ::: "memory");
}
__device__ __forceinline__ int win_src_col(int v0) {
    if (v0 < 1024) return v0;
    if (v0 < 3072) { const int t = v0 - 1024, j = t >> 8, r = t & 255; return r < 128 ? 2112 + 128 * j + r : 3136 + 128 * j + (r - 128); }
    return 1088 + (v0 - 3072);
}
constexpr int IT_IN = 32 * 128, IT_PE = 32 * 2, IT_UQ = 8 * 48, IT_UKV = 8 * 64, IT_OUT = 32 * 64, IT_UP = 32 * 256, IT_DN = 128 * 64;
constexpr int IT_LAYER = IT_IN + IT_PE + IT_UQ + IT_UKV + IT_OUT + IT_UP + IT_DN;
__device__ __forceinline__ void p0_prep(const float* w_in, const float* w_uq, const float* w_ukv, const float* w_out, const float* w_up, const float* w_down, const float* c_p, const float* c_s, unsigned char* ws, LAS unsigned char* lds, int tid, int lane, int wave, int vcu, int G) {
    LAS float* scr = (LAS float*)(lds + wave * 16384);
    const int gw = vcu * NWAVES + wave, NGW = G * NWAVES;
    auto decode = [&](int it) -> TrItem {
        const int l = it / IT_LAYER; int r = it % IT_LAYER;
        unsigned char* wl = ws + WS_W + (size_t)l * W_LAYER;
        if (r < IT_IN) { const int kb = r / 128, nb = r % 128; return tr_item(w_in + (size_t)l * DM * INC, DM, INC, win_src_col(32 * nb), (bf16*)(wl + WO_IN), 32 * nb, kb, lane); } r -= IT_IN;
        if (r < IT_PE) { const int kb = r / 2, nb = r % 2; return tr_item(w_in + (size_t)l * DM * INC, DM, INC, 1024 + 32 * nb, (bf16*)(wl + WO_PE), 32 * nb, kb, lane); } r -= IT_PE;
        if (r < IT_UQ) { const int kb = r / 48, nb = r % 48; return tr_item(w_uq + (size_t)l * QLR * NQ, QLR, NQ, 32 * nb, (bf16*)(wl + WO_UQ), 32 * nb, kb, lane); } r -= IT_UQ;
        if (r < IT_UKV) { const int kb = r / 64, nb = r % 64; return tr_item(w_ukv + (size_t)l * KVLR * NKV, KVLR, NKV, 32 * nb, (bf16*)(wl + WO_UKV), 32 * nb, kb, lane); } r -= IT_UKV;
        if (r < IT_OUT) { const int kb = r / 64, nb = r % 64; return tr_item(w_out + (size_t)l * DM * DM, DM, DM, 32 * nb, (bf16*)(wl + WO_OUT), 32 * nb, kb, lane); } r -= IT_OUT;
        if (r < IT_UP) { const int kb = r / 256, nb = r % 256; return tr_item(w_up + (size_t)l * DM * DFF, DM, DFF, 32 * nb, (bf16*)(wl + WO_UP), 32 * nb, kb, lane); } r -= IT_UP;
        const int kb = r / 64, nb = r % 64; return tr_item(w_down + (size_t)l * DFF * DM, DFF, DM, 32 * nb, (bf16*)(wl + WO_DN), 32 * nb, kb, lane);
    };
    { int it = gw; float wa[32], wb[32]; TrItem cur, nxt;
      if (it < DEPTH * IT_LAYER) { cur = decode(it); tr_load(cur, wa); }
      while (it < DEPTH * IT_LAYER) {
          const int itn = it + NGW; const bool hn = itn < DEPTH * IT_LAYER;
          if (hn) { nxt = decode(itn); tr_load(nxt, wb); }
          tr_store(cur, wa, scr, lane);
          if (hn) {
#pragma unroll
              for (int i = 0; i < 32; ++i) wa[i] = wb[i];
              cur = nxt; }
          it = itn;
      }
    }
    const int gt = (vcu * NWAVES + wave) * 64 + lane, NGT = NGW * 64;
    float* sct = (float*)(ws + WS_SCT);
    for (int i = gt; i < NB * DM; i += NGT) { const int b = i / DM, k = i % DM; const float c = b < NBP ? c_p[b * DM + k] : c_s[(b - NBP) * DM + k];
        sct[k * 32 + b] = c / (1.0f + __expf(-c)); }
    for (int i = gt; i < DM * 8; i += NGT) sct[(i >> 3) * 32 + NB + (i & 7)] = 0.f;
    float* cosT = (float*)(ws + WS_COS); float* sinT = (float*)(ws + WS_SIN);
    for (int i = gt; i < NPOS * 32; i += NGT) { const int pos = i >> 5, fi = i & 31;
        double inv_d = 1.0; for (int q = 0; q < fi; ++q) inv_d *= 0.74989420933245582730;
        const float inv_f = (float)inv_d; const float ang = __fmul_rn((float)pos, inv_f);
        const double rev4 = (double)ang * 0.63661977236758134308;
        const double qd = __builtin_rint(rev4); const double y = (rev4 - qd) * 1.57079632679489661923;
        const double y2 = y * y;
        const double sy = y * (1.0 + y2 * (-1.0 / 6 + y2 * (1.0 / 120 + y2 * (-1.0 / 5040 + y2 * (1.0 / 362880 + y2 * (-1.0 / 39916800 + y2 * (1.0 / 6227020800.0)))))));
        const double cy = 1.0 + y2 * (-0.5 + y2 * (1.0 / 24 + y2 * (-1.0 / 720 + y2 * (1.0 / 40320 + y2 * (-1.0 / 3628800 + y2 * (1.0 / 479001600.0 + y2 * (-1.0 / 87178291200.0)))))));
        const int qi = ((int)qd) & 3;
        const double cv = qi == 0 ? cy : qi == 1 ? -sy : qi == 2 ? -cy : sy;
        const double sv = qi == 0 ? sy : qi == 1 ? cy : qi == 2 ? -sy : -cy;
        cosT[i] = (float)cv; sinT[i] = (float)sv; }
}
__device__ __forceinline__ void p1_mod(const float* w_ada, const float* b_ada, unsigned char* ws, LAS unsigned char* lds, int tid, int lane, int wave, int vcu, int G) {
    typedef float f32x16m __attribute__((ext_vector_type(16)));
    const float* sct = (const float*)(ws + WS_SCT); float* mod = (float*)(ws + WS_MOD);
    LAS float* Sl = (LAS float*)lds;
    const int n = lane & 31, kk = lane >> 5, ch = wave & 1, ks = wave >> 1;
    for (int it = (G == 256 ? ((vcu & 3) < 3 ? (vcu >> 2) * 3 + (vcu & 3) : DEPTH * (MODW / 256)) : vcu); it < DEPTH * (MODW / 256); it += G) {
        const int l = it / (MODW / 256), n0 = 256 * (it % (MODW / 256));
        f32x16m acc[4] = {};
        for (int q = 0; q < 4; ++q) {
            __syncthreads();
            { const GAS f32x4* src = (const GAS f32x4*)(sct + (size_t)q * 512 * 32) + tid; LAS f32x4* dst = (LAS f32x4*)Sl + tid;
#pragma unroll
              for (int j = 0; j < 8; ++j) dst[512 * j] = src[512 * j]; }
            __syncthreads();
            const float* wp = w_ada + ((size_t)l * DM + 512 * q + 128 * ks + kk) * MODW + n0 + 128 * ch + 4 * n;
            const LAS float* sp = Sl + (128 * ks + kk) * 32 + n;
#pragma unroll 1
            for (int i0 = 0; i0 < 64; i0 += 16) {
                f32x4 wv[16];
#pragma unroll
                for (int j = 0; j < 16; ++j) wv[j] = *(const GAS f32x4*)(wp + (size_t)(2 * (i0 + j)) * MODW);
                __builtin_amdgcn_sched_barrier(0);
#pragma unroll
                for (int j = 0; j < 16; ++j) { const float a = sp[2 * (i0 + j) * 32];
                    acc[0] = __builtin_amdgcn_mfma_f32_32x32x2f32(a, wv[j].x, acc[0], 0, 0, 0); acc[1] = __builtin_amdgcn_mfma_f32_32x32x2f32(a, wv[j].y, acc[1], 0, 0, 0);
                    acc[2] = __builtin_amdgcn_mfma_f32_32x32x2f32(a, wv[j].z, acc[2], 0, 0, 0); acc[3] = __builtin_amdgcn_mfma_f32_32x32x2f32(a, wv[j].w, acc[3], 0, 0, 0); }
            }
        }
        __syncthreads();
        LAS float* red = (LAS float*)lds;
#pragma unroll
        for (int t = 0; t < 4; ++t)
#pragma unroll
            for (int r = 0; r < 16; ++r) red[((wave * 4 + t) * 16 + r) * 64 + lane] = acc[t][r];
        __syncthreads();
        for (int i = tid; i < 8192; i += NWAVES * 64) { const int cch = i >> 12, t = (i >> 10) & 3, r = (i >> 6) & 15, L = i & 63; const int bb = (r & 3) + 8 * (r >> 2) + 4 * (L >> 5), c = n0 + 128 * cch + 4 * (L & 31) + t;
            if (bb < NB) { float sum = b_ada[(size_t)l * MODW + c];
#pragma unroll
                for (int k4 = 0; k4 < 4; ++k4) sum += red[(((2 * k4 + cch) * 4 + t) * 16 + r) * 64 + L];
                mod[((size_t)l * NB + bb) * MODW + c] = sum; } }
    }
    __syncthreads();
}
__device__ __forceinline__ void unpk8f(const v4u& w, f32x4& a, f32x4& b) {
    a = (f32x4){bf_lo(w.x), bf_hi(w.x), bf_lo(w.y), bf_hi(w.y)}; b = (f32x4){bf_lo(w.z), bf_hi(w.z), bf_lo(w.w), bf_hi(w.w)};
}
template <bool F32IN> __device__ __forceinline__ void norm_load(const void* xb, int row, int lane, f32x4 (&v)[8]) {
    if (F32IN) { const GAS f32x4* x4 = (const GAS f32x4*)((const float*)xb + (size_t)row * DM) + 2 * lane;
#pragma unroll
        for (int j = 0; j < 4; ++j) { v[2 * j] = x4[128 * j]; v[2 * j + 1] = x4[128 * j + 1]; } }
    else { const GAS v4u* x8 = (const GAS v4u*)((const bf16*)xb + (size_t)row * DM) + lane;
#pragma unroll
        for (int j = 0; j < 4; ++j) { const v4u w = x8[64 * j]; unpk8f(w, v[2 * j], v[2 * j + 1]); } }
}
template <bool F32IN> __device__ __forceinline__ void norm_rows(const void* xb, const float* modl, int sh_off, int sc_off, bf16* H, int lane, int gw, int NGW) {
    for (int r0 = gw * 8; r0 < MP; r0 += NGW * 8) {
        const int b = r0 >> 11;
        const GAS f32x4* sc4 = (const GAS f32x4*)(modl + (size_t)b * MODW + sc_off) + 2 * lane; const GAS f32x4* sh4 = (const GAS f32x4*)(modl + (size_t)b * MODW + sh_off) + 2 * lane;
        f32x4 sc[8], sh[8];
#pragma unroll
        for (int j = 0; j < 4; ++j) { sc[2 * j] = sc4[128 * j] + 1.f; sc[2 * j + 1] = sc4[128 * j + 1] + 1.f; sh[2 * j] = sh4[128 * j]; sh[2 * j + 1] = sh4[128 * j + 1]; }
        if constexpr (!F32IN) {
            const GAS v4u* x8 = (const GAS v4u*)((const bf16*)xb + (size_t)r0 * DM) + lane;
            v4u raw[4][4];
#pragma unroll
            for (int d = 0; d < 4; ++d)
#pragma unroll
                for (int j = 0; j < 4; ++j) raw[d][j] = x8[256 * d + 64 * j];
#pragma unroll
            for (int i = 0; i < 8; ++i) {
                f32x4 cur[8];
#pragma unroll
                for (int j = 0; j < 4; ++j) unpk8f(raw[i & 3][j], cur[2 * j], cur[2 * j + 1]);
                if (i + 4 < 8) {
#pragma unroll
                    for (int j = 0; j < 4; ++j) raw[i & 3][j] = x8[256 * (i + 4) + 64 * j]; }
                float s = 0.f;
#pragma unroll
                for (int j = 0; j < 8; ++j) s += (cur[j].x * cur[j].x + cur[j].y * cur[j].y) + (cur[j].z * cur[j].z + cur[j].w * cur[j].w);
                const float rstd = 1.0f / sqrtf(wave_sum(s) * (1.f / DM) + EPS);
                GAS v4u* o8 = (GAS v4u*)(H + (size_t)(r0 + i) * DM) + lane;
#pragma unroll
                for (int j = 0; j < 4; ++j) { const f32x4 y0 = cur[2 * j] * rstd * sc[2 * j] + sh[2 * j], y1 = cur[2 * j + 1] * rstd * sc[2 * j + 1] + sh[2 * j + 1];
                    v4u o; o.x = pkbf(y0.x, y0.y); o.y = pkbf(y0.z, y0.w); o.z = pkbf(y1.x, y1.y); o.w = pkbf(y1.z, y1.w); o8[64 * j] = o; }
            }
        } else if (true) {
            const GAS f32x4* x4 = (const GAS f32x4*)((const float*)xb + (size_t)r0 * DM) + 2 * lane;
            f32x4 raw[2][8];
#pragma unroll
            for (int d = 0; d < 2; ++d)
#pragma unroll
                for (int j = 0; j < 4; ++j) { raw[d][2 * j] = x4[512 * d + 128 * j]; raw[d][2 * j + 1] = x4[512 * d + 128 * j + 1]; }
#pragma unroll
            for (int i = 0; i < 8; ++i) {
                f32x4 cur[8];
#pragma unroll
                for (int j = 0; j < 8; ++j) cur[j] = raw[i & 1][j];
                if (i + 2 < 8) {
#pragma unroll
                    for (int j = 0; j < 4; ++j) { raw[i & 1][2 * j] = x4[512 * (i + 2) + 128 * j]; raw[i & 1][2 * j + 1] = x4[512 * (i + 2) + 128 * j + 1]; } }
                float s = 0.f;
#pragma unroll
                for (int j = 0; j < 8; ++j) s += (cur[j].x * cur[j].x + cur[j].y * cur[j].y) + (cur[j].z * cur[j].z + cur[j].w * cur[j].w);
                const float rstd = 1.0f / sqrtf(wave_sum(s) * (1.f / DM) + EPS);
                GAS v4u* o8 = (GAS v4u*)(H + (size_t)(r0 + i) * DM) + lane;
#pragma unroll
                for (int j = 0; j < 4; ++j) { const f32x4 y0 = cur[2 * j] * rstd * sc[2 * j] + sh[2 * j], y1 = cur[2 * j + 1] * rstd * sc[2 * j + 1] + sh[2 * j + 1];
                    v4u o; o.x = pkbf(y0.x, y0.y); o.y = pkbf(y0.z, y0.w); o.z = pkbf(y1.x, y1.y); o.w = pkbf(y1.z, y1.w); o8[64 * j] = o; }
            }
        } else {
        f32x4 cur[8], nxt[8];
        norm_load<F32IN>(xb, r0, lane, cur);
#pragma unroll 1
        for (int i = 0; i < 8; ++i) {
            const int row = r0 + i;
            norm_load<F32IN>(xb, i < 7 ? row + 1 : row, lane, nxt);
            float s = 0.f;
#pragma unroll
            for (int j = 0; j < 8; ++j) s += (cur[j].x * cur[j].x + cur[j].y * cur[j].y) + (cur[j].z * cur[j].z + cur[j].w * cur[j].w);
            const float rstd = 1.0f / sqrtf(wave_sum(s) * (1.f / DM) + EPS);
            GAS v4u* o8 = (GAS v4u*)(H + (size_t)row * DM) + lane;
#pragma unroll
            for (int j = 0; j < 4; ++j) { const f32x4 y0 = cur[2 * j] * rstd * sc[2 * j] + sh[2 * j], y1 = cur[2 * j + 1] * rstd * sc[2 * j + 1] + sh[2 * j + 1];
                v4u o; o.x = pkbf(y0.x, y0.y); o.y = pkbf(y0.z, y0.w); o.z = pkbf(y1.x, y1.y); o.w = pkbf(y1.z, y1.w); o8[64 * j] = o; }
#pragma unroll
            for (int j = 0; j < 8; ++j) cur[j] = nxt[j];
        }
        }
    }
}
__device__ __forceinline__ void final_norm_rows(const bf16* XB, const float* gain, float* out, int lane, int gw, int NGW) {
    const GAS f32x4* g4 = (const GAS f32x4*)gain + 2 * lane; f32x4 g[8];
#pragma unroll
    for (int j = 0; j < 4; ++j) { g[2 * j] = g4[128 * j]; g[2 * j + 1] = g4[128 * j + 1]; }
    for (int r0 = gw * 8; r0 < MP; r0 += NGW * 8) {
        const GAS v4u* x8 = (const GAS v4u*)(XB + (size_t)r0 * DM) + lane;
        v4u raw[2][4];
#pragma unroll
        for (int d = 0; d < 2; ++d)
#pragma unroll
            for (int j = 0; j < 4; ++j) raw[d][j] = x8[256 * d + 64 * j];
#pragma unroll
        for (int i = 0; i < 8; ++i) {
            f32x4 cur[8];
#pragma unroll
            for (int j = 0; j < 4; ++j) unpk8f(raw[i & 1][j], cur[2 * j], cur[2 * j + 1]);
            if (i + 2 < 8) {
#pragma unroll
                for (int j = 0; j < 4; ++j) raw[i & 1][j] = x8[256 * (i + 2) + 64 * j]; }
            float s = 0.f;
#pragma unroll
            for (int j = 0; j < 8; ++j) s += (cur[j].x * cur[j].x + cur[j].y * cur[j].y) + (cur[j].z * cur[j].z + cur[j].w * cur[j].w);
            const float rstd = 1.0f / sqrtf(wave_sum(s) * (1.f / DM) + EPS);
            GAS f32x4* o4 = (GAS f32x4*)(out + (size_t)(r0 + i) * DM) + 2 * lane;
#pragma unroll
            for (int j = 0; j < 4; ++j) { o4[128 * j] = cur[2 * j] * rstd * g[2 * j]; o4[128 * j + 1] = cur[2 * j + 1] * rstd * g[2 * j + 1]; }
        }
    }
}
__device__ __forceinline__ void elt_kpe(const bf16* H, const bf16* WPE, bf16* KPE, const float* cosT, const float* sinT, float* outp, float* outs, LAS unsigned char* lds,
                                        int tid, int lane, int wave, int vcu, int G) {
    typedef float f32x16 __attribute__((ext_vector_type(16)));
    constexpr int PITCH = 1040, WOFF = 64 * PITCH;
    LAS float* red = (LAS float*)lds;
    const int r32 = lane & 31, hi = lane >> 5, rt = wave & 1, ct = (wave >> 1) & 1, kh = wave >> 2;
    for (int it = vcu; it < MP / 64; it += G) {
        const int R0 = 64 * it;
        f32x16 acc = {};
        for (int kc = 0; kc < 4; ++kc) {
#pragma unroll
            for (int j = 0; j < 8; ++j) { const int i = wave + 8 * j;
                const bf16* hsrc = R0 < MP ? H + (size_t)(R0 + i) * DM + 512 * kc + lane * 8 : H + (size_t)MP * DM + ((size_t)(16 * kc + (lane >> 2)) * 256 + (R0 - MP + i)) * 32 + 8 * (lane & 3);
                __builtin_amdgcn_global_load_lds((const unsigned*)hsrc, (LAS unsigned*)(lds + i * PITCH), 16, 0, 0);
                __builtin_amdgcn_global_load_lds((const unsigned*)(WPE + (size_t)i * DM + 512 * kc + lane * 8), (LAS unsigned*)(lds + WOFF + i * PITCH), 16, 0, 0); }
            asm volatile("s_waitcnt vmcnt(0)" ::: "memory");
            __syncthreads();
            const LAS unsigned char* ap = lds + (32 * rt + r32) * PITCH + (256 * kh + 8 * hi) * 2;
            const LAS unsigned char* bp = lds + WOFF + (32 * ct + r32) * PITCH + (256 * kh + 8 * hi) * 2;
#pragma unroll
            for (int s = 0; s < 16; ++s) acc = __builtin_amdgcn_mfma_f32_32x32x16_bf16(*(const LAS bf16x8*)(ap + 32 * s), *(const LAS bf16x8*)(bp + 32 * s), acc, 0, 0, 0);
            __syncthreads();
        }
#pragma unroll
        for (int r = 0; r < 16; ++r) red[(wave * 16 + r) * 64 + lane] = acc[r];
        __syncthreads();
        if (wave < 2) {
#pragma unroll
            for (int r = 0; r < 16; ++r) {
                const float x1 = red[((rt + 0) * 16 + r) * 64 + lane] + red[((rt + 4) * 16 + r) * 64 + lane];
                const float x2 = red[((rt + 2) * 16 + r) * 64 + lane] + red[((rt + 6) * 16 + r) * 64 + lane];
                const int row = R0 + 32 * rt + (r & 3) + 8 * (r >> 2) + 4 * hi, pos = row_pos(row);
                const float cs = cosT[pos * 32 + r32], sn = sinT[pos * 32 + r32];
                const float o1 = x1 * cs - x2 * sn, o2 = x2 * cs + x1 * sn;
                float* of = row < MP ? outp + (size_t)row * 64 : outs + (size_t)(row - MP) * 64;
                of[r32] = o1; of[32 + r32] = o2;
                const size_t kr = row < MP ? (size_t)row : (size_t)KVROW_S + (row - MP);
                KPE[kr * 64 + r32] = (bf16)(pkbf(o1, 0.f) & 0xffffu); KPE[kr * 64 + 32 + r32] = (bf16)(pkbf(o2, 0.f) & 0xffffu); }
        }
        __syncthreads();
    }
}
struct EltRow { v4u q, kv, c0a, c0b, c1a, c1b, c2a, c2b, ba, bb; };
__device__ __forceinline__ EltRow elt_load(const bf16* Z, int row, int lane) {
    const bf16* zr = Z + (size_t)row * ZW; const int t = row & (SEQ - 1), c0 = 16 * lane;
    const bf16* z1 = t >= 1 ? zr - ZW : zr; const bf16* z2 = t >= 2 ? zr - 2 * ZW : zr;
    EltRow r;
    r.q = *(const GAS v4u*)(zr + 8 * lane); r.kv = *(const GAS v4u*)(zr + 512 + 8 * lane);
    r.c0a = *(const GAS v4u*)(zr + 1024 + c0); r.c0b = *(const GAS v4u*)(zr + 1024 + c0 + 8);
    r.c1a = *(const GAS v4u*)(z1 + 1024 + c0); r.c1b = *(const GAS v4u*)(z1 + 1024 + c0 + 8);
    r.c2a = *(const GAS v4u*)(z2 + 1024 + c0); r.c2b = *(const GAS v4u*)(z2 + 1024 + c0 + 8);
    r.ba = *(const GAS v4u*)(zr + 2048 + c0); r.bb = *(const GAS v4u*)(zr + 2048 + c0 + 8);
    return r;
}
__device__ __forceinline__ void unpk8(const v4u& w, float* x) {
#pragma unroll
    for (int i = 0; i < 4; ++i) { x[2 * i] = bf_lo(w[i]); x[2 * i + 1] = bf_hi(w[i]); }
}
__device__ __forceinline__ void elt_rows(const bf16* Z, const float* q_norm, const float* kv_norm, const float* conv_w, const float* conv_norm, const float* state_conv_l,
                                         bf16* QN, bf16* CKV, bf16* MIX, float* ockv_p, float* ockv_s, float* oconv_p, float* oconv_s, const float* ckv_cache_l, int lane, int gw  , int NGW  , int rend = MP  ) {
    (void)state_conv_l; (void)ockv_s; (void)oconv_s; (void)ckv_cache_l;
    if (gw >= rend) return;
    const int c0 = 16 * lane;
    const f32x4 qg0 = *(const GAS f32x4*)(q_norm + 8 * lane), qg1 = *(const GAS f32x4*)(q_norm + 8 * lane + 4);
    const f32x4 kg0 = *(const GAS f32x4*)(kv_norm + 8 * lane), kg1 = *(const GAS f32x4*)(kv_norm + 8 * lane + 4);
    EltRow cur = elt_load(Z, gw, lane);
    for (int row = gw; row < rend; row += NGW) {
        const int nrow = row + NGW < rend ? row + NGW : row;
        const EltRow nxt = elt_load(Z, nrow, lane);
        const int t = row & (SEQ - 1), b = row >> 11;
        { float x[8]; unpk8(cur.q, x); float s = 0.f;
#pragma unroll
          for (int i = 0; i < 8; ++i) s += x[i] * x[i];
          const float rstd = 1.0f / sqrtf(wave_sum(s) * (1.f / QLR) + EPS);
          v4u o; o.x = pkbf(x[0] * rstd * qg0.x, x[1] * rstd * qg0.y); o.y = pkbf(x[2] * rstd * qg0.z, x[3] * rstd * qg0.w); o.z = pkbf(x[4] * rstd * qg1.x, x[5] * rstd * qg1.y); o.w = pkbf(x[6] * rstd * qg1.z, x[7] * rstd * qg1.w);
          *(GAS v4u*)(QN + (size_t)row * QLR + 8 * lane) = o; }
        { float x[8]; unpk8(cur.kv, x); float s = 0.f;
#pragma unroll
          for (int i = 0; i < 8; ++i) s += x[i] * x[i];
          const float rstd = 1.0f / sqrtf(wave_sum(s) * (1.f / KVLR) + EPS);
          const f32x4 y0 = {x[0] * rstd * kg0.x, x[1] * rstd * kg0.y, x[2] * rstd * kg0.z, x[3] * rstd * kg0.w}, y1 = {x[4] * rstd * kg1.x, x[5] * rstd * kg1.y, x[6] * rstd * kg1.z, x[7] * rstd * kg1.w};
          float* of = ockv_p + (size_t)row * KVLR;
          *(GAS f32x4*)(of + 8 * lane) = y0; *(GAS f32x4*)(of + 8 * lane + 4) = y1;
          v4u o; o.x = pkbf(y0.x, y0.y); o.y = pkbf(y0.z, y0.w); o.z = pkbf(y1.x, y1.y); o.w = pkbf(y1.z, y1.w);
          *(GAS v4u*)(CKV + (size_t)row * KVLR + 8 * lane) = o; }
        { float cu[16], f1[16], f0[16], gb[16];
          unpk8(cur.c0a, cu); unpk8(cur.c0b, cu + 8); unpk8(cur.c1a, f1); unpk8(cur.c1b, f1 + 8); unpk8(cur.c2a, f0); unpk8(cur.c2b, f0 + 8); unpk8(cur.ba, gb); unpk8(cur.bb, gb + 8);
          const float m1 = t >= 1 ? 1.f : 0.f, m0 = t >= 2 ? 1.f : 0.f;
          float o[16]; float s = 0.f;
#pragma unroll
          for (int i = 0; i < 16; ++i) { const float y = conv_w[c0 + i] * (f0[i] * m0) + conv_w[DCONV + c0 + i] * (f1[i] * m1) + conv_w[2 * DCONV + c0 + i] * cu[i]; o[i] = gb[i] * y; s += o[i] * o[i]; }
          const float rstd = 1.0f / sqrtf(wave_sum(s) * (1.f / DCONV) + EPS);
          v4u p0, p1;
#pragma unroll
          for (int i = 0; i < 4; ++i) { p0[i] = pkbf(o[2 * i] * rstd * conv_norm[c0 + 2 * i], o[2 * i + 1] * rstd * conv_norm[c0 + 2 * i + 1]);
                                        p1[i] = pkbf(o[8 + 2 * i] * rstd * conv_norm[c0 + 8 + 2 * i], o[8 + 2 * i + 1] * rstd * conv_norm[c0 + 8 + 2 * i + 1]); }
          *(GAS v4u*)(MIX + (size_t)row * DM + DATT + c0) = p0; *(GAS v4u*)(MIX + (size_t)row * DM + DATT + c0 + 8) = p1;
          if (t >= SEQ - 2) { float* oc = oconv_p + ((size_t)b * 2 + (t - (SEQ - 2))) * DCONV + c0;
#pragma unroll
            for (int i = 0; i < 4; ++i) *(GAS f32x4*)(oc + 4 * i) = (f32x4){cu[4 * i], cu[4 * i + 1], cu[4 * i + 2], cu[4 * i + 3]}; }
        }
        cur = nxt;
    }
}
__device__ __forceinline__ void elt_cache(const float* kpe_l, bf16* KPE, int gt, int NGT) {
    constexpr int N2 = MC * 64 / 8;
    for (int i = gt; i < N2; i += NGT) { const f32x8v x = *(const GAS f32x8v*)(kpe_l + (size_t)i * 8);
        v4u o; o.x = pkbf(x[0], x[1]); o.y = pkbf(x[2], x[3]); o.z = pkbf(x[4], x[5]); o.w = pkbf(x[6], x[7]); *(GAS v4u*)(KPE + (size_t)KVROW_C * 64 + (size_t)i * 8) = o; }
}
__device__ __forceinline__ void anorm_rows(bf16* MIX, const float* gain, int lane, int row0, int stride, int rend) {
    float gn[16];
#pragma unroll
    for (int i = 0; i < 4; ++i) { const f32x4 g4 = *(const GAS f32x4*)(gain + 16 * lane + 4 * i); gn[4 * i] = g4.x; gn[4 * i + 1] = g4.y; gn[4 * i + 2] = g4.z; gn[4 * i + 3] = g4.w; }
    if (row0 >= rend) return;
    const size_t rs = (size_t)stride * DM;
    bf16* mr = MIX + (size_t)row0 * DM + 16 * lane;
    v4u a0 = *(const GAS v4u*)mr, a1 = *(const GAS v4u*)(mr + 8), b0 = a0, b1 = a1;
    if (row0 + stride < rend) { b0 = *(const GAS v4u*)(mr + rs); b1 = *(const GAS v4u*)(mr + rs + 8); }
    for (int row = row0; row < rend; row += stride) {
        v4u c0 = b0, c1 = b1;
        if (row + 2 * stride < rend) { c0 = *(const GAS v4u*)(mr + 2 * rs); c1 = *(const GAS v4u*)(mr + 2 * rs + 8); }
        float x[16];
#pragma unroll
        for (int i = 0; i < 4; ++i) { x[2 * i] = bf_lo(a0[i]); x[2 * i + 1] = bf_hi(a0[i]); x[8 + 2 * i] = bf_lo(a1[i]); x[8 + 2 * i + 1] = bf_hi(a1[i]); }
        float s = 0.f;
#pragma unroll
        for (int i = 0; i < 16; ++i) s += x[i] * x[i];
        const float rstd = 1.0f / sqrtf(wave_sum(s) * (1.f / DATT) + EPS);
        v4u p0, p1;
#pragma unroll
        for (int i = 0; i < 4; ++i) { p0[i] = pkbf(x[2 * i] * rstd * gn[2 * i], x[2 * i + 1] * rstd * gn[2 * i + 1]);
                                      p1[i] = pkbf(x[8 + 2 * i] * rstd * gn[8 + 2 * i], x[8 + 2 * i + 1] * rstd * gn[8 + 2 * i + 1]); }
        *(GAS v4u*)mr = p0; *(GAS v4u*)(mr + 8) = p1;
        a0 = b0; a1 = b1; b0 = c0; b1 = c1; mr += rs;
    }
}
__device__ __forceinline__ void sattn_unit(int b, int h, const bf16* Qs  , const bf16* KVb, const bf16* KVn  , const bf16* KPb, bf16* Ob, const float* cosT, const float* sinT, LAS unsigned char* lds, int tid, int lane, int wave) {
    constexpr int NKEY = PAST + TS;
    LAS float* S = (LAS float*)lds; LAS float* invl = (LAS float*)(lds + NKEY * 64);
    const int qi = lane & 15, g = lane >> 4;
    const int qrow0 = MP + b * TS;
    bf16x8 qf[6];
#if defined(SQ_RM) && !defined(SQ_QKB)
    { const bf16* qp = Qs + (size_t)(b * TS + qi) * NQ + h * QKD + 8 * g;
#pragma unroll
      for (int s = 0; s < 6; ++s) qf[s] = *(const bf16x8*)(qp + 32 * s);
#else
    { const bf16* qp = Qs + ((size_t)(h * 6) * 256 + b * TS + qi) * 32 + 8 * g;
#pragma unroll
      for (int s = 0; s < 6; ++s) qf[s] = *(const bf16x8*)(qp + s * 8192);
#endif
      const int pos = PAST + qi; const float* cp = cosT + pos * 32 + 8 * g; const float* sp = sinT + pos * 32 + 8 * g;
      const v4u x1 = *reinterpret_cast<const v4u*>(&qf[4]), x2 = *reinterpret_cast<const v4u*>(&qf[5]); v4u y1, y2;
#pragma unroll
      for (int w = 0; w < 4; ++w) { const float ca = cp[2 * w], cb = cp[2 * w + 1], sa = sp[2 * w], sb = sp[2 * w + 1];
          const float a1 = bf_lo(x1[w]), b1 = bf_hi(x1[w]), a2 = bf_lo(x2[w]), b2 = bf_hi(x2[w]);
          y1[w] = pkbf(a1 * ca - a2 * sa, b1 * cb - b2 * sb); y2[w] = pkbf(a2 * ca + a1 * sa, b2 * cb + b1 * sb); }
      qf[4] = *reinterpret_cast<const bf16x8*>(&y1); qf[5] = *reinterpret_cast<const bf16x8*>(&y2); }
#pragma unroll 1
    for (int i0 = 0; i0 < 16; i0 += 2) {
        bf16x8 kf[2][6];
#pragma unroll
        for (int u = 0; u < 2; ++u) { const int key = 16 * (wave + 8 * (i0 + u)) + qi; const size_t krow = (size_t)KVROW_C + (size_t)b * PAST + key;
            const bf16* kn = KVb + krow * NKV + h * 256 + 8 * g; const bf16* kp = KPb + krow * 64 + 8 * g;
#pragma unroll
            for (int s = 0; s < 4; ++s) kf[u][s] = *(const GAS bf16x8*)(kn + 32 * s);
            kf[u][4] = *(const GAS bf16x8*)kp; kf[u][5] = *(const GAS bf16x8*)(kp + 32); }
#pragma unroll
        for (int u = 0; u < 2; ++u) { const int tt = wave + 8 * (i0 + u); f32x4 acc = {0.f, 0.f, 0.f, 0.f};
#pragma unroll
            for (int s = 0; s < 6; ++s) acc = __builtin_amdgcn_mfma_f32_16x16x32_bf16(kf[u][s], qf[s], acc, 0, 0, 0);
#pragma unroll
            for (int r = 0; r < 4; ++r) S[(16 * tt + 4 * g + r) * 16 + qi] = acc[r] * (ATTN_SCALE * LOG2E); }
    }
    if (wave == 0) {
        const bf16* kn = KVn + ((size_t)(h * 8) * 256 + b * TS + qi) * 32 + 8 * g; const bf16* kp = KPb + ((size_t)KVROW_S + b * TS + qi) * 64 + 8 * g;
        f32x4 acc = {0.f, 0.f, 0.f, 0.f};
#pragma unroll
        for (int s = 0; s < 4; ++s) acc = __builtin_amdgcn_mfma_f32_16x16x32_bf16(*(const GAS bf16x8*)(kn + 8192 * s), qf[s], acc, 0, 0, 0);
#pragma unroll
        for (int s = 0; s < 2; ++s) acc = __builtin_amdgcn_mfma_f32_16x16x32_bf16(*(const GAS bf16x8*)(kp + 32 * s), qf[4 + s], acc, 0, 0, 0);
#pragma unroll
        for (int r = 0; r < 4; ++r) S[(PAST + 4 * g + r) * 16 + qi] = acc[r] * (ATTN_SCALE * LOG2E);
    }
    __syncthreads();
    for (int q = 2 * wave; q < 2 * wave + 2; ++q) {
        float m = -INFINITY;
        for (int k = lane; k < NKEY; k += 64) m = fmaxf(m, S[k * 16 + q]);
        m = wave_max(m);
        float s = 0.f;
        for (int k = lane; k < NKEY; k += 64) { const float p = __builtin_amdgcn_exp2f(S[k * 16 + q] - m); S[k * 16 + q] = p; s += p; }
        s = wave_sum(s);
        if (lane == 0) invl[q] = 1.0f / s;
    }
    __syncthreads();
    { const int vc4 = tid & 31, ks = tid >> 5;
      float o[16][4];
#pragma unroll
      for (int q = 0; q < 16; ++q)
#pragma unroll
          for (int c = 0; c < 4; ++c) o[q][c] = 0.f;
#define SPV_FMA(W_, KEY_) do { float v[4]; v[0] = bf_lo((unsigned)(W_)); v[1] = bf_hi((unsigned)(W_)); v[2] = bf_lo((unsigned)((W_) >> 32)); v[3] = bf_hi((unsigned)((W_) >> 32)); \
          const LAS f32x4* p4 = (const LAS f32x4*)(S + (KEY_) * 16); \
          _Pragma("unroll") for (int qq = 0; qq < 4; ++qq) { const f32x4 p = p4[qq]; \
              _Pragma("unroll") for (int c = 0; c < 4; ++c) { o[4 * qq][c] = fmaf(p.x, v[c], o[4 * qq][c]); o[4 * qq + 1][c] = fmaf(p.y, v[c], o[4 * qq + 1][c]); o[4 * qq + 2][c] = fmaf(p.z, v[c], o[4 * qq + 2][c]); o[4 * qq + 3][c] = fmaf(p.w, v[c], o[4 * qq + 3][c]); } } } while (0)
      {
        const __amdgpu_buffer_rsrc_t rs = __builtin_amdgcn_make_buffer_rsrc((void*)KVb, 0, (unsigned)((size_t)MKV * NKV * 2), 0x00020000);
        const unsigned voff = (unsigned)((ks * NKV + 4 * vc4) * 2);
        const unsigned sb0 = (unsigned)((((size_t)KVROW_C + (size_t)b * PAST) * NKV + h * 256 + 128) * 2);
        typedef unsigned u32x2v __attribute__((ext_vector_type(2)));
#pragma unroll 1
        for (int i0 = 0; i0 < 128; i0 += 4) {
            unsigned long long w[4];
#pragma unroll
            for (int u = 0; u < 4; ++u) w[u] = __builtin_bit_cast(unsigned long long, __builtin_amdgcn_raw_buffer_load_b64(rs, voff, sb0 + (unsigned)(16 * (i0 + u)) * (NKV * 2), 0));
#pragma unroll
            for (int u = 0; u < 4; ++u) { SPV_FMA(w[u], ks + 16 * (i0 + u)); if (u & 1) __builtin_amdgcn_sched_barrier(0); }
        }
        int vcl = vc4; asm volatile("" : "+v"(vcl));
        const unsigned long long wn = *(const GAS unsigned long long*)(KVn + ((size_t)(h * 8 + 4 + (vcl >> 3)) * 256 + b * TS + ks) * 32 + ((4 * vcl) & 31));
        SPV_FMA(wn, PAST + ks); }
#undef SPV_FMA
      int ln2; asm volatile("v_mbcnt_lo_u32_b32 %0, -1, 0\n\tv_mbcnt_hi_u32_b32 %0, -1, %0" : "=v"(ln2)); const int tid2 = wave * 64 + ln2, vc4b = tid2 & 31;
#pragma unroll
      for (int q = 0; q < 16; ++q)
#pragma unroll
          for (int c = 0; c < 4; ++c) o[q][c] = half_swap_add(o[q][c]);
      __syncthreads();
      LAS float* red = (LAS float*)lds;
      if (ln2 < 32) {
#pragma unroll
          for (int q = 0; q < 16; ++q) *(LAS f32x4*)(red + (wave * 16 + q) * 128 + 4 * vc4b) = (f32x4){o[q][0], o[q][1], o[q][2], o[q][3]}; }
      const float il = invl[tid2 >> 5];
      __syncthreads();
      { int tl2 = tid2; const int q = tl2 >> 5, c4 = (tl2 & 31) * 4; f32x4 acc = {0.f, 0.f, 0.f, 0.f};
#pragma unroll
        for (int w = 0; w < NWAVES; ++w) acc += *(const LAS f32x4*)(red + (w * 16 + q) * 128 + c4);
        acc = acc * il;
        unsigned long long pk = (unsigned long long)pkbf(acc.x, acc.y) | ((unsigned long long)pkbf(acc.z, acc.w) << 32);
        *(GAS unsigned long long*)(Ob + ((size_t)(4 * h + (c4 >> 5)) * 256 + b * TS + q) * 32 + (c4 & 31)) = pk; }
    }
    __syncthreads();
}

typedef float f32x16v __attribute__((ext_vector_type(16)));
struct SEpiPart {
    float* P; int ldp;
    __device__ __forceinline__ void operator()(const f32x16v& acc, int wave, int r32, int hi, int n0) const {
#pragma unroll
        for (int r = 0; r < 16; ++r) { const int row = 32 * wave + (r & 3) + 8 * (r >> 2) + 4 * hi; P[(size_t)row * ldp + n0 + r32] = acc[r]; }
    }
};
template <int ACT> struct SEpiBf {
    bf16* O; int badd = 0;
    __device__ __forceinline__ void operator()(const f32x16v& acc, int wave, int r32, int hi, int n0) const {
        bf16* ob = O + (size_t)((n0 >> 5) + badd) * (256 * 32) + r32;
#pragma unroll
        for (int r = 0; r < 16; ++r) { const int row = 32 * wave + (r & 3) + 8 * (r >> 2) + 4 * hi; float v = acc[r]; if (ACT == 1) { v = v > 0.f ? v : 0.f; v = v * v; }
            ob[row * 32] = (bf16)(pkbf(v, 0.f) & 0xffffu); }
    }
};
__device__ __forceinline__ size_t kb32(int row, int k) { return ((size_t)(k >> 5) * 256 + row) * 32 + (k & 31); }
template <class Epi> __device__ __forceinline__ void sgemm_unit(LAS unsigned char* lds, const bf16* A  , const bf16* Bt, int ldb, int n0, int k0, int Kc, const Epi& E, int lane, int wave) {
    const int r32 = lane & 31, hi = lane >> 5;
    const int rowB = Kc * 2 + 16, cpr = Kc / 512;
    const __amdgpu_buffer_rsrc_t arsrc = __builtin_amdgcn_make_buffer_rsrc((void*)A, 0, 0x7fffffff, 0x00020000);
    const unsigned avoff = (unsigned)((r32 * 32 + 8 * hi) * 2);
    const unsigned asoff = (unsigned)((((k0 >> 5) * 256 + 32 * wave) * 32) * 2);
#define SG_ALOAD(i) __builtin_bit_cast(bf16x8, __builtin_amdgcn_raw_buffer_load_b128(arsrc, avoff, asoff + (unsigned)(((i) >> 1) * 16384 + ((i) & 1) * 32), 0))
    bf16x8 a0[8], a1[8];
#pragma unroll
    for (int i = 0; i < 8; ++i) a0[i] = SG_ALOAD(i);
    for (int ch = wave; ch < 32 * cpr; ch += NWAVES) { const int c = ch / cpr, qd = ch % cpr;
        __builtin_amdgcn_global_load_lds((const unsigned*)(Bt + (size_t)(n0 + c) * ldb + k0 + qd * 512 + lane * 8), (LAS unsigned*)(lds + c * rowB + qd * 1024), 16, 0, 0); }
    asm volatile("s_waitcnt vmcnt(0)" ::: "memory");
    __syncthreads();
    f32x16v acc = {};
    const LAS unsigned char* Bp = lds + r32 * rowB + 16 * hi;
    for (int s = 0; s < Kc / 16; s += 16) {
#pragma unroll
        for (int i = 0; i < 8; ++i) a1[i] = SG_ALOAD(s + 8 + i);
#pragma unroll
        for (int i = 0; i < 8; ++i) acc = __builtin_amdgcn_mfma_f32_32x32x16_bf16(a0[i], *(const LAS bf16x8*)(Bp + 32 * (s + i)), acc, 0, 0, 0);
        if (s + 16 < Kc / 16) {
#pragma unroll
            for (int i = 0; i < 8; ++i) a0[i] = SG_ALOAD(s + 16 + i); }
#pragma unroll
        for (int i = 0; i < 8; ++i) acc = __builtin_amdgcn_mfma_f32_32x32x16_bf16(a1[i], *(const LAS bf16x8*)(Bp + 32 * (s + 8 + i)), acc, 0, 0, 0);
    }
    E(acc, wave, r32, hi, n0);
#undef SG_ALOAD
    __syncthreads();
}
__device__ __forceinline__ void elt_rows_s(const float* ZS, const float* q_norm, const float* kv_norm, const float* conv_w, const float* conv_norm, const float* state_conv_l,
                                           bf16* QNs, bf16* CKVs, bf16* MIXs  , float* ockv_s, float* oconv_s, int lane, int gw, int NGW,
                                           const float* KS  , bf16* KPEs  , float* okpe_s, const float* cosT, const float* sinT,
                                           int part = -1  ) {
    for (int r = gw; r < MS; r += NGW) {
        const int t = r & (TS - 1), b = r >> 4;
        if (lane < 32 && (part < 0 || part == 0)) {
            const float* k0 = KS + (size_t)r * 64; const float* k1 = k0 + (size_t)MS * 64; const float* k2 = k1 + (size_t)MS * 64; const float* k3 = k2 + (size_t)MS * 64;
            const float x1 = (k0[lane] + k1[lane]) + (k2[lane] + k3[lane]), x2 = (k0[32 + lane] + k1[32 + lane]) + (k2[32 + lane] + k3[32 + lane]);
            const float cs = cosT[(PAST + t) * 32 + lane], sn = sinT[(PAST + t) * 32 + lane];
            const float o1 = x1 * cs - x2 * sn, o2 = x2 * cs + x1 * sn;
            okpe_s[(size_t)r * 64 + lane] = o1; okpe_s[(size_t)r * 64 + 32 + lane] = o2;
            KPEs[(size_t)r * 64 + lane] = (bf16)(pkbf(o1, 0.f) & 0xffffu); KPEs[(size_t)r * 64 + 32 + lane] = (bf16)(pkbf(o2, 0.f) & 0xffffu); }
        const float* z0 = ZS + (size_t)r * 4096; const float* z1 = z0 + (size_t)MS * 4096;
        if (part < 0 || part == 1) {
            const f32x4 a0 = *(const GAS f32x4*)(z0 + 8 * lane) + *(const GAS f32x4*)(z1 + 8 * lane), a1 = *(const GAS f32x4*)(z0 + 8 * lane + 4) + *(const GAS f32x4*)(z1 + 8 * lane + 4);
            const float s = (a0.x * a0.x + a0.y * a0.y) + (a0.z * a0.z + a0.w * a0.w) + (a1.x * a1.x + a1.y * a1.y) + (a1.z * a1.z + a1.w * a1.w);
            const float rstd = 1.0f / sqrtf(wave_sum(s) * (1.f / QLR) + EPS);
            const f32x4 g0 = *(const GAS f32x4*)(q_norm + 8 * lane), g1 = *(const GAS f32x4*)(q_norm + 8 * lane + 4);
            v4u o; o.x = pkbf(a0.x * rstd * g0.x, a0.y * rstd * g0.y); o.y = pkbf(a0.z * rstd * g0.z, a0.w * rstd * g0.w); o.z = pkbf(a1.x * rstd * g1.x, a1.y * rstd * g1.y); o.w = pkbf(a1.z * rstd * g1.z, a1.w * rstd * g1.w);
            *(GAS v4u*)(QNs + kb32(r, 8 * lane)) = o; }
        if (part < 0 || part == 2) {
            const f32x4 a0 = *(const GAS f32x4*)(z0 + 512 + 8 * lane) + *(const GAS f32x4*)(z1 + 512 + 8 * lane), a1 = *(const GAS f32x4*)(z0 + 512 + 8 * lane + 4) + *(const GAS f32x4*)(z1 + 512 + 8 * lane + 4);
            const float s = (a0.x * a0.x + a0.y * a0.y) + (a0.z * a0.z + a0.w * a0.w) + (a1.x * a1.x + a1.y * a1.y) + (a1.z * a1.z + a1.w * a1.w);
            const float rstd = 1.0f / sqrtf(wave_sum(s) * (1.f / KVLR) + EPS);
            const f32x4 g0 = *(const GAS f32x4*)(kv_norm + 8 * lane), g1 = *(const GAS f32x4*)(kv_norm + 8 * lane + 4);
            const f32x4 y0 = a0 * rstd * g0, y1 = a1 * rstd * g1;
            *(GAS f32x4*)(ockv_s + (size_t)r * KVLR + 8 * lane) = y0; *(GAS f32x4*)(ockv_s + (size_t)r * KVLR + 8 * lane + 4) = y1;
            v4u o; o.x = pkbf(y0.x, y0.y); o.y = pkbf(y0.z, y0.w); o.z = pkbf(y1.x, y1.y); o.w = pkbf(y1.z, y1.w);
            *(GAS v4u*)(CKVs + kb32(r, 8 * lane)) = o; }
        if (part < 0 || part == 3) {
            const int c0 = 16 * lane, vC = 1024 + 256 * (c0 >> 7) + (c0 & 127), vU = vC + 128, vB = 3072 + c0;
            float cu[16], f1[16], f0[16], gb[16];
#pragma unroll
            for (int i = 0; i < 16; ++i) { cu[i] = (z0[vC + i] + z1[vC + i]) * (z0[vU + i] + z1[vU + i]); gb[i] = z0[vB + i] + z1[vB + i]; }
            if (t >= 1) {
#pragma unroll
                for (int i = 0; i < 16; ++i) f1[i] = (z0[vC + i - 4096] + z1[vC + i - 4096]) * (z0[vU + i - 4096] + z1[vU + i - 4096]); }
            else {
#pragma unroll
                for (int i = 0; i < 16; ++i) f1[i] = state_conv_l[((size_t)b * 2 + 1) * DCONV + c0 + i]; }
            if (t >= 2) {
#pragma unroll
                for (int i = 0; i < 16; ++i) f0[i] = (z0[vC + i - 8192] + z1[vC + i - 8192]) * (z0[vU + i - 8192] + z1[vU + i - 8192]); }
            else {
#pragma unroll
                for (int i = 0; i < 16; ++i) f0[i] = state_conv_l[((size_t)b * 2 + t) * DCONV + c0 + i]; }
            float o[16]; float s = 0.f;
#pragma unroll
            for (int i = 0; i < 16; ++i) { const float y = conv_w[c0 + i] * f0[i] + conv_w[DCONV + c0 + i] * f1[i] + conv_w[2 * DCONV + c0 + i] * cu[i]; o[i] = gb[i] * y; s += o[i] * o[i]; }
            const float rstd = 1.0f / sqrtf(wave_sum(s) * (1.f / DCONV) + EPS);
            v4u p0, p1;
#pragma unroll
            for (int i = 0; i < 4; ++i) { p0[i] = pkbf(o[2 * i] * rstd * conv_norm[c0 + 2 * i], o[2 * i + 1] * rstd * conv_norm[c0 + 2 * i + 1]);
                                          p1[i] = pkbf(o[8 + 2 * i] * rstd * conv_norm[c0 + 8 + 2 * i], o[8 + 2 * i + 1] * rstd * conv_norm[c0 + 8 + 2 * i + 1]); }
            *(GAS v4u*)(MIXs + kb32(r, DATT + c0)) = p0; *(GAS v4u*)(MIXs + kb32(r, DATT + c0 + 8)) = p1;
            if (t >= TS - 2) { float* oc = oconv_s + ((size_t)b * 2 + (t - (TS - 2))) * DCONV + c0;
#pragma unroll
                for (int i = 0; i < 4; ++i) *(GAS f32x4*)(oc + 4 * i) = (f32x4){cu[4 * i], cu[4 * i + 1], cu[4 * i + 2], cu[4 * i + 3]}; }
        }
    }
}
template <bool FINAL> __device__ __forceinline__ void norm_rows_s(const float* xs, float* X, bool first, const float* PS, int np, const float* gatel  ,
                                                                  const float* modl, int sh_off, int sc_off, bf16* H, const float* gain, float* yout, int lane, int gw, int NGW, const float* ssa = nullptr  ) {
    for (int r = gw; r < MS; r += NGW) {
        const int row = MP + r, b = NBP + (r >> 4);
        float ra = 1.f;
        if (ssa) { float t = 0.f;
#pragma unroll
            for (int hh = 0; hh < NH; ++hh) t += ssa[hh * 256 + r];
            ra = 1.0f / sqrtf(t * (1.f / DATT) + EPS); }
        const GAS f32x4* x4 = (const GAS f32x4*)(first ? xs + (size_t)r * DM : X + (size_t)row * DM) + lane;
        f32x4 v[8]; float s = 0.f;
#pragma unroll
        for (int j = 0; j < 8; ++j) { v[j] = x4[64 * j];
            if (np > 0) { f32x4 p = {0.f, 0.f, 0.f, 0.f};
                for (int k = 0; k < np; ++k) { const f32x4 pk = ((const GAS f32x4*)(PS + ((size_t)k * MS + r) * DM) + lane)[64 * j]; p += (k < 2) ? pk * ra : pk; }
                v[j] += ((const GAS f32x4*)(gatel + (size_t)b * MODW) + lane)[64 * j] * p; }
            s += (v[j].x * v[j].x + v[j].y * v[j].y) + (v[j].z * v[j].z + v[j].w * v[j].w); }
        if (!FINAL && (np > 0 || first)) { GAS f32x4* xc = (GAS f32x4*)(X + (size_t)row * DM) + lane;
#pragma unroll
            for (int j = 0; j < 8; ++j) xc[64 * j] = v[j]; }
        const float rstd = 1.0f / sqrtf(wave_sum(s) * (1.f / DM) + EPS);
        if (FINAL) { const GAS f32x4* g4 = (const GAS f32x4*)gain + lane; GAS f32x4* o4 = (GAS f32x4*)(yout + (size_t)row * DM) + lane;
#pragma unroll
            for (int j = 0; j < 8; ++j) o4[64 * j] = v[j] * rstd * g4[64 * j]; }
        else { const GAS f32x4* sc4 = (const GAS f32x4*)(modl + (size_t)b * MODW + sc_off) + lane; const GAS f32x4* sh4 = (const GAS f32x4*)(modl + (size_t)b * MODW + sh_off) + lane;
#pragma unroll
            for (int j = 0; j < 8; ++j) { const f32x4 sc = sc4[64 * j], sh = sh4[64 * j]; GAS unsigned long long* o8 = (GAS unsigned long long*)(H + kb32(r, 4 * lane + 256 * j));
                const float a = v[j].x * rstd * (1.f + sc.x) + sh.x, bq = v[j].y * rstd * (1.f + sc.y) + sh.y, c = v[j].z * rstd * (1.f + sc.z) + sh.z, d = v[j].w * rstd * (1.f + sc.w) + sh.w;
                *o8 = (unsigned long long)pkbf(a, bq) | ((unsigned long long)pkbf(c, d) << 32); } }
    }
}

template <bool FINAL> __device__ __forceinline__ void norm_rows_s_coop(const float* xs, float* X, bool first, const float* PS, int np, const float* gatel, const float* modl, int sh_off, int sc_off, bf16* H,
                                                                       const float* gain, float* yout, LAS float* red, int lane, int wave, int vcu, int G, const float* ssa = nullptr) {
    for (int r = vcu; r < MS; r += G) {
        const int row = MP + r, b = NBP + (r >> 4), j = wave;
        float ra = 1.f;
        if (ssa) { float t = 0.f;
#pragma unroll
            for (int hh = 0; hh < NH; ++hh) t += ssa[hh * 256 + r];
            ra = 1.0f / sqrtf(t * (1.f / DATT) + EPS); }
        f32x4 v = ((const GAS f32x4*)(first ? xs + (size_t)r * DM : X + (size_t)row * DM) + lane)[64 * j];
        if (np > 0) { f32x4 p = {0.f, 0.f, 0.f, 0.f};
            for (int k = 0; k < np; ++k) { const f32x4 pk = ((const GAS f32x4*)(PS + ((size_t)k * MS + r) * DM) + lane)[64 * j]; p += (k < 2) ? pk * ra : pk; }
            v += ((const GAS f32x4*)(gatel + (size_t)b * MODW) + lane)[64 * j] * p; }
        const float sw = wave_sum((v.x * v.x + v.y * v.y) + (v.z * v.z + v.w * v.w));
        if (lane == 0) red[wave] = sw;
        if (!FINAL && (np > 0 || first)) ((GAS f32x4*)(X + (size_t)row * DM) + lane)[64 * j] = v;
        __syncthreads();
        float s = 0.f;
#pragma unroll
        for (int w = 0; w < NWAVES; ++w) s += red[w];
        const float rstd = 1.0f / sqrtf(s * (1.f / DM) + EPS);
        if (FINAL) ((GAS f32x4*)(yout + (size_t)row * DM) + lane)[64 * j] = v * rstd * ((const GAS f32x4*)gain + lane)[64 * j];
        else { const f32x4 sc = ((const GAS f32x4*)(modl + (size_t)b * MODW + sc_off) + lane)[64 * j], sh = ((const GAS f32x4*)(modl + (size_t)b * MODW + sh_off) + lane)[64 * j];
            const float a = v.x * rstd * (1.f + sc.x) + sh.x, bq = v.y * rstd * (1.f + sc.y) + sh.y, c = v.z * rstd * (1.f + sc.z) + sh.z, d = v.w * rstd * (1.f + sc.w) + sh.w;
            *(GAS unsigned long long*)(H + kb32(r, 4 * lane + 256 * j)) = (unsigned long long)pkbf(a, bq) | ((unsigned long long)pkbf(c, d) << 32); }
        __syncthreads();
    }
}
constexpr size_t WS_SA = WS_KV + 64 * MiB;
constexpr size_t WS_QA = WS_SA, WS_PO = WS_SA + 4 * MiB, WS_PML = WS_SA + 40 * MiB, WS_SSA = WS_SA + 41 * MiB;
constexpr int SCH = 17;
static_assert((size_t)NBS * SCH * 8 * 32 * 256 * 2 <= 36 * MiB && WS_SSA + 8192 <= WS_MIX, "absorbed-attention scratch");
typedef short s16x4v __attribute__((ext_vector_type(4)));
template <int OFF> __device__ __forceinline__ s16x4v sa_tr(int vb) { s16x4v r; asm volatile("ds_read_b64_tr_b16 %0, %1 offset:%2" : "=&v"(r) : "v"(vb), "i"(OFF) : "memory"); return r; }
__device__ __forceinline__ bf16x8 cvt8_f32(const float* p) { const f32x4 a = *(const GAS f32x4*)p, b = *(const GAS f32x4*)(p + 4); v4u o; o.x = pkbf(a.x, a.y); o.y = pkbf(a.z, a.w); o.z = pkbf(b.x, b.y); o.w = pkbf(b.z, b.w);
    return __builtin_bit_cast(bf16x8, o); }
__device__ __forceinline__ void prep_qabs(const float* w_uq, const float* w_ukv, unsigned char* ws, LAS unsigned char* lds, int tid, int lane, int wave, int first, int stride) {
    constexpr int PITCH = 272, BOFF = 128 * PITCH;
    const int i32 = lane & 31, hi = lane >> 5, ct = wave & 3, kq = wave >> 2;
    for (int it = first; it < DEPTH * NH * 8; it += stride) {
        const int kh = it & 1, cq = (it >> 1) & 3, h = (it >> 3) & 7, l = it >> 6;
        __syncthreads();
        { const float* asrc = w_ukv + ((size_t)l * KVLR + 128 * cq) * NKV + h * 256;
          const float* bsrc = w_uq + ((size_t)l * QLR + 256 * kh) * NQ + h * QKD;
          bf16x8 av[4], bv[8];
#pragma unroll
          for (int i = 0; i < 4; ++i) { const int id = tid + 512 * i; av[i] = cvt8_f32(asrc + (size_t)(id >> 4) * NKV + 8 * (id & 15)); }
#pragma unroll
          for (int i = 0; i < 8; ++i) { const int id = tid + 512 * i; bv[i] = cvt8_f32(bsrc + (size_t)(id >> 4) * NQ + 8 * (id & 15)); }
#pragma unroll
          for (int i = 0; i < 4; ++i) { const int id = tid + 512 * i; *(LAS bf16x8*)(lds + (id >> 4) * PITCH + 16 * (id & 15)) = av[i]; }
#pragma unroll
          for (int i = 0; i < 8; ++i) { const int id = tid + 512 * i; *(LAS bf16x8*)(lds + BOFF + (id >> 4) * PITCH + 16 * (id & 15)) = bv[i]; } }
        __syncthreads();
        const LAS unsigned char* ap = lds + (32 * ct + i32) * PITCH + 16 * hi;
        const LAS unsigned char* bp = lds + BOFF + (128 * kq + i32) * PITCH + 16 * hi;
        bf16* o = (bf16*)(ws + WS_W + (size_t)l * W_LAYER + WO_QA) + (size_t)(h * 512 + 128 * cq + 32 * ct) * QLR + 256 * kh + 128 * kq + i32;
#pragma unroll
        for (int kt = 0; kt < 4; ++kt) { f32x16v acc = {};
#pragma unroll
            for (int s = 0; s < 8; ++s) acc = __builtin_amdgcn_mfma_f32_32x32x16_bf16(*(const LAS bf16x8*)(ap + 32 * s), *(const LAS bf16x8*)(bp + kt * 32 * PITCH + 32 * s), acc, 0, 0, 0);
#pragma unroll
            for (int r = 0; r < 16; ++r) o[(size_t)((r & 3) + 8 * (r >> 2) + 4 * hi) * QLR + 32 * kt] = (bf16)(pkbf(acc[r], 0.f) & 0xffffu); }
    }
    __syncthreads();
}
__device__ __forceinline__ void sabs_unit(int b, int ch, const bf16* QAs  , const bf16* CKV, const bf16* KPE, const float* ckv_l  , const float* kpe_l  , const float* cosT, const float* sinT, bf16* PO, float* PML,
                                          LAS unsigned char* lds, int lane, int wave) {
    const int qi = lane & 15, g = lane >> 4, h = wave;
    const bool isnew = ch == SCH - 1;
    __syncthreads();
    bf16x8 qf[18];
    { const bf16* pp = QAs + ((size_t)(128 + 2 * h) * 256 + b * TS + qi) * 32 + 8 * g;
      qf[16] = *(const GAS bf16x8*)pp; qf[17] = *(const GAS bf16x8*)(pp + 8192);
      const int pos = PAST + qi; const float* cp = cosT + pos * 32 + 8 * g; const float* sp = sinT + pos * 32 + 8 * g;
      const v4u x1 = __builtin_bit_cast(v4u, qf[16]), x2 = __builtin_bit_cast(v4u, qf[17]); v4u y1, y2;
#pragma unroll
      for (int w = 0; w < 4; ++w) { const float ca = cp[2 * w], cb = cp[2 * w + 1], sa = sp[2 * w], sb = sp[2 * w + 1];
          const float a1 = bf_lo(x1[w]), b1 = bf_hi(x1[w]), a2 = bf_lo(x2[w]), b2 = bf_hi(x2[w]);
          y1[w] = pkbf(a1 * ca - a2 * sa, b1 * cb - b2 * sb); y2[w] = pkbf(a2 * ca + a1 * sa, b2 * cb + b1 * sb); }
      qf[16] = __builtin_bit_cast(bf16x8, y1); qf[17] = __builtin_bit_cast(bf16x8, y2); }
    f32x4 sc[8];
#pragma unroll
    for (int T = 0; T < 8; ++T) sc[T] = (f32x4){0.f, 0.f, 0.f, 0.f};
    if (!isnew) {
        const float* src = ckv_l + ((size_t)b * PAST + 128 * ch + wave) * KVLR + 8 * lane;
        const float* kf = kpe_l + ((size_t)b * PAST + 128 * ch + qi) * 64 + 8 * g;
        const int cbk = lane >> 4, c16 = lane & 15;
        f32x4 v0[8], v1[8], kq[4][4];
#define SA_SLOAD(HB) do { _Pragma("unroll") for (int j = 0; j < 8; ++j) { const float* p = src + (size_t)(8 * (8 * (HB) + j)) * KVLR; v0[j] = *(const GAS f32x4*)p; v1[j] = *(const GAS f32x4*)(p + 4); } } while (0)
#define SA_SWRITE(HB) do { _Pragma("unroll") for (int j = 0; j < 8; ++j) { const int key = 8 * (8 * (HB) + j) + wave, row = key & 31, xr = ((row & 3) << 2) | ((row >> 2) & 3); \
            v4u o; o.x = pkbf(v0[j].x, v0[j].y); o.y = pkbf(v0[j].z, v0[j].w); o.z = pkbf(v1[j].x, v1[j].y); o.w = pkbf(v1[j].z, v1[j].w); \
            *(LAS v4u*)(lds + ((key >> 5) * 4 + cbk) * 8192 + 256 * row + 16 * (c16 ^ xr)) = o; } } while (0)
#define SA_KLOAD(T0) do { _Pragma("unroll") for (int t = 0; t < 4; ++t) { const float* p = kf + (size_t)(16 * ((T0) + t)) * 64; kq[t][0] = *(const GAS f32x4*)p; kq[t][1] = *(const GAS f32x4*)(p + 4); kq[t][2] = *(const GAS f32x4*)(p + 32); kq[t][3] = *(const GAS f32x4*)(p + 36); } } while (0)
#define SA_KMMA(T0) do { _Pragma("unroll") for (int t = 0; t < 4; ++t) { v4u a, c; a.x = pkbf(kq[t][0].x, kq[t][0].y); a.y = pkbf(kq[t][0].z, kq[t][0].w); a.z = pkbf(kq[t][1].x, kq[t][1].y); a.w = pkbf(kq[t][1].z, kq[t][1].w); \
            c.x = pkbf(kq[t][2].x, kq[t][2].y); c.y = pkbf(kq[t][2].z, kq[t][2].w); c.z = pkbf(kq[t][3].x, kq[t][3].y); c.w = pkbf(kq[t][3].z, kq[t][3].w); \
            sc[(T0) + t] = __builtin_amdgcn_mfma_f32_16x16x32_bf16(__builtin_bit_cast(bf16x8, a), qf[16], sc[(T0) + t], 0, 0, 0); sc[(T0) + t] = __builtin_amdgcn_mfma_f32_16x16x32_bf16(__builtin_bit_cast(bf16x8, c), qf[17], sc[(T0) + t], 0, 0, 0); } } while (0)
        SA_SLOAD(0); SA_KLOAD(0); __builtin_amdgcn_sched_barrier(0);
        SA_SWRITE(0); __builtin_amdgcn_sched_barrier(0);
        SA_SLOAD(1); __builtin_amdgcn_sched_barrier(0);
        SA_KMMA(0); __builtin_amdgcn_sched_barrier(0);
        SA_KLOAD(4); __builtin_amdgcn_sched_barrier(0);
        SA_SWRITE(1); __builtin_amdgcn_sched_barrier(0);
        SA_KMMA(4);
#undef SA_SLOAD
#undef SA_SWRITE
#undef SA_KLOAD
#undef SA_KMMA
    } else {
        const int row = 4 * wave + g; const int chk = (lane & 15) ^ (((row & 3) << 2) | ((row >> 2) & 3));
        const bf16* src = CKV + (size_t)KVROW_S * KVLR + ((size_t)(chk >> 2) * 256 + b * TS + (row & 15)) * 32 + (chk & 3) * 8;
#pragma unroll
        for (int cbk = 0; cbk < 4; ++cbk) __builtin_amdgcn_global_load_lds((const unsigned*)(src + (size_t)cbk * 4 * 8192), (LAS unsigned*)(lds + cbk * 8192 + wave * 1024), 16, 0, 0);
        const bf16* kp = KPE + ((size_t)KVROW_S + b * TS + qi) * 64 + 8 * g;
        sc[0] = __builtin_amdgcn_mfma_f32_16x16x32_bf16(*(const GAS bf16x8*)kp, qf[16], sc[0], 0, 0, 0); sc[0] = __builtin_amdgcn_mfma_f32_16x16x32_bf16(*(const GAS bf16x8*)(kp + 32), qf[17], sc[0], 0, 0, 0);
    }
    { const bf16* qp = QAs + ((size_t)(h * 16) * 256 + b * TS + qi) * 32 + 8 * g;
#pragma unroll
      for (int s = 0; s < 16; ++s) qf[s] = *(const GAS bf16x8*)(qp + (size_t)s * 8192); }
    asm volatile("s_waitcnt vmcnt(0)" ::: "memory");
    __syncthreads();
    { const int ab = 256 * qi + 16 * (g ^ ((qi >> 2) & 3));
      int o4[4];
#pragma unroll
      for (int s4 = 0; s4 < 4; ++s4) o4[s4] = 64 * (s4 ^ (qi & 3));
#pragma unroll
      for (int T = 0; T < 8; ++T) {
          if (T < 1 || !isnew) {
              f32x4 acc = sc[T];
              const LAS unsigned char* ip = lds + (T >> 1) * 32768 + (T & 1) * 4096 + ab;
#pragma unroll
              for (int s = 0; s < 16; ++s) acc = __builtin_amdgcn_mfma_f32_16x16x32_bf16(*(const LAS bf16x8*)(ip + (s >> 2) * 8192 + o4[s & 3]), qf[s], acc, 0, 0, 0);
              sc[T] = acc * (ATTN_SCALE * LOG2E);
          } else sc[T] = (f32x4){-INFINITY, -INFINITY, -INFINITY, -INFINITY};
      }
    }
    float m = sc[0][0];
#pragma unroll
    for (int T = 0; T < 8; ++T)
#pragma unroll
        for (int r = 0; r < 4; ++r) m = fmaxf(m, sc[T][r]);
    m = fmaxf(m, swz_xor<16>(m)); m = half_swap_max(m);
    float lsum = 0.f;
#pragma unroll
    for (int T = 0; T < 8; ++T)
#pragma unroll
        for (int r = 0; r < 4; ++r) { sc[T][r] = __builtin_amdgcn_exp2f(sc[T][r] - m); lsum += sc[T][r]; }
    lsum += swz_xor<16>(lsum); lsum = half_swap_add(lsum);
    const size_t unit = (size_t)b * SCH + ch;
    if (g == 0) { float* mp = PML + ((unit * 8 + h) * 16 + qi) * 2; mp[0] = m; mp[1] = lsum; }
    bf16x8 pf[4];
#pragma unroll
    for (int kb = 0; kb < 4; ++kb) { v4u o; o.x = pkbf(sc[2 * kb][0], sc[2 * kb][1]); o.y = pkbf(sc[2 * kb][2], sc[2 * kb][3]); o.z = pkbf(sc[2 * kb + 1][0], sc[2 * kb + 1][1]); o.w = pkbf(sc[2 * kb + 1][2], sc[2 * kb + 1][3]);
        pf[kb] = __builtin_bit_cast(bf16x8, o); }
    f32x4 oacc[32];
#pragma unroll
    for (int t = 0; t < 32; ++t) oacc[t] = (f32x4){0.f, 0.f, 0.f, 0.f};
    { const int q4 = qi >> 2, p = lane & 3;
      const int trb = (int)(unsigned)(size_t)lds + 256 * (4 * g + q4) + 16 * ((p >> 1) ^ (g & 1)) + 8 * (p & 1);
      const int x3 = (q4 << 1) | (g >> 1);
      int vb[8];
#pragma unroll
      for (int c = 0; c < 8; ++c) vb[c] = trb + 32 * (c ^ x3);
#define SA_BLK(KB, CBK, VBA) do { \
          const s16x4v a0 = sa_tr<((KB) & 1) * 32768 + (CBK) * 8192>(VBA[0]), b0 = sa_tr<((KB) & 1) * 32768 + (CBK) * 8192 + 4096>(VBA[0]); \
          const s16x4v a1 = sa_tr<((KB) & 1) * 32768 + (CBK) * 8192>(VBA[1]), b1 = sa_tr<((KB) & 1) * 32768 + (CBK) * 8192 + 4096>(VBA[1]); \
          const s16x4v a2 = sa_tr<((KB) & 1) * 32768 + (CBK) * 8192>(VBA[2]), b2 = sa_tr<((KB) & 1) * 32768 + (CBK) * 8192 + 4096>(VBA[2]); \
          const s16x4v a3 = sa_tr<((KB) & 1) * 32768 + (CBK) * 8192>(VBA[3]), b3 = sa_tr<((KB) & 1) * 32768 + (CBK) * 8192 + 4096>(VBA[3]); \
          const s16x4v a4 = sa_tr<((KB) & 1) * 32768 + (CBK) * 8192>(VBA[4]), b4 = sa_tr<((KB) & 1) * 32768 + (CBK) * 8192 + 4096>(VBA[4]); \
          const s16x4v a5 = sa_tr<((KB) & 1) * 32768 + (CBK) * 8192>(VBA[5]), b5 = sa_tr<((KB) & 1) * 32768 + (CBK) * 8192 + 4096>(VBA[5]); \
          const s16x4v a6 = sa_tr<((KB) & 1) * 32768 + (CBK) * 8192>(VBA[6]), b6 = sa_tr<((KB) & 1) * 32768 + (CBK) * 8192 + 4096>(VBA[6]); \
          const s16x4v a7 = sa_tr<((KB) & 1) * 32768 + (CBK) * 8192>(VBA[7]), b7 = sa_tr<((KB) & 1) * 32768 + (CBK) * 8192 + 4096>(VBA[7]); \
          asm volatile("s_waitcnt lgkmcnt(0)" ::: "memory"); __builtin_amdgcn_sched_barrier(0); \
          oacc[(CBK) * 8 + 0] = __builtin_amdgcn_mfma_f32_16x16x32_bf16(SA_PK(a0, b0), pf[KB], oacc[(CBK) * 8 + 0], 0, 0, 0); oacc[(CBK) * 8 + 1] = __builtin_amdgcn_mfma_f32_16x16x32_bf16(SA_PK(a1, b1), pf[KB], oacc[(CBK) * 8 + 1], 0, 0, 0); \
          oacc[(CBK) * 8 + 2] = __builtin_amdgcn_mfma_f32_16x16x32_bf16(SA_PK(a2, b2), pf[KB], oacc[(CBK) * 8 + 2], 0, 0, 0); oacc[(CBK) * 8 + 3] = __builtin_amdgcn_mfma_f32_16x16x32_bf16(SA_PK(a3, b3), pf[KB], oacc[(CBK) * 8 + 3], 0, 0, 0); \
          oacc[(CBK) * 8 + 4] = __builtin_amdgcn_mfma_f32_16x16x32_bf16(SA_PK(a4, b4), pf[KB], oacc[(CBK) * 8 + 4], 0, 0, 0); oacc[(CBK) * 8 + 5] = __builtin_amdgcn_mfma_f32_16x16x32_bf16(SA_PK(a5, b5), pf[KB], oacc[(CBK) * 8 + 5], 0, 0, 0); \
          oacc[(CBK) * 8 + 6] = __builtin_amdgcn_mfma_f32_16x16x32_bf16(SA_PK(a6, b6), pf[KB], oacc[(CBK) * 8 + 6], 0, 0, 0); oacc[(CBK) * 8 + 7] = __builtin_amdgcn_mfma_f32_16x16x32_bf16(SA_PK(a7, b7), pf[KB], oacc[(CBK) * 8 + 7], 0, 0, 0); \
          __builtin_amdgcn_sched_barrier(0); } while (0)
#define SA_PK(L, H) ((bf16x8){L[0], L[1], L[2], L[3], H[0], H[1], H[2], H[3]})
#define SA_KB(KB, VBA) do { SA_BLK(KB, 0, VBA); SA_BLK(KB, 1, VBA); SA_BLK(KB, 2, VBA); SA_BLK(KB, 3, VBA); } while (0)
      SA_KB(0, vb);
      if (!isnew) { SA_KB(1, vb);
          int vc[8];
#pragma unroll
          for (int c = 0; c < 8; ++c) vc[c] = vb[c] + 65536;
          SA_KB(2, vc); SA_KB(3, vc); }
#undef SA_KB
#undef SA_BLK
#undef SA_PK
    }
    { bf16* po = PO + ((unit * 8 + h) * 32) * 256 + lane * 4;
#pragma unroll
      for (int t = 0; t < 32; ++t) *(GAS unsigned long long*)(po + t * 256) = (unsigned long long)pkbf(oacc[t][0], oacc[t][1]) | ((unsigned long long)pkbf(oacc[t][2], oacc[t][3]) << 32); }
    __syncthreads();
}
__device__ __forceinline__ void scomb_unit(int b, int h, const bf16* PO, const float* PML, const bf16* WUKVt  , const float* gain, bf16* MIXs  , float* SSA,
                                           LAS unsigned char* lds, int lane, int wave) {
    const int qi = lane & 15, g = lane >> 4;
    __syncthreads();
    const float* ml0 = PML + (((size_t)b * SCH * 8 + h) * 16 + qi) * 2;
    const bf16* po0 = PO + (((size_t)b * SCH * 8 + h) * 32 + 4 * wave) * 256 + lane * 4;
    const bf16* wp = WUKVt + (size_t)(h * 256 + 128 + qi) * KVLR + 64 * wave + 4 * g;
    pg8::f32x2 ml[SCH]; unsigned long long wl_[8][2][2], pa[6][4], pb[6][4];
#pragma unroll
    for (int ch = 0; ch < SCH; ++ch) ml[ch] = *(const GAS pg8::f32x2*)(ml0 + ch * 256);
#pragma unroll
    for (int c = 0; c < 6; ++c)
#pragma unroll
        for (int t = 0; t < 4; ++t) pa[c][t] = *(const GAS unsigned long long*)(po0 + (size_t)c * 65536 + t * 256);
#pragma unroll
    for (int c = 0; c < 6; ++c)
#pragma unroll
        for (int t = 0; t < 4; ++t) pb[c][t] = *(const GAS unsigned long long*)(po0 + (size_t)(6 + c) * 65536 + t * 256);
#pragma unroll
    for (int vt = 0; vt < 8; ++vt)
#pragma unroll
        for (int k2 = 0; k2 < 2; ++k2) { wl_[vt][k2][0] = *(const GAS unsigned long long*)(wp + (size_t)vt * 16 * KVLR + 32 * k2); wl_[vt][k2][1] = *(const GAS unsigned long long*)(wp + (size_t)vt * 16 * KVLR + 32 * k2 + 16); }
    __builtin_amdgcn_sched_barrier(0);
    float M = ml[0].x;
#pragma unroll
    for (int ch = 1; ch < SCH; ++ch) M = fmaxf(M, ml[ch].x);
    float L = 0.f; f32x4 acc[4];
#pragma unroll
    for (int t = 0; t < 4; ++t) acc[t] = (f32x4){0.f, 0.f, 0.f, 0.f};
#define SC_ACC(PV, C0, NC) do { _Pragma("unroll") for (int c = 0; c < NC; ++c) { const float w = __builtin_amdgcn_exp2f(ml[(C0) + c].x - M); L += w * ml[(C0) + c].y; \
            _Pragma("unroll") for (int t = 0; t < 4; ++t) { const unsigned lo = (unsigned)PV[c][t], hi2 = (unsigned)(PV[c][t] >> 32); acc[t] += w * (f32x4){bf_lo(lo), bf_hi(lo), bf_lo(hi2), bf_hi(hi2)}; } } } while (0)
    SC_ACC(pa, 0, 6);
    __builtin_amdgcn_sched_barrier(0);
#pragma unroll
    for (int c = 0; c < 5; ++c)
#pragma unroll
        for (int t = 0; t < 4; ++t) pa[c][t] = *(const GAS unsigned long long*)(po0 + (size_t)(12 + c) * 65536 + t * 256);
    __builtin_amdgcn_sched_barrier(0);
    SC_ACC(pb, 6, 6);
    __builtin_amdgcn_sched_barrier(0);
    SC_ACC(pa, 12, 5);
#undef SC_ACC
    const float inv = 1.0f / L;
    bf16x8 afr[2];
#pragma unroll
    for (int k2 = 0; k2 < 2; ++k2) { v4u o; o.x = pkbf(acc[2 * k2][0] * inv, acc[2 * k2][1] * inv); o.y = pkbf(acc[2 * k2][2] * inv, acc[2 * k2][3] * inv);
        o.z = pkbf(acc[2 * k2 + 1][0] * inv, acc[2 * k2 + 1][1] * inv); o.w = pkbf(acc[2 * k2 + 1][2] * inv, acc[2 * k2 + 1][3] * inv); afr[k2] = __builtin_bit_cast(bf16x8, o); }
    LAS f32x4* red = (LAS f32x4*)lds;
    {
      __builtin_amdgcn_sched_barrier(0);
#pragma unroll
      for (int vt = 0; vt < 8; ++vt) { f32x4 o = {0.f, 0.f, 0.f, 0.f};
#pragma unroll
          for (int k2 = 0; k2 < 2; ++k2) { v4u bw; bw.x = (unsigned)wl_[vt][k2][0]; bw.y = (unsigned)(wl_[vt][k2][0] >> 32); bw.z = (unsigned)wl_[vt][k2][1]; bw.w = (unsigned)(wl_[vt][k2][1] >> 32);
              o = __builtin_amdgcn_mfma_f32_16x16x32_bf16(afr[k2], __builtin_bit_cast(bf16x8, bw), o, 0, 0, 0); }
          red[(wave * 8 + vt) * 64 + lane] = o; } }
    __syncthreads();
    f32x4 s = {0.f, 0.f, 0.f, 0.f};
#pragma unroll
    for (int w = 0; w < 8; ++w) s += red[(w * 8 + wave) * 64 + lane];
    f32x4 ss = s * s;
#pragma unroll
    for (int r = 0; r < 4; ++r) { float t = ss[r]; t += swz_xor<1>(t); t += swz_xor<2>(t); t += swz_xor<4>(t); t += swz_xor<8>(t); ss[r] = t; }
    LAS float* sq = (LAS float*)(lds + 65536);
    if (qi == 0) {
#pragma unroll
        for (int r = 0; r < 4; ++r) sq[wave * 16 + 4 * g + r] = ss[r]; }
    const int col = h * 128 + 16 * wave + qi; const float gn = gain[col];
#pragma unroll
    for (int r = 0; r < 4; ++r) MIXs[kb32(b * TS + 4 * g + r, col)] = (bf16)(pkbf(s[r] * gn, 0.f) & 0xffffu);
    __syncthreads();
    if (wave == 0 && lane < 16) { float t = 0.f;
#pragma unroll
        for (int w = 0; w < 8; ++w) t += sq[w * 16 + lane];
        SSA[h * 256 + b * TS + lane] = t; }
    __syncthreads();
}

#ifndef MK_MULTI
#define MK_MULTI 0
#endif
#ifndef REP_PREP
#define REP_PREP 1
#endif
#ifndef REP_MOD
#define REP_MOD 1
#endif
#ifndef REP_DN
#define REP_DN 1
#endif
#ifndef REP_OUT
#define REP_OUT 1
#endif
#ifndef REP_N1
#define REP_N1 1
#endif
#ifndef REP_SATT
#define REP_SATT 1
#endif
#ifndef REP_UP
#define REP_UP 1
#endif
#ifndef REP_IN
#define REP_IN 1
#endif
#ifndef REP_QKV
#define REP_QKV 1
#endif
#ifndef REP_ATT
#define REP_ATT 1
#endif
#ifndef REP_QABS
#define REP_QABS 1
#endif
#ifndef REP_SABS
#define REP_SABS 1
#endif
#ifndef REP_COMB
#define REP_COMB 1
#endif
#ifndef REP_ELT
#define REP_ELT 1
#endif
constexpr int PH_PREP = 0, PH_MOD = 1, PH_L0 = 2, PH_PER_LAYER = 10, PH_FINAL = PH_L0 + DEPTH * PH_PER_LAYER, N_PHASES = PH_FINAL + 1;
struct Args { const float* in[21]; float* out; unsigned char* ws; int ph_lo, ph_hi; };
static_assert(sizeof(Args) == 21 * 8 + 8 + 8 + 8, "Args has no padding");

__global__ void __launch_bounds__(NWAVES * 64, 2) trunk_fwd(Args args) {
    extern __shared__ __attribute__((aligned(16))) unsigned char lds_raw[];
    LAS unsigned char* lds = (LAS unsigned char*)lds_raw;
    volatile LAS unsigned* MISC = (volatile LAS unsigned*)(lds + MISC_OFF);
    const int wave0 = __builtin_amdgcn_readfirstlane((int)threadIdx.x >> 6);
    const int G = gridDim.x; const int bx = blockIdx.x; const int vcu = (G % 8 == 0) ? (bx % 8) * (G / 8) + bx / 8 : bx;
    { const int t0 = threadIdx.x; for (int u = t0; u < (LDS_BYTES - LDSCTL_OFF) / 4; u += NWAVES * 64) ((LAS unsigned*)(lds + LDSCTL_OFF))[u] = 0u; }
    __syncthreads();
#if MK_MULTI
#define GRID_BAR() do { } while (0)
#else
    XcdBarrier bar = xcd_barrier_post((unsigned*)((gu32*)(args.ws + WS_CTL) + CW_BAR), MISC + 8);
#define GRID_BAR() xcd_barrier(bar)
#endif
    const int lo = args.ph_lo, hi = args.ph_hi;
#define IN(k) (lo <= (k) && (k) < hi)
#ifndef REP_SG
#define REP_SG 1
#endif
#ifndef REP_KPE
#define REP_KPE 1
#endif
#ifndef REP_ROWS
#define REP_ROWS 1
#endif
#ifndef REP_BAR
#define REP_BAR 1
#endif
#define SEAM(k) do { if ((k) + 1 < hi) { for (int rb_ = 0; rb_ < REP_BAR; ++rb_) GRID_BAR(); } } while (0)
#define PHASE_ENV() int ln_; asm volatile("v_mbcnt_lo_u32_b32 %0, -1, 0\n\tv_mbcnt_hi_u32_b32 %0, -1, %0" : "=v"(ln_)); int wv_ = wave0; asm volatile("" : "+s"(wv_)); const int wave = wv_, lane = ln_, tid = wave * 64 + lane; \
    const int SGW_ = (wave == 0) ? vcu : (1 << 20); (void)SGW_; const int PGW_ = (G == 256) ? (wave * 256 + vcu) : (vcu * NWAVES + wave); (void)PGW_;         \
    const int gw = vcu * NWAVES + wave, NGW = G * NWAVES, gt = gw * 64 + lane, NGT = NGW * 64; (void)gt; (void)NGT; (void)gw; (void)NGW; (void)tid; (void)lane; \
    size_t zoff_ = 0; asm volatile("" : "+s"(zoff_)); unsigned char* ws = args.ws + zoff_; float* out = args.out; (void)out; \
    float* X = (float*)(ws + WS_X); bf16* XB = (bf16*)(ws + WS_X); (void)XB; bf16* H = (bf16*)(ws + WS_H); bf16* Z = (bf16*)(ws + WS_Z); bf16* QN = (bf16*)(ws + WS_QN); bf16* CKV = (bf16*)(ws + WS_CKV); \
    bf16* KPE = (bf16*)(ws + WS_KPE); bf16* Qb = (bf16*)(ws + WS_Q); bf16* KVb = (bf16*)(ws + WS_KV); bf16* MIX = (bf16*)(ws + WS_MIX); bf16* HB = (bf16*)(ws + WS_HB); \
    const float* cosT = (const float*)(ws + WS_COS); const float* sinT = (const float*)(ws + WS_SIN); \
    const unsigned char* wl = ws + WS_W + (size_t)l * W_LAYER; const float* modl = (const float*)(ws + WS_MOD) + (size_t)l * NB * MODW; \
    float* ZS = (float*)(ws + WS_ZS); float* PS = (float*)(ws + WS_PS); const int rbx = G - 1 - bx; const bool sg_first_ = (bx & 1) != 0; (void)ZS; (void)PS; (void)rbx; (void)sg_first_; \
    (void)X; (void)H; (void)Z; (void)QN; (void)CKV; (void)KPE; (void)Qb; (void)KVb; (void)MIX; (void)HB; (void)cosT; (void)sinT; (void)wl; (void)modl;

    if (IN(PH_PREP)) for (int rep_ = 0; rep_ < REP_PREP; ++rep_) { const int l = 0; PHASE_ENV(); p0_prep(args.in[9], args.in[11], args.in[13], args.in[17], args.in[18], args.in[19], args.in[2], args.in[3], ws, lds, tid, lane, wave, vcu, G);
        if (G != 256) prep_qabs(args.in[11], args.in[13], ws, lds, tid, lane, wave, vcu, G);
        SEAM(PH_PREP); }
    if (IN(PH_MOD)) for (int rep_ = 0; rep_ < REP_MOD; ++rep_) { const int l = 0; PHASE_ENV(); p1_mod(args.in[7], args.in[8], ws, lds, tid, lane, wave, vcu, G);
        if (G == 256 && (vcu & 3) == 3) prep_qabs(args.in[11], args.in[13], ws, lds, tid, lane, wave, vcu >> 2, 64);
        SEAM(PH_MOD); }

    for (int l = 0; l < DEPTH; ++l) {
        const int pb = PH_L0 + l * PH_PER_LAYER;
        if (hi <= pb || lo >= pb + PH_PER_LAYER) continue;
        if (IN(pb + 0)) { PHASE_ENV(); for (int rep_ = 0; rep_ < REP_N1; ++rep_) { if (l == 0) norm_rows<true>(args.in[0], modl, 0, DM, H, lane, PGW_, NGW); else norm_rows<false>(XB, modl, 0, DM, H, lane, PGW_, NGW); }
            norm_rows_s_coop<false>(args.in[1], X, l == 0, PS, l == 0 ? 0 : 4, modl - (size_t)NB * MODW + 5 * DM, modl, 0, DM, H + (size_t)MP * DM, nullptr, nullptr, (LAS float*)lds, lane, wave, vcu, G);
            SEAM(pb + 0); }
        if (IN(pb + 1)) for (int rep_ = 0; rep_ < REP_IN; ++rep_) { PHASE_ENV();
            if (sg_first_) {
            for (int u = rbx; u < 264; u += G) {
                const bool pe = u >= 256; const int cb = pe ? (u & 1) : (u & 127), ks = pe ? ((u - 256) >> 1) : (u >> 7);
                SEpiPart Es{pe ? (float*)(ws + WS_SSA + 65536) + (size_t)ks * MS * 64 : ZS + (size_t)ks * MS * 4096, pe ? 64 : 4096};
                sgemm_unit(lds, H + (size_t)MP * DM, (const bf16*)(wl + (pe ? WO_PE : WO_IN)), DM, 32 * cb, pe ? 512 * ks : 1024 * ks, pe ? 512 : 1024, Es, lane, wave); }
            }
            pg8::Gemm g{H, (const bf16*)(wl + WO_IN), MP, 4096, DM, (pg8::bf16_t*)(ws + WS_DUMMY)}; pg8::StaticOrder S; S.init(MP, 4096, G, bx);
            pg8::EpiZ E{Z};
            pg8::gemm_phase<pg8::EpiZ, pg8::StaticOrder, true, true>(lds, g, S, E, wave0);
            __syncthreads();
            if (!sg_first_) {
            for (int u = rbx; u < 264; u += G) {
                const bool pe = u >= 256; const int cb = pe ? (u & 1) : (u & 127), ks = pe ? ((u - 256) >> 1) : (u >> 7);
                SEpiPart Es{pe ? (float*)(ws + WS_SSA + 65536) + (size_t)ks * MS * 64 : ZS + (size_t)ks * MS * 4096, pe ? 64 : 4096};
                sgemm_unit(lds, H + (size_t)MP * DM, (const bf16*)(wl + (pe ? WO_PE : WO_IN)), DM, 32 * cb, pe ? 512 * ks : 1024 * ks, pe ? 512 : 1024, Es, lane, wave); }
            }
            SEAM(pb + 1);
        }
        if (IN(pb + 2)) for (int rep_ = 0; rep_ < REP_ELT; ++rep_) {
#pragma unroll 1
            for (int slot = 0; slot < 2; ++slot) { PHASE_ENV();
                if ((slot == 0) != sg_first_) elt_kpe(H, (const bf16*)(wl + WO_PE), KPE, cosT, sinT, out + O_KPEP + (size_t)l * MP * 64, out + O_KPES + (size_t)l * MS * 64, lds, tid, lane, wave, vcu, G);
                else elt_rows(Z, args.in[10] + l * QLR, args.in[12] + l * KVLR, args.in[14] + l * 3 * DCONV, args.in[16] + l * DCONV, args.in[6] + (size_t)l * NBS * 2 * DCONV,
                     QN, CKV, MIX, out + O_CKVP + (size_t)l * MP * 512, out + O_CKVS + (size_t)l * MS * 512, out + O_CONVP + (size_t)l * NBP * 2 * DCONV, out + O_CONVS + (size_t)l * NBS * 2 * DCONV, args.in[4] + (size_t)l * MC * 512, lane, gw, NGW);
            }
            PHASE_ENV();
            elt_rows_s(ZS, args.in[10] + l * QLR, args.in[12] + l * KVLR, args.in[14] + l * 3 * DCONV, args.in[16] + l * DCONV, args.in[6] + (size_t)l * NBS * 2 * DCONV,
                       QN + (size_t)MP * QLR, CKV + (size_t)KVROW_S * KVLR, MIX + (size_t)MP * DM, out + O_CKVS + (size_t)l * MS * 512, out + O_CONVS + (size_t)l * NBS * 2 * DCONV, lane, wave < 4 ? vcu : (1 << 20), G,
                       (const float*)(ws + WS_SSA + 65536), KPE + (size_t)KVROW_S * 64, out + O_KPES + (size_t)l * MS * 64, cosT, sinT, wave);
            SEAM(pb + 2);
        }
        if (IN(pb + 3)) for (int rep_ = 0; rep_ < REP_QKV; ++rep_) { PHASE_ENV();
            { pg8::Gemm g{QN, (const bf16*)(wl + WO_UQ), MP, NQ, QLR, (pg8::bf16_t*)(ws + WS_DUMMY)}; pg8::StaticOrder S; S.init(MP, NQ, G, bx);
              pg8::EpiStore<0> E{Qb, NQ};
              pg8::gemm_phase<pg8::EpiStore<0>, pg8::StaticOrder, true, true>(lds, g, S, E, wave0); }
            __syncthreads();
            { pg8::Gemm g{CKV, (const bf16*)(wl + WO_UKV), MP, NKV, KVLR, (pg8::bf16_t*)(ws + WS_DUMMY)}; pg8::StaticOrder S; S.init(MP, NKV, G, bx);
              pg8::EpiStore<0> E{KVb, NKV};
              pg8::gemm_phase<pg8::EpiStore<0>, pg8::StaticOrder, true, true>(lds, g, S, E, wave0); }
            __syncthreads();
            if (G != 256 || rbx < 128) for (int u = rbx; u < 144; u += (G == 256 ? 128 : G)) {
                if (u < 128) { SEpiBf<0> Es{(bf16*)(ws + WS_QA)}; sgemm_unit(lds, QN + (size_t)MP * QLR, (const bf16*)(wl + WO_QA), QLR, 32 * u, 0, 512, Es, lane, wave); }
                else { const int hh = (u - 128) >> 1, hf = (u - 128) & 1; SEpiBf<0> Es{(bf16*)(ws + WS_QA), 124 - 4 * hh};
                    sgemm_unit(lds, QN + (size_t)MP * QLR, (const bf16*)(wl + WO_UQ), QLR, hh * QKD + 128 + 32 * hf, 0, 512, Es, lane, wave); } }
            SEAM(pb + 3);
        }
        if (IN(pb + 4)) for (int rep_ = 0; rep_ < REP_ATT; ++rep_) {
#pragma unroll 1
            for (int slot = 0; slot < 3; ++slot) { PHASE_ENV();
                const int bh = vcu >> 2, role = vcu & 3;
                const int kind = sg_first_ ? (slot == 0 ? 2 : slot - 1) : (slot == 2 ? 2 : slot);
                if (kind == 2) {
                    const int su2_ = (G == 256) ? (((vcu & 15) == 0) ? 256 + (vcu >> 4) : NBS * SCH) : vcu + G;
#pragma unroll 1
                    for (int su = vcu, ns_ = 0; su < NBS * SCH; su = (ns_++ == 0 ? su2_ : su + G)) { const int sb = su < 256 ? (su >> 4) : su - 256, sc_ = su < 256 ? (su & 15) : 16;
                        sabs_unit(sb, sc_, (const bf16*)(ws + WS_QA), CKV, KPE, args.in[4] + (size_t)l * MC * 512, args.in[5] + (size_t)l * MC * 64, cosT, sinT, (bf16*)(ws + WS_PO), (float*)(ws + WS_PML), lds, lane, wave); }
                } else if (G == NBP * NH * 4) att::attn_unit(bh >> 3, bh & 7, kind == 0 ? 7 - role : role, Qb, KVb, KPE, MIX, cosT, sinT, (char*)lds_raw, wave0);
            }
            if (G != NBP * NH * 4) { PHASE_ENV(); (void)lane;
                for (int pu = vcu; pu < NBP * NH * 4; pu += G) { const int bh = pu >> 2, s = pu & 3;
#pragma unroll 1
                    for (int k = 0; k < 2; ++k) att::attn_unit(bh >> 3, bh & 7, k == 0 ? 7 - s : s, Qb, KVb, KPE, MIX, cosT, sinT, (char*)lds_raw, wave0); } }
            SEAM(pb + 4);
        }
        if (IN(pb + 5)) { PHASE_ENV();
#pragma unroll 1
            for (int cu = (G == 256 ? ((vcu & 1) ? NBS * NH : (vcu >> 1)) : vcu); cu < NBS * NH; cu += G) scomb_unit((cu & 127) >> 3, cu & 7, (const bf16*)(ws + WS_PO), (const float*)(ws + WS_PML), (const bf16*)(wl + WO_UKV), args.in[15] + l * DATT, MIX + (size_t)MP * DM, (float*)(ws + WS_SSA), lds, lane, wave);
            if (G == 256) { const int hw_ = (vcu >> 1) * NWAVES + wave; if ((vcu & 1) == 0) anorm_rows(MIX, args.in[15] + l * DATT, lane, hw_, 1024, 4096); else anorm_rows(MIX, args.in[15] + l * DATT, lane, 4096 + hw_, 1024, MP); }
            else anorm_rows(MIX, args.in[15] + l * DATT, lane, gw, NGW, MP);
            SEAM(pb + 5); }
        if (IN(pb + 6)) { PHASE_ENV();
            if (sg_first_) {
            for (int u = rbx; u < 256 * REP_SG; u += G) { const int uu = u & 255; const int cb = uu & 63, ks = uu >> 6; SEpiPart Es{PS + (size_t)ks * MS * DM, DM};
                sgemm_unit(lds, MIX + (size_t)MP * DM, (const bf16*)(wl + WO_OUT), DM, 32 * cb, 512 * ks, 512, Es, lane, wave); }
            }
            pg8::Gemm g{MIX, (const bf16*)(wl + WO_OUT), MP, DM, DM, (pg8::bf16_t*)(ws + WS_DUMMY)}; pg8::StaticOrder S; S.init(MP, DM, G, bx);
            for (int rep_ = 1; rep_ < REP_OUT; ++rep_) { pg8::EpiResid Ed{l == 0 ? args.in[0] : nullptr, XB, (bf16*)(ws + WS_END), modl + 2 * DM}; pg8::gemm_phase<pg8::EpiResid, pg8::StaticOrder, true, true>(lds, g, S, Ed, wave0); __syncthreads(); }
            pg8::EpiResid E{l == 0 ? args.in[0] : nullptr, XB, XB, modl + 2 * DM};
            pg8::gemm_phase<pg8::EpiResid, pg8::StaticOrder, true, true>(lds, g, S, E, wave0);
            __syncthreads();
            if (!sg_first_) {
            for (int u = rbx; u < 256 * REP_SG; u += G) { const int uu = u & 255; const int cb = uu & 63, ks = uu >> 6; SEpiPart Es{PS + (size_t)ks * MS * DM, DM};
                sgemm_unit(lds, MIX + (size_t)MP * DM, (const bf16*)(wl + WO_OUT), DM, 32 * cb, 512 * ks, 512, Es, lane, wave); }
            }
            SEAM(pb + 6);
        }
        if (IN(pb + 7)) { PHASE_ENV(); norm_rows<false>(XB, modl, 3 * DM, 4 * DM, H, lane, PGW_, NGW);
            norm_rows_s_coop<false>(nullptr, X, false, PS, 4, modl + 2 * DM, modl, 3 * DM, 4 * DM, H + (size_t)MP * DM, nullptr, nullptr, (LAS float*)lds, lane, wave, vcu, G, (const float*)(ws + WS_SSA));
            SEAM(pb + 7); }
        if (IN(pb + 8)) for (int rep_ = 0; rep_ < REP_UP; ++rep_) { PHASE_ENV();
            if (sg_first_) {
            for (int u = rbx; u < 256 * REP_SG; u += G) { SEpiBf<1> Es{HB + (size_t)MP * DFF};
                sgemm_unit(lds, H + (size_t)MP * DM, (const bf16*)(wl + WO_UP), DM, 32 * (u & 255), 0, 2048, Es, lane, wave); }
            }
            pg8::Gemm g{H, (const bf16*)(wl + WO_UP), MP, DFF, DM, (pg8::bf16_t*)(ws + WS_DUMMY)}; pg8::StaticOrder S; S.init(MP, DFF, G, bx);
            pg8::EpiStore<1> E{HB, DFF};
            pg8::gemm_phase<pg8::EpiStore<1>, pg8::StaticOrder, true, true>(lds, g, S, E, wave0);
            __syncthreads();
            if (!sg_first_) {
            for (int u = rbx; u < 256 * REP_SG; u += G) { SEpiBf<1> Es{HB + (size_t)MP * DFF};
                sgemm_unit(lds, H + (size_t)MP * DM, (const bf16*)(wl + WO_UP), DM, 32 * (u & 255), 0, 2048, Es, lane, wave); }
            }
            SEAM(pb + 8);
        }
        if (IN(pb + 9)) { PHASE_ENV();
            if (sg_first_) {
            for (int u = rbx; u < 256 * REP_SG; u += G) { const int uu = u & 255; const int cb = uu & 63, ks = uu >> 6; SEpiPart Es{PS + (size_t)ks * MS * DM, DM};
                sgemm_unit(lds, HB + (size_t)MP * DFF, (const bf16*)(wl + WO_DN), DFF, 32 * cb, 2048 * ks, 2048, Es, lane, wave); }
            }
            pg8::Gemm g{HB, (const bf16*)(wl + WO_DN), MP, DM, DFF, (pg8::bf16_t*)(ws + WS_DUMMY)}; pg8::StaticOrder S; S.init(MP, DM, G, bx);
            for (int rep_ = 1; rep_ < REP_DN; ++rep_) { pg8::EpiResid Ed{nullptr, XB, (bf16*)(ws + WS_END), modl + 5 * DM}; pg8::gemm_phase<pg8::EpiResid, pg8::StaticOrder, true, true>(lds, g, S, Ed, wave0); __syncthreads(); }
            pg8::EpiResid E{nullptr, XB, XB, modl + 5 * DM};
            pg8::gemm_phase<pg8::EpiResid, pg8::StaticOrder, true, true>(lds, g, S, E, wave0);
            __syncthreads();
            if (!sg_first_) {
            for (int u = rbx; u < 256 * REP_SG; u += G) { const int uu = u & 255; const int cb = uu & 63, ks = uu >> 6; SEpiPart Es{PS + (size_t)ks * MS * DM, DM};
                sgemm_unit(lds, HB + (size_t)MP * DFF, (const bf16*)(wl + WO_DN), DFF, 32 * cb, 2048 * ks, 2048, Es, lane, wave); }
            }
            SEAM(pb + 9);
        }
    }
    int lo_f = args.ph_lo, hi_f = args.ph_hi; asm volatile("" : "+s"(lo_f), "+s"(hi_f));
    if (lo_f <= PH_FINAL && PH_FINAL < hi_f) { const int l = 0; PHASE_ENV(); final_norm_rows(XB, args.in[20], out, lane, PGW_, NGW);
        norm_rows_s_coop<true>(nullptr, X, false, PS, 4, (const float*)(ws + WS_MOD) + (size_t)(DEPTH - 1) * NB * MODW + 5 * DM, nullptr, 0, 0, nullptr, args.in[20], out, (LAS float*)lds, lane, wave, vcu, G); }
#undef IN
#undef SEAM
}

extern "C" void kernel_launch(void* const* d_in, const int* in_sizes, int n_in, void* d_out, int out_size, void* d_ws, size_t ws_size, hipStream_t stream) {
    static int grid = 0;
    if (grid == 0) {
        if (n_in != 21 || in_sizes[0] != MP * DM || (size_t)out_size != O_END || ws_size < WS_END + ((REP_DN > 1 || REP_OUT > 1) ? (size_t)MP * DM * 4 : 0)) {
            fprintf(stderr, "kernel_launch: shape mismatch: n_in %d in0 %d out %d ws %zu (need %zu); nothing launched\n", n_in, n_in > 0 ? in_sizes[0] : -1, out_size, ws_size, (size_t)WS_END); grid = -1; return; }
        int dev = 0, cus = 0, per_cu = 0;
        if (hipGetDevice(&dev) != hipSuccess || hipDeviceGetAttribute(&cus, hipDeviceAttributeMultiprocessorCount, dev) != hipSuccess) { fprintf(stderr, "kernel_launch: device query failed\n"); grid = -1; return; }
        if (hipFuncSetAttribute((const void*)trunk_fwd, hipFuncAttributeMaxDynamicSharedMemorySize, LDS_BYTES) != hipSuccess) { fprintf(stderr, "kernel_launch: hipFuncSetAttribute failed\n"); grid = -1; return; }
        if (hipOccupancyMaxActiveBlocksPerMultiprocessor(&per_cu, (const void*)trunk_fwd, NWAVES * 64, LDS_BYTES) != hipSuccess || per_cu < 1)
            fprintf(stderr, "kernel_launch: note: occupancy query reports %d workgroups per CU\n", per_cu);
        (void)hipGetLastError();
        grid = cus;
    }
    if (grid < 0) return;
    if (hipMemsetAsync((char*)d_ws + WS_CTL, 0, CTL_ZERO_BYTES, stream) != hipSuccess) { fprintf(stderr, "kernel_launch: memset failed\n"); return; }
    Args a{};
    for (int i = 0; i < 21; ++i) a.in[i] = (const float*)d_in[i];
    a.out = (float*)d_out; a.ws = (unsigned char*)d_ws;
#if MK_MULTI
    for (int p = 0; p < N_PHASES; ++p) { a.ph_lo = p; a.ph_hi = p + 1; hipLaunchKernelGGL(trunk_fwd, dim3(grid), dim3(NWAVES * 64), LDS_BYTES, stream, a); }
#else
    a.ph_lo = 0; a.ph_hi = N_PHASES;
    hipLaunchKernelGGL(trunk_fwd, dim3(grid), dim3(NWAVES * 64), LDS_BYTES, stream, a);
#endif
    const hipError_t le = hipPeekAtLastError();
    if (le != hipSuccess) fprintf(stderr, "kernel_launch: launch failed: %s\n", hipGetErrorName(le));
}
```

```cpp
#include <hip/hip_runtime.h>
#include <cstdio>
#include <cstdint>
namespace pg8 {
#define PG8_LAS __attribute__((address_space(3)))
typedef unsigned short bf16_t;
typedef short bf16x8 __attribute__((ext_vector_type(8)));
typedef float f32x4 __attribute__((ext_vector_type(4)));
typedef unsigned u32x4 __attribute__((ext_vector_type(4)));
constexpr int BM = 256, BK = 64, HALF = 128, HTB = HALF * BK * 2  , STAGE_BYTES = 8 * HTB, NXCD = 8, WGM = 8;

__host__ __device__ __forceinline__ int lds_byte(int r, int c) { const int st = (r >> 4) * 2 + (c >> 5), rr = r & 15, cc = c & 31, ob = rr * 64 + cc * 2; return st * 1024 + (ob ^ (((ob >> 9) & 1) << 5)); }
__host__ __device__ __forceinline__ void stage_rc(int b, int& R, int& C) { const int st = b / 1024, sb = b % 1024, swz = sb ^ (((sb >> 9) & 1) << 5); R = (st >> 1) * 16 + swz / 64; C = (st & 1) * 32 + (swz % 64) / 2; }
__host__ __device__ __forceinline__ int perm32(int rho) { const int n = rho >> 4, i = rho & 15; return 8 * (i >> 2) + 4 * n + (i & 3); }

struct Unit { int pm, pn; };
struct Gemm { const bf16_t* A; const bf16_t* Bt; int M, N, K; bf16_t* dummy; };

struct StaticOrder {
    int nM, nN, nwg, G, c;
    __host__ __device__ void init(int M, int N, int G_, int c_) { nM = M / BM; nN = N / BM; nwg = nM * nN; G = G_; c = c_; }
    __host__ __device__ bool next(int i, Unit& u) const {
        const long L = (long)i * G + c; if (L >= nwg) return false;
        int wgid = (int)L; { const int q = nwg / NXCD, r = nwg % NXCD, xcd = wgid % NXCD, off = wgid / NXCD; wgid = (xcd < r ? xcd * (q + 1) : r * (q + 1) + (xcd - r) * q) + off; }
        const int nig = WGM * nN, gid = wgid / nig, fm = gid * WGM, gsz = (nM - fm) < WGM ? (nM - fm) : WGM;
        u.pm = fm + ((wgid % nig) % gsz); u.pn = (wgid % nig) / gsz; return true;
    }
    __device__ __forceinline__ void a_ready(const Unit&) const {}
    __device__ __forceinline__ void done(const Unit&) const {}
};

typedef float f32x2pk __attribute__((ext_vector_type(2))); typedef __bf16 bf16x2pk __attribute__((ext_vector_type(2)));
__device__ __forceinline__ unsigned cvt_pk_bf16(float lo, float hi) { const f32x2pk v = {lo, hi}; const bf16x2pk b = __builtin_convertvector(v, bf16x2pk); return __builtin_bit_cast(unsigned, b); }
typedef float f32x2 __attribute__((ext_vector_type(2)));
template <class Epi, class Sched, bool ALIGN_EPI = false, bool SP2 = false>
__device__ __forceinline__ void gemm_phase(PG8_LAS unsigned char* lds, const Gemm g, const Sched& S, const Epi& E, const int wave_s  ) {
    int tid_l; asm volatile("v_mbcnt_lo_u32_b32 %0, -1, 0\n\tv_mbcnt_hi_u32_b32 %0, -1, %0" : "=v"(tid_l)); tid_l += wave_s * 64;
    const int tid = tid_l, wid = wave_s, lane = tid & 63, wr = wid >> 2, wc = wid & 3, fr = lane & 15, fq = lane >> 4;
    const int K = g.K, nt = K / BK;
    unsigned voffA[2], voffB[2];
#pragma unroll
    for (int i = 0; i < 2; ++i) { int R, C; stage_rc(tid * 16 + i * 8192, R, C); const int Rb = Epi::PERM ? ((R & ~31) + perm32(R & 31)) : R;
        voffA[i] = (unsigned)(R * K + C) * 2u; voffB[i] = (unsigned)(Rb * K + C) * 2u; }
    const size_t kstep = (size_t)(BK * 2);
    const size_t hstep = (size_t)HALF * K * 2;
    const size_t tstep = 2 * hstep;
    const unsigned ldsw = (unsigned)wid * 1024u;
    const int aoff = lds_byte(wr * 64 + fr, fq * 8), boff = lds_byte(wc * 32 + fr, fq * 8);
#define PG8_SA(b, h) (((b) * 2 + (h)) * HTB)
#define PG8_SB(b, h) ((4 + (b) * 2 + (h)) * HTB)
#define PG8_STAGE(bufoff, gbase, voff) do { _Pragma("unroll") for (int _i = 0; _i < 2; ++_i) \
        __builtin_amdgcn_global_load_lds((const unsigned*)((const char*)(gbase) + (voff)[_i]), (PG8_LAS unsigned*)(lds + (bufoff) + ldsw + _i * 8192), 16, 0, 0); } while (0)
#define PG8_LDA(dst, b, h) do { _Pragma("unroll") for (int m = 0; m < 4; ++m) _Pragma("unroll") for (int k = 0; k < 2; ++k) dst[m][k] = *(const PG8_LAS bf16x8*)(lds + PG8_SA(b, h) + aoff + m * 2048 + k * 1024); } while (0)
#define PG8_LDB(dst, b, h) do { _Pragma("unroll") for (int n = 0; n < 2; ++n) _Pragma("unroll") for (int k = 0; k < 2; ++k) dst[n][k] = *(const PG8_LAS bf16x8*)(lds + PG8_SB(b, h) + boff + n * 2048 + k * 1024); } while (0)
#define PG8_MMA(ai, bj, At, Bt) do { __builtin_amdgcn_s_setprio(1); _Pragma("unroll") for (int m = 0; m < 4; ++m) _Pragma("unroll") for (int n = 0; n < 2; ++n) _Pragma("unroll") for (int k = 0; k < 2; ++k) \
        acc[ai][bj][m][n] = __builtin_amdgcn_mfma_f32_16x16x32_bf16(Bt[n][k], At[m][k], acc[ai][bj][m][n], 0, 0, 0); __builtin_amdgcn_s_setprio(0); } while (0)
#define PG8_WAIT_V(n) asm volatile("s_waitcnt vmcnt(" #n ")" ::: "memory")
#define PG8_WAIT_L(n) asm volatile("s_waitcnt lgkmcnt(" #n ")" ::: "memory")
#define PG8_WAIT_VR(flag, n) asm volatile("s_cmp_eq_u32 %0, 0\n\ts_cbranch_scc0 .Lpg8w%=\n\ts_waitcnt vmcnt(8)\n.Lpg8w%=:\n\ts_waitcnt vmcnt(%1)" :: "s"(flag), "n"(n) : "memory", "scc")
#define PG8_BAR __builtin_amdgcn_s_barrier()
#define PG8_SCHED __builtin_amdgcn_sched_barrier(0)
    Unit cur, nxt; int ui = 0;
    if (!S.next(0, cur)) return;
    f32x4 acc[2][2][4][2];
#pragma unroll
    for (int a = 0; a < 2; ++a)
#pragma unroll
        for (int b = 0; b < 2; ++b)
#pragma unroll
            for (int m = 0; m < 4; ++m)
#pragma unroll
                for (int n = 0; n < 2; ++n) acc[a][b][m][n] = (f32x4){0.f, 0.f, 0.f, 0.f};
    bf16x8 At[4][2], B0[2][2], B1[2][2];
    const char* cA = (const char*)g.A + (size_t)cur.pm * tstep; const char* cB = (const char*)g.Bt + (size_t)cur.pn * tstep;
    S.a_ready(cur);
    if constexpr (SP2) {
        PG8_STAGE(PG8_SB(0, 0), cB, voffB); PG8_STAGE(PG8_SB(0, 1), cB + hstep, voffB); PG8_STAGE(PG8_SA(0, 0), cA, voffA); PG8_STAGE(PG8_SA(0, 1), cA + hstep, voffA);
        if (wr == 1) PG8_BAR;
        PG8_WAIT_V(2); PG8_BAR;
        PG8_STAGE(PG8_SB(1, 0), cB + kstep, voffB); PG8_STAGE(PG8_SA(1, 0), cA + kstep, voffA); PG8_STAGE(PG8_SB(1, 1), cB + hstep + kstep, voffB);
        PG8_WAIT_V(6); PG8_BAR;
    } else {
        PG8_STAGE(PG8_SB(0, 0), cB, voffB); PG8_STAGE(PG8_SA(0, 0), cA, voffA); PG8_STAGE(PG8_SB(0, 1), cB + hstep, voffB); PG8_STAGE(PG8_SA(0, 1), cA + hstep, voffA);
        if (wr == 1) PG8_BAR;
        PG8_WAIT_V(4); PG8_BAR;
        PG8_STAGE(PG8_SB(1, 0), cB + kstep, voffB); PG8_STAGE(PG8_SA(1, 0), cA + kstep, voffA); PG8_STAGE(PG8_SB(1, 1), cB + hstep + kstep, voffB);
        PG8_WAIT_V(6); PG8_BAR;
    }
    for (;;) {
        const bool has_next = S.next(ui + 1, nxt);
        const char* nA = has_next ? (const char*)g.A + (size_t)nxt.pm * tstep : cA; const char* nB = has_next ? (const char*)g.Bt + (size_t)nxt.pn * tstep : cB;
        for (int t = 0; t < nt; t += 2) {
            const bool last = (t == nt - 2);
            const char* a1 = cA + (size_t)(t + 1) * kstep;
            const char* a2 = last ? nA : cA + (size_t)(t + 2) * kstep; const char* b2 = last ? nB : cB + (size_t)(t + 2) * kstep;
            const char* a3 = a2 + kstep; const char* b3 = b2 + kstep;
            if (last && has_next) S.a_ready(nxt);
            if constexpr (SP2) {
            PG8_LDB(B0, 0, 0); PG8_LDB(B1, 0, 1); PG8_SCHED; PG8_LDA(At, 0, 0); PG8_STAGE(PG8_SA(1, 1), a1 + hstep, voffA);
            PG8_WAIT_V(8); PG8_WAIT_L(0); PG8_BAR; PG8_MMA(0, 0, At, B0); PG8_MMA(0, 1, At, B1); PG8_BAR; PG8_SCHED;
            PG8_LDA(At, 0, 1); PG8_STAGE(PG8_SB(0, 0), b2, voffB); PG8_STAGE(PG8_SB(0, 1), b2 + hstep, voffB); PG8_STAGE(PG8_SA(0, 0), a2, voffA);
            PG8_WAIT_V(8); PG8_WAIT_L(0); PG8_BAR; PG8_MMA(1, 0, At, B0); PG8_MMA(1, 1, At, B1); PG8_BAR; PG8_SCHED;
            PG8_LDB(B0, 1, 0); PG8_LDB(B1, 1, 1); PG8_SCHED; PG8_LDA(At, 1, 0); PG8_STAGE(PG8_SA(0, 1), a2 + hstep, voffA);
            PG8_WAIT_V(8); PG8_WAIT_L(0); PG8_BAR; PG8_MMA(0, 0, At, B0); PG8_MMA(0, 1, At, B1); PG8_BAR; PG8_SCHED;
            PG8_LDA(At, 1, 1); PG8_STAGE(PG8_SB(1, 0), b3, voffB); PG8_STAGE(PG8_SB(1, 1), b3 + hstep, voffB); PG8_STAGE(PG8_SA(1, 0), a3, voffA);
            PG8_WAIT_V(8); PG8_WAIT_L(0); PG8_BAR; PG8_MMA(1, 0, At, B0); PG8_MMA(1, 1, At, B1); PG8_BAR; PG8_SCHED;
            } else {
            PG8_LDB(B0, 0, 0); PG8_SCHED; PG8_LDA(At, 0, 0); PG8_STAGE(PG8_SA(1, 1), a1 + hstep, voffA);
            PG8_WAIT_L(8); PG8_BAR; PG8_WAIT_L(0); PG8_MMA(0, 0, At, B0); PG8_BAR; PG8_SCHED;
            PG8_LDB(B1, 0, 1); PG8_STAGE(PG8_SB(0, 0), b2, voffB);
            PG8_BAR; PG8_WAIT_L(0); PG8_MMA(0, 1, At, B1); PG8_BAR;
            PG8_LDA(At, 0, 1); PG8_STAGE(PG8_SA(0, 0), a2, voffA);
            PG8_BAR; PG8_WAIT_L(0); PG8_MMA(1, 0, At, B0); PG8_BAR; PG8_SCHED;
            PG8_STAGE(PG8_SB(0, 1), b2 + hstep, voffB);
            PG8_WAIT_V(6); PG8_BAR; PG8_MMA(1, 1, At, B1); PG8_BAR;
            PG8_LDB(B0, 1, 0); PG8_SCHED; PG8_LDA(At, 1, 0); PG8_STAGE(PG8_SA(0, 1), a2 + hstep, voffA);
            PG8_WAIT_L(8); PG8_BAR; PG8_WAIT_L(0); PG8_MMA(0, 0, At, B0); PG8_BAR; PG8_SCHED;
            PG8_LDB(B1, 1, 1); PG8_STAGE(PG8_SB(1, 0), b3, voffB);
            PG8_BAR; PG8_WAIT_L(0); PG8_MMA(0, 1, At, B1); PG8_BAR;
            PG8_LDA(At, 1, 1); PG8_STAGE(PG8_SA(1, 0), a3, voffA);
            PG8_BAR; PG8_WAIT_L(0); PG8_MMA(1, 0, At, B0); PG8_BAR; PG8_SCHED;
            PG8_STAGE(PG8_SB(1, 1), b3 + hstep, voffB);
            PG8_WAIT_V(6); PG8_BAR; PG8_MMA(1, 1, At, B1); PG8_BAR;
            }
        }
        if constexpr (ALIGN_EPI) { if (wr == 0) PG8_BAR; }
        if constexpr (!Epi::AFTER_DRAIN) { E(acc, cur, wr, wc, fr, fq); S.done(cur); }
        if (!has_next) break;
#pragma unroll
        for (int a = 0; a < 2; ++a)
#pragma unroll
            for (int b = 0; b < 2; ++b)
#pragma unroll
                for (int m = 0; m < 4; ++m)
#pragma unroll
                    for (int n = 0; n < 2; ++n) acc[a][b][m][n] = (f32x4){0.f, 0.f, 0.f, 0.f};
        cur = nxt; cA = nA; cB = nB; ++ui;
        if constexpr (ALIGN_EPI) { if (wr == 1) PG8_BAR; }
    }
    PG8_WAIT_V(0);
    if constexpr (!ALIGN_EPI) { if (wr == 0) PG8_BAR; }
    PG8_BAR;
    if constexpr (Epi::AFTER_DRAIN) { E.fused(acc, cur, wr, wc, fr, fq, lds, wid, lane); S.done(cur); }
#undef PG8_SA
#undef PG8_SB
#undef PG8_STAGE
#undef PG8_LDA
#undef PG8_LDB
#undef PG8_MMA
#undef PG8_WAIT_V
#undef PG8_WAIT_L
#undef PG8_WAIT_VR
#undef PG8_BAR
#undef PG8_SCHED
}
}
#define GAS __attribute__((address_space(1)))
#define LAS __attribute__((address_space(3)))
typedef unsigned short bf16;
typedef unsigned v4u __attribute__((ext_vector_type(4)));
typedef float f32x4 __attribute__((ext_vector_type(4)));
typedef short bf16x8 __attribute__((ext_vector_type(8)));
typedef GAS unsigned gu32;
typedef GAS unsigned long long gu64;
#define RLX_AGENT __ATOMIC_RELAXED, __HIP_MEMORY_SCOPE_AGENT
#define LDS_WAIT() asm volatile("s_waitcnt lgkmcnt(0)" ::: "memory")
#define VM_WAIT() asm volatile("s_waitcnt vmcnt(0)" ::: "memory")
__device__ __forceinline__ unsigned long long rt() { return __builtin_amdgcn_s_memrealtime(); }
__device__ __forceinline__ unsigned f2bf(float f) { unsigned u = __builtin_bit_cast(unsigned, f); return (u + 0x7fffu + ((u >> 16) & 1u)) >> 16; }
__device__ __forceinline__ unsigned pk2(float lo, float hi) { return f2bf(lo) | (f2bf(hi) << 16); }
#define XB_TMO      128
#define XB_XCNT(j)  (256  + 64 * (j))
#define XB_XSUB(j)  (1280 + 64 * (j))
#define XB_XGEN(j)  (2304 + 64 * (j))
#define XB_TOP      3328
#define XB_TOPGEN   3392
#define XCD_BAR_WORDS 3456
#define XB_SPIN_CAP (1u << 18)

__device__ __forceinline__ unsigned xb_ld(unsigned* p)              { return __hip_atomic_load(p, __ATOMIC_RELAXED, __HIP_MEMORY_SCOPE_AGENT); }
__device__ __forceinline__ unsigned xb_add(unsigned* p, unsigned v) { return __hip_atomic_fetch_add(p, v, __ATOMIC_RELAXED, __HIP_MEMORY_SCOPE_AGENT); }
__device__ __forceinline__ unsigned xb_xcc_id() { return (unsigned)__builtin_amdgcn_s_getreg((3 << 11) | 20) & 0xFu; }
#define XB_SPIN(cond, bar) do { unsigned _sp = 0; while (cond) { __builtin_amdgcn_s_sleep(1); \
    if ((++_sp & 255u) == 0u) { if (xb_ld(&(bar)[XB_TMO])) break; if (_sp > XB_SPIN_CAP) { atomicAdd(&(bar)[XB_TMO], 1u); break; } } } } while (0)

struct XcdBarrier {
    unsigned* bar; unsigned x;
    volatile LAS unsigned* st;
};

__device__ __forceinline__ XcdBarrier xcd_barrier_post(unsigned* bar, volatile LAS unsigned* st) {
    XcdBarrier b; b.bar = bar; b.x = xb_xcc_id(); b.st = st;
    if (threadIdx.x == 0) (void)xb_add(&bar[XB_XCNT(b.x)], 1u);
    return b;
}
__device__ __forceinline__ void xcd_barrier_complete(unsigned* bar, unsigned x, unsigned& nloc, unsigned& nx) {
    const unsigned G = gridDim.x * gridDim.y * gridDim.z;
    unsigned sum, cnt, mine, sp = 0u;
    for (;;) {
        sum = 0u; cnt = 0u; mine = 0u;
#pragma unroll
        for (unsigned j = 0; j < 16; ++j) { const unsigned c = xb_ld(&bar[XB_XCNT(j)]); sum += c; cnt += (c > 0u) ? 1u : 0u; mine = (j == x) ? c : mine; }
        if (sum == G) break;
        __builtin_amdgcn_s_sleep(1);
        if ((++sp & 255u) == 0u) { if (xb_ld(&bar[XB_TMO])) break; if (sp > XB_SPIN_CAP) { atomicAdd(&bar[XB_TMO], 1u); break; } }
    }
    nloc = mine > 0u ? mine : 1u; nx = cnt > 0u ? cnt : 1u;
}

__device__ __forceinline__ void xcd_barrier(const XcdBarrier& b) {
    asm volatile("s_waitcnt vmcnt(0)" ::: "memory");
    __syncthreads();
    if (threadIdx.x == 0) {
        unsigned* bar = b.bar;
        __builtin_amdgcn_s_waitcnt(0);
        unsigned nloc = b.st[0], nx = b.st[1];
        if (nloc == 0u) { xcd_barrier_complete(bar, b.x, nloc, nx); b.st[0] = nloc; b.st[1] = nx; }
        const unsigned old = xb_add(&bar[XB_XSUB(b.x)], 1u);
        const unsigned gen = old / nloc;
        if (old + 1u == (gen + 1u) * nloc) {
            __builtin_amdgcn_fence(__ATOMIC_RELEASE, "agent");
            asm volatile("s_waitcnt vmcnt(0)" ::: "memory");
            const unsigned og = xb_add(&bar[XB_TOP], 1u);
            const unsigned tg = og / nx;
            if (og + 1u == (tg + 1u) * nx) xb_add(&bar[XB_TOPGEN], 1u);
            else XB_SPIN(xb_ld(&bar[XB_TOPGEN]) == tg, bar);
            __builtin_amdgcn_fence(__ATOMIC_ACQUIRE, "agent");
            xb_add(&bar[XB_XGEN(b.x)], 1u);
            asm volatile("s_waitcnt vmcnt(0)" ::: "memory");
        } else {
            XB_SPIN(xb_ld(&bar[XB_XGEN(b.x)]) == gen, bar);
            __builtin_amdgcn_fence(__ATOMIC_ACQUIRE, "agent");
            asm volatile("s_waitcnt vmcnt(0)" ::: "memory");
        }
    }
    __syncthreads();
}

constexpr int DM = 2048, SEQ = 2048, NBP = 8, NBS = 16, TS = 16, PAST = 2048, DEPTH = 4;
constexpr int MP = NBP * SEQ, MS = NBS * TS, MR = MP + MS, MC = NBS * PAST, MKV = MR + MC;
constexpr int NH = 8, QKD = 192, QLR = 512, KVLR = 512, DATT = 1024, DCONV = 1024, DFF = 8192, INC = 4160;
constexpr int ZW = 3072, NQ = NH * QKD, NKV = NH * 256, MODW = 6 * DM, NB = NBP + NBS;
constexpr int NPOS = PAST + TS;
constexpr float EPS = 1e-6f;
constexpr float ATTN_SCALE = 0.07216878364870322f;
constexpr float LOG2E = 1.4426950408889634f;

namespace pg8 {
template <int ACT> struct EpiStore {
    static constexpr bool PERM = true, AFTER_DRAIN = false; static constexpr int NST = 16;
    bf16_t* O; int ldc;
    __device__ __forceinline__ void operator()(const f32x4 (&acc)[2][2][4][2], const Unit& u, int wr, int wc, int fr, int fq) const {
        const int row0 = u.pm * BM + wr * 64 + fr, col0 = u.pn * BM + wc * 32 + 8 * fq;
#pragma unroll
        for (int ai = 0; ai < 2; ++ai)
#pragma unroll
            for (int m = 0; m < 4; ++m) { bf16_t* rowp = O + (size_t)(row0 + ai * HALF + m * 16) * ldc + col0;
#pragma unroll
                for (int bj = 0; bj < 2; ++bj) { f32x4 v0 = acc[ai][bj][m][0], v1 = acc[ai][bj][m][1];
                    if (ACT == 1) {
#pragma unroll
                        for (int e = 0; e < 4; ++e) { const float a = v0[e] > 0.f ? v0[e] : 0.f, b = v1[e] > 0.f ? v1[e] : 0.f; v0[e] = a * a; v1[e] = b * b; } }
                    u32x4 w; w.x = cvt_pk_bf16(v0[0], v0[1]); w.y = cvt_pk_bf16(v0[2], v0[3]); w.z = cvt_pk_bf16(v1[0], v1[1]); w.w = cvt_pk_bf16(v1[2], v1[3]);
                    *(u32x4*)(rowp + bj * HALF) = w; } }
    }
};
struct EpiZ {
    static constexpr bool PERM = true, AFTER_DRAIN = false; static constexpr int NST = 8;
    bf16_t* O;
    __device__ __forceinline__ void operator()(const f32x4 (&acc)[2][2][4][2], const Unit& u, int wr, int wc, int fr, int fq) const {
        const int row0 = u.pm * BM + wr * 64 + fr, lc = wc * 32 + 8 * fq;
        const bool prod = (u.pn >= 4 && u.pn < 12);
        const int colb = prod ? 1024 + 128 * (u.pn - 4) : (u.pn < 4 ? 256 * u.pn : 2048 + 256 * (u.pn - 12));
#pragma unroll
        for (int ai = 0; ai < 2; ++ai)
#pragma unroll
            for (int m = 0; m < 4; ++m) { bf16_t* rowp = O + (size_t)(row0 + ai * HALF + m * 16) * ZW + colb + lc;
                if (prod) { const f32x4 v0 = acc[ai][0][m][0] * acc[ai][1][m][0], v1 = acc[ai][0][m][1] * acc[ai][1][m][1];
                    u32x4 w; w.x = cvt_pk_bf16(v0[0], v0[1]); w.y = cvt_pk_bf16(v0[2], v0[3]); w.z = cvt_pk_bf16(v1[0], v1[1]); w.w = cvt_pk_bf16(v1[2], v1[3]);
                    *(u32x4*)(rowp) = w; }
                else {
#pragma unroll
                    for (int bj = 0; bj < 2; ++bj) { const f32x4 v0 = acc[ai][bj][m][0], v1 = acc[ai][bj][m][1];
                        u32x4 w; w.x = cvt_pk_bf16(v0[0], v0[1]); w.y = cvt_pk_bf16(v0[2], v0[3]); w.z = cvt_pk_bf16(v1[0], v1[1]); w.w = cvt_pk_bf16(v1[2], v1[3]);
                        *(u32x4*)(rowp + bj * HALF) = w; } } }
    }
};
struct EpiResid {
    static constexpr bool PERM = true, AFTER_DRAIN = false; static constexpr int NST = 0;
    const float* xin32; const bf16_t* xin16; bf16_t* xout; const float* gate;
    __device__ __forceinline__ void operator()(const f32x4 (&acc)[2][2][4][2], const Unit& u, int wr, int wc, int fr, int fq) const {
        const int col0 = u.pn * BM + wc * 32 + 8 * fq;
        const float* g = gate + (size_t)(u.pm >> 3) * MODW + col0;
#pragma unroll
        for (int ai = 0; ai < 2; ++ai)
#pragma unroll
            for (int m = 0; m < 4; ++m) { const size_t off = (size_t)(u.pm * BM + ai * HALF + wr * 64 + m * 16 + fr) * DM + col0;
#pragma unroll
                for (int bj = 0; bj < 2; ++bj) { f32x4 x0, x1;
                    if (xin32) { x0 = *(const f32x4*)(xin32 + off + bj * HALF); x1 = *(const f32x4*)(xin32 + off + bj * HALF + 4); }
                    else { const u32x4 w = *(const u32x4*)(xin16 + off + bj * HALF);
                        x0 = (f32x4){__uint_as_float(w.x << 16), __uint_as_float(w.x & 0xffff0000u), __uint_as_float(w.y << 16), __uint_as_float(w.y & 0xffff0000u)};
                        x1 = (f32x4){__uint_as_float(w.z << 16), __uint_as_float(w.z & 0xffff0000u), __uint_as_float(w.w << 16), __uint_as_float(w.w & 0xffff0000u)}; }
                    const f32x4 y0 = x0 + *(const f32x4*)(g + bj * HALF) * acc[ai][bj][m][0], y1 = x1 + *(const f32x4*)(g + bj * HALF + 4) * acc[ai][bj][m][1];
                    u32x4 o; o.x = cvt_pk_bf16(y0[0], y0[1]); o.y = cvt_pk_bf16(y0[2], y0[3]); o.z = cvt_pk_bf16(y1[0], y1[1]); o.w = cvt_pk_bf16(y1[2], y1[3]);
                    *(u32x4*)(xout + off + bj * HALF) = o; } }
    }
};
}

namespace att {
using bf16x8 = __attribute__((ext_vector_type(8))) short;
using s16x4  = __attribute__((ext_vector_type(4))) short;
using f32x16 = __attribute__((ext_vector_type(16))) float;
using f32x4  = __attribute__((ext_vector_type(4))) float;
using u32x4  = __attribute__((ext_vector_type(4))) unsigned;
typedef unsigned short bf16_t;
constexpr int NW = 8, QBLK = 32, KVBLK = 64;
constexpr int SHM_V = KVBLK * 128 * 2, SHM_KN = KVBLK * 128 * 2, SHM_KP = KVBLK * 64 * 2;
constexpr int OFF_V = 0, OFF_KN = 2 * SHM_V, OFF_KP = OFF_KN + 2 * SHM_KN, OFF_WS = OFF_KP + 2 * SHM_KP, OFF_QP = OFF_WS + NW * 64 * 4, ATT_LDS = OFF_QP + NW * 4 * 1024;
constexpr float THR = 8.f;
constexpr float CSC = ATTN_SCALE * LOG2E;
#define KSWZ(row, colB) ((row) * 256 + ((colB) ^ (((row) & 7) << 4)))
#define PSWZ(row, colB) ((row) * 128 + ((colB) ^ (((row) & 7) << 4)))
#define SBAR() __builtin_amdgcn_sched_barrier(0)
__device__ __forceinline__ int crow(int r, int hi) { return (r & 3) + 8 * (r >> 2) + 4 * hi; }
__device__ __forceinline__ unsigned cvtpk(float lo, float hi) { unsigned r; asm volatile("v_cvt_pk_bf16_f32 %0, %1, %2" : "=v"(r) : "v"(lo), "v"(hi)); return r; }
__device__ __forceinline__ float bflo(unsigned w) { return __uint_as_float(w << 16); }
__device__ __forceinline__ float bfhi(unsigned w) { return __uint_as_float(w & 0xffff0000u); }

__device__ __forceinline__ void partialSM(f32x16& p0, f32x16& p1, float& m_reg, float& mn, float& alpha) {
  float pmax = p0[0];
#pragma unroll
  for (int r = 1; r < 16; ++r) pmax = fmaxf(pmax, p0[r]);
#pragma unroll
  for (int r = 0; r < 16; ++r) pmax = fmaxf(pmax, p1[r]);
  { auto rr = __builtin_amdgcn_permlane32_swap(__float_as_uint(pmax), __float_as_uint(pmax), false, false);
    pmax = fmaxf(__uint_as_float(rr[0]), __uint_as_float(rr[1])); }
  if (__builtin_expect(__all(pmax - m_reg <= THR / ATTN_SCALE), 1)) { mn = m_reg; alpha = 1.f; }
  else { mn = fmaxf(m_reg, pmax); alpha = __builtin_amdgcn_exp2f((m_reg - mn) * CSC); m_reg = mn; }
  const float mnC = -mn * CSC;
#pragma unroll
  for (int r = 0; r < 16; ++r) p0[r] = fmaf(p0[r], CSC, mnC);
#pragma unroll
  for (int r = 0; r < 16; ++r) p1[r] = fmaf(p1[r], CSC, mnC);
#pragma unroll
  for (int r = 0; r < 16; ++r) p0[r] = __builtin_amdgcn_exp2f(p0[r]);
}
__device__ __forceinline__ void finishSM(f32x16& p0, f32x16& p1, float alpha, float& l_reg, bf16x8& pa0, bf16x8& pa1, bf16x8& pa2, bf16x8& pa3) {
#pragma unroll
  for (int r = 0; r < 16; ++r) p1[r] = __builtin_amdgcn_exp2f(p1[r]);
  float ps = 0;
#pragma unroll
  for (int r = 0; r < 16; ++r) ps += p0[r];
#pragma unroll
  for (int r = 0; r < 16; ++r) ps += p1[r];
  { auto rr = __builtin_amdgcn_permlane32_swap(__float_as_uint(ps), __float_as_uint(ps), false, false);
    ps = __uint_as_float(rr[0]) + __uint_as_float(rr[1]); }
  l_reg = l_reg * alpha + ps;
#define PK4(P, BASE, OUT) do { unsigned a0 = cvtpk(P[BASE + 0], P[BASE + 1]), a1 = cvtpk(P[BASE + 2], P[BASE + 3]);   \
    unsigned b0 = cvtpk(P[BASE + 4], P[BASE + 5]), b1 = cvtpk(P[BASE + 6], P[BASE + 7]);                              \
    auto r0 = __builtin_amdgcn_permlane32_swap(a0, b0, false, false); auto r1 = __builtin_amdgcn_permlane32_swap(a1, b1, false, false); \
    u32x4 w = {r0[0], r1[0], r0[1], r1[1]}; OUT = *reinterpret_cast<bf16x8*>(&w); } while (0)
  PK4(p0, 0, pa0); PK4(p0, 8, pa1); PK4(p1, 0, pa2); PK4(p1, 8, pa3);
#undef PK4
}
__device__ __forceinline__ void qkt(f32x16& p0, f32x16& p1, const char* Kn, const char* Kp, const bf16x8* qr, const char* qp, int r32, int hi) {
  p0 = f32x16{}; p1 = f32x16{};
#pragma unroll
  for (int d0 = 0; d0 < 8; ++d0) { const int cb = (d0 * 16 + hi * 8) * 2;
    const bf16x8 b0 = *reinterpret_cast<const bf16x8*>(Kn + KSWZ(r32, cb));
    const bf16x8 b1 = *reinterpret_cast<const bf16x8*>(Kn + KSWZ(32 + r32, cb));
    p0 = __builtin_amdgcn_mfma_f32_32x32x16_bf16(b0, qr[d0], p0, 0, 0, 0);
    p1 = __builtin_amdgcn_mfma_f32_32x32x16_bf16(b1, qr[d0], p1, 0, 0, 0); }
#pragma unroll
  for (int d0 = 0; d0 < 4; ++d0) { const int cb = (d0 * 16 + hi * 8) * 2;
    const bf16x8 b0 = *reinterpret_cast<const bf16x8*>(Kp + PSWZ(r32, cb));
    const bf16x8 b1 = *reinterpret_cast<const bf16x8*>(Kp + PSWZ(32 + r32, cb));
    const bf16x8 qd = *reinterpret_cast<const bf16x8*>(qp + d0 * 1024);
    p0 = __builtin_amdgcn_mfma_f32_32x32x16_bf16(b0, qd, p0, 0, 0, 0);
    p1 = __builtin_amdgcn_mfma_f32_32x32x16_bf16(b1, qd, p1, 0, 0, 0); }
}
__device__ __forceinline__ void maskt(f32x16& p0, f32x16& p1, bool hide) {
  if (hide) {
#pragma unroll
    for (int r = 0; r < 16; ++r) { p0[r] = -INFINITY; p1[r] = -INFINITY; } }
}
__device__ __forceinline__ int v_st(int k, int c) { const int kk = (k & ~0xC) | ((k & 4) << 1) | ((k & 8) >> 1); return ((kk >> 3) * 4 + (c >> 5)) * 512 + ((kk & 7) * 32 + (c & 31)) * 2; }
__device__ __forceinline__ int v_rd_base(int lane) { return ((lane & 3) << 3) | (((lane >> 2) & 3) << 6) | (((lane >> 4) & 1) << 5) | (((lane >> 5) & 1) << 8); }
constexpr int v_rd_off(int d0, int ks, int half) { return d0 * 512 + ks * 4096 + half * 2048; }
template <int OFF> __device__ __forceinline__ s16x4 tr_read(int vb) {
  s16x4 r; asm volatile("ds_read_b64_tr_b16 %0, %1 offset:%2" : "=&v"(r) : "v"(vb), "i"(OFF) : "memory"); return r;
}
template <int D0> __device__ __forceinline__ void pv_one(f32x16& od, int vb, bf16x8 pa0, bf16x8 pa1, bf16x8 pa2, bf16x8 pa3) {
  const s16x4 l0 = tr_read<v_rd_off(D0, 0, 0)>(vb), h0 = tr_read<v_rd_off(D0, 0, 1)>(vb), l1 = tr_read<v_rd_off(D0, 1, 0)>(vb), h1 = tr_read<v_rd_off(D0, 1, 1)>(vb);
  const s16x4 l2 = tr_read<v_rd_off(D0, 2, 0)>(vb), h2 = tr_read<v_rd_off(D0, 2, 1)>(vb), l3 = tr_read<v_rd_off(D0, 3, 0)>(vb), h3 = tr_read<v_rd_off(D0, 3, 1)>(vb);
  asm volatile("s_waitcnt lgkmcnt(0)" ::: "memory"); SBAR();
#define PK(L, H) (bf16x8){L[0], L[1], L[2], L[3], H[0], H[1], H[2], H[3]}
  od = __builtin_amdgcn_mfma_f32_32x32x16_bf16(pa0, PK(l0, h0), od, 0, 0, 0);
  od = __builtin_amdgcn_mfma_f32_32x32x16_bf16(pa1, PK(l1, h1), od, 0, 0, 0);
  od = __builtin_amdgcn_mfma_f32_32x32x16_bf16(pa2, PK(l2, h2), od, 0, 0, 0);
  od = __builtin_amdgcn_mfma_f32_32x32x16_bf16(pa3, PK(l3, h3), od, 0, 0, 0);
#undef PK
}
__device__ __forceinline__ void pv_d0(f32x16* o, int vb, bf16x8 pa0, bf16x8 pa1, bf16x8 pa2, bf16x8 pa3) {
  pv_one<0>(o[0], vb, pa0, pa1, pa2, pa3); pv_one<1>(o[1], vb, pa0, pa1, pa2, pa3); pv_one<2>(o[2], vb, pa0, pa1, pa2, pa3); pv_one<3>(o[3], vb, pa0, pa1, pa2, pa3);
}

__device__ __forceinline__ void attn_unit(int b, int h, int qb, const bf16_t* __restrict__ Qb, const bf16_t* __restrict__ KVb, const bf16_t* __restrict__ KPb, bf16_t* __restrict__ Ob,
                                          const float* __restrict__ cosT, const float* __restrict__ sinT, char* lds, const int wave_s) {
  int tid_l; asm volatile("v_mbcnt_lo_u32_b32 %0, -1, 0\n\tv_mbcnt_hi_u32_b32 %0, -1, %0" : "=v"(tid_l)); tid_l += wave_s * 64;
  const int tid = tid_l, wid = wave_s, lane = tid & 63, r32 = lane & 31, hi = lane >> 5;
  char* V_lds = lds + OFF_V; char* KN_lds = lds + OFF_KN; char* KP_lds = lds + OFF_KP;
  float* ws = (float*)(lds + OFF_WS) + wid * 64; float* li_l = ws; float* al_l = ws + 32;
  float m_reg = -1e30f, l_reg = 0; f32x16 o[4] = {}; bf16x8 qr[8];
  char* qp = lds + OFF_QP + wid * 4096 + lane * 16;
  const int q0 = qb * 256, tq = q0 + wid * QBLK + r32;
  const long rowbase = (long)b * SEQ;
  { const bf16_t* Qw = Qb + (rowbase + tq) * NQ + h * QKD + hi * 8;
#pragma unroll
    for (int d0 = 0; d0 < 8; ++d0) qr[d0] = *reinterpret_cast<const bf16x8*>(Qw + d0 * 16);
#pragma unroll
    for (int pr = 0; pr < 2; ++pr) {
      const float* cp = cosT + (long)tq * 32 + pr * 16 + hi * 8; const float* sp = sinT + (long)tq * 32 + pr * 16 + hi * 8;
      const f32x4 c0 = *(const f32x4*)cp, c1 = *(const f32x4*)(cp + 4), s0 = *(const f32x4*)sp, s1 = *(const f32x4*)(sp + 4);
      const u32x4 x1 = *reinterpret_cast<const u32x4*>(Qw + (8 + pr) * 16), x2 = *reinterpret_cast<const u32x4*>(Qw + (10 + pr) * 16);
      u32x4 y1, y2;
#pragma unroll
      for (int w = 0; w < 4; ++w) {
        const float ca = w < 2 ? c0[2 * w] : c1[2 * w - 4], cb = w < 2 ? c0[2 * w + 1] : c1[2 * w - 3];
        const float sa = w < 2 ? s0[2 * w] : s1[2 * w - 4], sb = w < 2 ? s0[2 * w + 1] : s1[2 * w - 3];
        const float a1 = bflo(x1[w]), b1 = bfhi(x1[w]), a2 = bflo(x2[w]), b2 = bfhi(x2[w]);
        y1[w] = cvtpk(a1 * ca - a2 * sa, b1 * cb - b2 * sb);
        y2[w] = cvtpk(a2 * ca + a1 * sa, b2 * cb + b1 * sb); }
      *reinterpret_cast<u32x4*>(qp + pr * 1024) = y1; *reinterpret_cast<u32x4*>(qp + (2 + pr) * 1024) = y2; }
    asm volatile("s_waitcnt lgkmcnt(0)" ::: "memory");
  }
  const bf16_t* Kh = KVb + rowbase * NKV + h * 256; const bf16_t* Vh = Kh + 128; const bf16_t* Ph = KPb + rowbase * 64;
  const int sr = tid >> 4, sc = (tid & 15) * 8, vst0 = v_st(sr, sc), vst1 = v_st(32 + sr, sc);
  const int pr_ = tid >> 3, pc_ = (tid & 7) * 8;
  const int vb0 = (int)(uintptr_t)V_lds + v_rd_base(lane);
  bf16x8 vs0, vs1, ks0, ks1, ps0;
#define SLOAD(k0) do { vs0 = *reinterpret_cast<const bf16x8*>(&Vh[(long)((k0) + sr) * NKV + sc]); vs1 = *reinterpret_cast<const bf16x8*>(&Vh[(long)((k0) + 32 + sr) * NKV + sc]); \
    ks0 = *reinterpret_cast<const bf16x8*>(&Kh[(long)((k0) + sr) * NKV + sc]); ks1 = *reinterpret_cast<const bf16x8*>(&Kh[(long)((k0) + 32 + sr) * NKV + sc]); \
    ps0 = *reinterpret_cast<const bf16x8*>(&Ph[(long)((k0) + pr_) * 64 + pc_]); } while (0)
#define SWRITE(bb) do { *(bf16x8*)(V_lds + (bb) * SHM_V + vst0) = vs0; *(bf16x8*)(V_lds + (bb) * SHM_V + vst1) = vs1; \
    *(bf16x8*)(KN_lds + (bb) * SHM_KN + KSWZ(sr, sc * 2)) = ks0; *(bf16x8*)(KN_lds + (bb) * SHM_KN + KSWZ(32 + sr, sc * 2)) = ks1; \
    *(bf16x8*)(KP_lds + (bb) * SHM_KP + PSWZ(pr_, pc_ * 2)) = ps0; } while (0)
#define SWAIT() asm volatile("s_waitcnt vmcnt(0)" ::: "memory")
#define RESC(a) do { if (__any((a) < 1.f)) { if (hi == 0) al_l[r32] = (a); asm volatile("s_waitcnt lgkmcnt(0)" ::: "memory"); \
    _Pragma("unroll") for (int d = 0; d < 4; ++d) _Pragma("unroll") for (int r = 0; r < 16; ++r) o[d][r] *= al_l[crow(r, hi)]; } } while (0)
  f32x16 pA0, pA1, pB0, pB1; float mnA, mnB, alA, alB; bf16x8 pa0, pa1, pa2, pa3;
  const int NT = 4 * qb + 4, cw = 4 * qb + (wid >> 1);
  SLOAD(0); SWAIT(); SWRITE(0); __syncthreads();
  qkt(pA0, pA1, KN_lds, KP_lds, qr, qp, r32, hi); partialSM(pA0, pA1, m_reg, mnA, alA);
  SLOAD(KVBLK);
  SWAIT(); SWRITE(1); __syncthreads();
  for (int j = 1; j + 1 < NT; j += 2) {
    SBAR(); qkt(pB0, pB1, KN_lds + SHM_KN, KP_lds + SHM_KP, qr, qp, r32, hi); maskt(pB0, pB1, j > cw);
    finishSM(pA0, pA1, alA, l_reg, pa0, pa1, pa2, pa3); SBAR();
    SLOAD((j + 1) * KVBLK); SBAR();
    pv_d0(o, vb0, pa0, pa1, pa2, pa3); partialSM(pB0, pB1, m_reg, mnB, alB);
    __syncthreads(); SWAIT(); SWRITE(0);
    RESC(alB); __syncthreads();
    SBAR(); qkt(pA0, pA1, KN_lds, KP_lds, qr, qp, r32, hi); maskt(pA0, pA1, j + 1 > cw);
    finishSM(pB0, pB1, alB, l_reg, pa0, pa1, pa2, pa3); SBAR();
    SLOAD((j + 2) * KVBLK); SBAR();
    pv_d0(o, vb0 + SHM_V, pa0, pa1, pa2, pa3); partialSM(pA0, pA1, m_reg, mnA, alA);
    __syncthreads(); SWAIT(); SWRITE(1);
    RESC(alA); __syncthreads();
  }
  SBAR(); qkt(pB0, pB1, KN_lds + SHM_KN, KP_lds + SHM_KP, qr, qp, r32, hi); maskt(pB0, pB1, NT - 1 > cw);
  finishSM(pA0, pA1, alA, l_reg, pa0, pa1, pa2, pa3); SBAR();
  pv_d0(o, vb0, pa0, pa1, pa2, pa3); partialSM(pB0, pB1, m_reg, mnB, alB);
  __syncthreads(); RESC(alB);
  finishSM(pB0, pB1, alB, l_reg, pa0, pa1, pa2, pa3); SBAR();
  pv_d0(o, vb0 + SHM_V, pa0, pa1, pa2, pa3);
  if (hi == 0) li_l[r32] = l_reg; asm volatile("s_waitcnt lgkmcnt(0)" ::: "memory");
#pragma unroll
  for (int r = 0; r < 16; ++r) { const float rl = __builtin_amdgcn_rcpf(li_l[crow(r, hi)]);
#pragma unroll
    for (int d0 = 0; d0 < 4; ++d0) o[d0][r] *= rl; }
  bf16_t* Ow = Ob + (rowbase + q0 + wid * QBLK) * DM + h * 128;
  { char* st = lds + OFF_QP + wid * 4096;
#pragma unroll
    for (int half = 0; half < 2; ++half) {
#pragma unroll
      for (int r = 0; r < 16; ++r) { const int orow = crow(r, hi);
#pragma unroll
        for (int dd = 0; dd < 2; ++dd) *reinterpret_cast<bf16_t*>(st + orow * 128 + (dd * 32 + r32) * 2) = (bf16_t)(cvtpk(o[2 * half + dd][r], 0.f) & 0xffffu); }
      asm volatile("s_waitcnt lgkmcnt(0)" ::: "memory");
#pragma unroll
      for (int i = 0; i < 4; ++i) { const int row = i * 8 + (lane >> 3), chn = lane & 7; const u32x4 v = *reinterpret_cast<const u32x4*>(st + row * 128 + chn * 16);
        *reinterpret_cast<u32x4*>(Ow + (long)row * DM + half * 64 + chn * 8) = v; }
      asm volatile("s_waitcnt lgkmcnt(0)" ::: "memory"); } }
  __syncthreads();
#undef SLOAD
#undef SWRITE
#undef SWAIT
#undef RESC
}
#undef SBAR
}

constexpr size_t MiB = 1u << 20;
constexpr size_t WS_CTL = 0, CTL_ZERO_BYTES = 1 * MiB;
constexpr size_t WS_MOD = 2 * MiB;
constexpr size_t WS_SCT = 7 * MiB;
constexpr size_t WS_DUMMY = 7 * MiB + 512 * 1024;
constexpr size_t WS_COS = 8 * MiB, WS_SIN = 8 * MiB + 512 * 1024;
constexpr size_t WS_W = 16 * MiB, W_LAYER = 96 * MiB;
constexpr size_t WO_IN = 0, WO_PE = 16 * MiB, WO_UQ = WO_PE + 256 * 1024, WO_UKV = WO_UQ + 1536 * 1024, WO_OUT = WO_UKV + 2 * MiB, WO_UP = WO_OUT + 8 * MiB, WO_DN = WO_UP + 32 * MiB, WO_QA = WO_DN + 32 * MiB;
static_assert(WO_QA + 4 * MiB <= W_LAYER, "weights per layer");
constexpr size_t WS_X = WS_W + DEPTH * W_LAYER;
constexpr size_t WS_H = WS_X + 130 * MiB;
constexpr size_t WS_R = WS_H + 66 * MiB;
constexpr size_t WS_Z = WS_R;
constexpr size_t WS_QN = WS_R + 98 * MiB;
constexpr size_t WS_CKV = WS_R + 115 * MiB;
constexpr size_t WS_KPE = WS_R + 164 * MiB;
constexpr size_t WS_Q = WS_R + 171 * MiB;
constexpr size_t WS_KV = WS_R + 220 * MiB;
constexpr size_t WS_MIX = WS_R + 414 * MiB;
constexpr size_t WS_HB = WS_R;
constexpr size_t WS_ZS = WS_R + 480 * MiB;
constexpr size_t WS_PS = WS_R + 488 * MiB;
constexpr size_t WS_END = WS_R + 496 * MiB;
static_assert((size_t)MR * DM * 4 <= 130 * MiB && (size_t)MR * DM * 2 <= 66 * MiB && (size_t)MR * ZW * 2 <= 98 * MiB && (size_t)MKV * 512 * 2 <= 49 * MiB && (size_t)MKV * 64 * 2 <= 7 * MiB
              && (size_t)MR * NQ * 2 <= 49 * MiB && (size_t)MKV * NKV * 2 <= 194 * MiB && (size_t)MR * DFF * 2 <= 414 * MiB, "d_ws map");
constexpr size_t O_Y = 0, O_CKVP = (size_t)MR * DM, O_KPEP = O_CKVP + (size_t)DEPTH * MP * 512, O_CONVP = O_KPEP + (size_t)DEPTH * MP * 64, O_CKVS = O_CONVP + (size_t)DEPTH * NBP * 2 * 1024,
                 O_KPES = O_CKVS + (size_t)DEPTH * MS * 512, O_CONVS = O_KPES + (size_t)DEPTH * MS * 64, O_END = O_CONVS + (size_t)DEPTH * NBS * 2 * 1024;
static_assert(O_END == 72613888, "output size");
constexpr int CW_BAR = 4096;
constexpr int KVROW_C = MP, KVROW_S = MP + MC;
constexpr int RING_BYTES = 135168;
constexpr int LDSCTL_OFF = RING_BYTES, MISC_OFF = LDSCTL_OFF + 320, LDS_BYTES = RING_BYTES + 1024;
constexpr int NWAVES = 8;
typedef float f32x8v __attribute__((ext_vector_type(8)));

template <int M> __device__ __forceinline__ float swz_xor(float v) { return __int_as_float(__builtin_amdgcn_ds_swizzle(__float_as_int(v), (M << 10) | 0x1f)); }
__device__ __forceinline__ float half_swap_add(float v) { auto rr = __builtin_amdgcn_permlane32_swap(__float_as_uint(v), __float_as_uint(v), false, false); return __uint_as_float(rr[0]) + __uint_as_float(rr[1]); }
__device__ __forceinline__ float half_swap_max(float v) { auto rr = __builtin_amdgcn_permlane32_swap(__float_as_uint(v), __float_as_uint(v), false, false); return fmaxf(__uint_as_float(rr[0]), __uint_as_float(rr[1])); }
__device__ __forceinline__ float wave_sum(float v) {
    v += swz_xor<1>(v); v += swz_xor<2>(v); v += swz_xor<4>(v); v += swz_xor<8>(v); v += swz_xor<16>(v);
    return half_swap_add(v);
}
__device__ __forceinline__ float wave_max(float v) {
    v = fmaxf(v, swz_xor<1>(v)); v = fmaxf(v, swz_xor<2>(v)); v = fmaxf(v, swz_xor<4>(v)); v = fmaxf(v, swz_xor<8>(v)); v = fmaxf(v, swz_xor<16>(v));
    return half_swap_max(v);
}
__device__ __forceinline__ float bf_lo(unsigned w) { return __uint_as_float(w << 16); }
__device__ __forceinline__ float bf_hi(unsigned w) { return __uint_as_float(w & 0xffff0000u); }
__device__ __forceinline__ unsigned pkbf(float lo, float hi) { return pg8::cvt_pk_bf16(lo, hi); }
__device__ __forceinline__ int row_batch(int row) { return row < MP ? (row >> 11) : NBP + ((row - MP) >> 4); }
__device__ __forceinline__ int row_pos(int row) { return row < MP ? (row & (SEQ - 1)) : PAST + ((row - MP) & (TS - 1)); }

struct TrItem { const float* src; bf16* dst; int N, K; };
__device__ __forceinline__ TrItem tr_item(const float* W, int K, int N, int src_col0, bf16* WT, int dst_row0, int kb, int lane) {
    TrItem d; d.src = W + (size_t)(64 * kb + (lane >> 5)) * N + src_col0 + (lane & 31); d.dst = WT + (size_t)dst_row0 * K + 64 * kb; d.N = N; d.K = K; return d; }
__device__ __forceinline__ void tr_load(const TrItem& d, float (&wv)[32]) {
#pragma unroll
    for (int i = 0; i < 32; ++i) wv[i] = d.src[(size_t)(2 * i) * d.N];
}
__device__ __forceinline__ void tr_store(const TrItem& d, const float (&wv)[32], LAS float* scr, int lane) {
#pragma unroll
    for (int i = 0; i < 32; ++i) scr[(2 * i + (lane >> 5)) * 33 + (lane & 31)] = wv[i];
    LDS_WAIT(); asm volatile("" ::: "memory");
    const int c = lane & 7;
#pragma unroll
    for (int j = 0; j < 4; ++j) { const int n = (lane >> 3) + 8 * j; const LAS float* s = scr + (8 * c) * 33 + n;
        v4u o; o.x = pkbf(s[0 * 33], s[1 * 33]); o.y = pkbf(s[2 * 33], s[3 * 33]); o.z = pkbf(s[4 * 33], s[5 * 33]); o.w = pkbf(s[6 * 33], s[7 * 33]);
        *(GAS v4u*)(d.dst + (size_t)n * d.K + 8 * c) = o; }
    LDS_WAIT(); asm volatile("" ::: "memory");
}
__device__ __forceinline__ int win_src_col(int v0) {
    if (v0 < 1024) return v0;
    if (v0 < 3072) { const int t = v0 - 1024, j = t >> 8, r = t & 255; return r < 128 ? 2112 + 128 * j + r : 3136 + 128 * j + (r - 128); }
    return 1088 + (v0 - 3072);
}
constexpr int IT_IN = 32 * 128, IT_PE = 32 * 2, IT_UQ = 8 * 48, IT_UKV = 8 * 64, IT_OUT = 32 * 64, IT_UP = 32 * 256, IT_DN = 128 * 64;
constexpr int IT_LAYER = IT_IN + IT_PE + IT_UQ + IT_UKV + IT_OUT + IT_UP + IT_DN;
__device__ __forceinline__ void p0_prep(const float* w_in, const float* w_uq, const float* w_ukv, const float* w_out, const float* w_up, const float* w_down, const float* c_p, const float* c_s, unsigned char* ws, LAS unsigned char* lds, int tid, int lane, int wave, int vcu, int G) {
    LAS float* scr = (LAS float*)(lds + wave * 16384);
    const int gw = vcu * NWAVES + wave, NGW = G * NWAVES;
    auto decode = [&](int it) -> TrItem {
        const int l = it / IT_LAYER; int r = it % IT_LAYER;
        unsigned char* wl = ws + WS_W + (size_t)l * W_LAYER;
        if (r < IT_IN) { const int kb = r / 128, nb = r % 128; return tr_item(w_in + (size_t)l * DM * INC, DM, INC, win_src_col(32 * nb), (bf16*)(wl + WO_IN), 32 * nb, kb, lane); } r -= IT_IN;
        if (r < IT_PE) { const int kb = r / 2, nb = r % 2; return tr_item(w_in + (size_t)l * DM * INC, DM, INC, 1024 + 32 * nb, (bf16*)(wl + WO_PE), 32 * nb, kb, lane); } r -= IT_PE;
        if (r < IT_UQ) { const int kb = r / 48, nb = r % 48; return tr_item(w_uq + (size_t)l * QLR * NQ, QLR, NQ, 32 * nb, (bf16*)(wl + WO_UQ), 32 * nb, kb, lane); } r -= IT_UQ;
        if (r < IT_UKV) { const int kb = r / 64, nb = r % 64; return tr_item(w_ukv + (size_t)l * KVLR * NKV, KVLR, NKV, 32 * nb, (bf16*)(wl + WO_UKV), 32 * nb, kb, lane); } r -= IT_UKV;
        if (r < IT_OUT) { const int kb = r / 64, nb = r % 64; return tr_item(w_out + (size_t)l * DM * DM, DM, DM, 32 * nb, (bf16*)(wl + WO_OUT), 32 * nb, kb, lane); } r -= IT_OUT;
        if (r < IT_UP) { const int kb = r / 256, nb = r % 256; return tr_item(w_up + (size_t)l * DM * DFF, DM, DFF, 32 * nb, (bf16*)(wl + WO_UP), 32 * nb, kb, lane); } r -= IT_UP;
        const int kb = r / 64, nb = r % 64; return tr_item(w_down + (size_t)l * DFF * DM, DFF, DM, 32 * nb, (bf16*)(wl + WO_DN), 32 * nb, kb, lane);
    };
    { int it = gw; float wa[32], wb[32]; TrItem cur, nxt;
      if (it < DEPTH * IT_LAYER) { cur = decode(it); tr_load(cur, wa); }
      while (it < DEPTH * IT_LAYER) {
          const int itn = it + NGW; const bool hn = itn < DEPTH * IT_LAYER;
          if (hn) { nxt = decode(itn); tr_load(nxt, wb); }
          tr_store(cur, wa, scr, lane);
          if (hn) {
#pragma unroll
              for (int i = 0; i < 32; ++i) wa[i] = wb[i];
              cur = nxt; }
          it = itn;
      }
    }
    const int gt = (vcu * NWAVES + wave) * 64 + lane, NGT = NGW * 64;
    float* sct = (float*)(ws + WS_SCT);
    for (int i = gt; i < NB * DM; i += NGT) { const int b = i / DM, k = i % DM; const float c = b < NBP ? c_p[b * DM + k] : c_s[(b - NBP) * DM + k];
        sct[k * 32 + b] = c / (1.0f + __expf(-c)); }
    for (int i = gt; i < DM * 8; i += NGT) sct[(i >> 3) * 32 + NB + (i & 7)] = 0.f;
    float* cosT = (float*)(ws + WS_COS); float* sinT = (float*)(ws + WS_SIN);
    for (int i = gt; i < NPOS * 32; i += NGT) { const int pos = i >> 5, fi = i & 31;
        double inv_d = 1.0; for (int q = 0; q < fi; ++q) inv_d *= 0.74989420933245582730;
        const float inv_f = (float)inv_d; const float ang = __fmul_rn((float)pos, inv_f);
        const double rev4 = (double)ang * 0.63661977236758134308;
        const double qd = __builtin_rint(rev4); const double y = (rev4 - qd) * 1.57079632679489661923;
        const double y2 = y * y;
        const double sy = y * (1.0 + y2 * (-1.0 / 6 + y2 * (1.0 / 120 + y2 * (-1.0 / 5040 + y2 * (1.0 / 362880 + y2 * (-1.0 / 39916800 + y2 * (1.0 / 6227020800.0)))))));
        const double cy = 1.0 + y2 * (-0.5 + y2 * (1.0 / 24 + y2 * (-1.0 / 720 + y2 * (1.0 / 40320 + y2 * (-1.0 / 3628800 + y2 * (1.0 / 479001600.0 + y2 * (-1.0 / 87178291200.0)))))));
        const int qi = ((int)qd) & 3;
        const double cv = qi == 0 ? cy : qi == 1 ? -sy : qi == 2 ? -cy : sy;
        const double sv = qi == 0 ? sy : qi == 1 ? cy : qi == 2 ? -sy : -cy;
        cosT[i] = (float)cv; sinT[i] = (float)sv; }
}
__device__ __forceinline__ void p1_mod(const float* w_ada, const float* b_ada, unsigned char* ws, LAS unsigned char* lds, int tid, int lane, int wave, int vcu, int G) {
    typedef float f32x16m __attribute__((ext_vector_type(16)));
    const float* sct = (const float*)(ws + WS_SCT); float* mod = (float*)(ws + WS_MOD);
    LAS float* Sl = (LAS float*)lds;
    const int n = lane & 31, kk = lane >> 5, ch = wave & 1, ks = wave >> 1;
    for (int it = (G == 256 ? ((vcu & 3) < 3 ? (vcu >> 2) * 3 + (vcu & 3) : DEPTH * (MODW / 256)) : vcu); it < DEPTH * (MODW / 256); it += G) {
        const int l = it / (MODW / 256), n0 = 256 * (it % (MODW / 256));
        f32x16m acc[4] = {};
        for (int q = 0; q < 4; ++q) {
            __syncthreads();
            { const GAS f32x4* src = (const GAS f32x4*)(sct + (size_t)q * 512 * 32) + tid; LAS f32x4* dst = (LAS f32x4*)Sl + tid;
#pragma unroll
              for (int j = 0; j < 8; ++j) dst[512 * j] = src[512 * j]; }
            __syncthreads();
            const float* wp = w_ada + ((size_t)l * DM + 512 * q + 128 * ks + kk) * MODW + n0 + 128 * ch + 4 * n;
            const LAS float* sp = Sl + (128 * ks + kk) * 32 + n;
#pragma unroll 1
            for (int i0 = 0; i0 < 64; i0 += 16) {
                f32x4 wv[16];
#pragma unroll
                for (int j = 0; j < 16; ++j) wv[j] = *(const GAS f32x4*)(wp + (size_t)(2 * (i0 + j)) * MODW);
                __builtin_amdgcn_sched_barrier(0);
#pragma unroll
                for (int j = 0; j < 16; ++j) { const float a = sp[2 * (i0 + j) * 32];
                    acc[0] = __builtin_amdgcn_mfma_f32_32x32x2f32(a, wv[j].x, acc[0], 0, 0, 0); acc[1] = __builtin_amdgcn_mfma_f32_32x32x2f32(a, wv[j].y, acc[1], 0, 0, 0);
                    acc[2] = __builtin_amdgcn_mfma_f32_32x32x2f32(a, wv[j].z, acc[2], 0, 0, 0); acc[3] = __builtin_amdgcn_mfma_f32_32x32x2f32(a, wv[j].w, acc[3], 0, 0, 0); }
            }
        }
        __syncthreads();
        LAS float* red = (LAS float*)lds;
#pragma unroll
        for (int t = 0; t < 4; ++t)
#pragma unroll
            for (int r = 0; r < 16; ++r) red[((wave * 4 + t) * 16 + r) * 64 + lane] = acc[t][r];
        __syncthreads();
        for (int i = tid; i < 8192; i += NWAVES * 64) { const int cch = i >> 12, t = (i >> 10) & 3, r = (i >> 6) & 15, L = i & 63; const int bb = (r & 3) + 8 * (r >> 2) + 4 * (L >> 5), c = n0 + 128 * cch + 4 * (L & 31) + t;
            if (bb < NB) { float sum = b_ada[(size_t)l * MODW + c];
#pragma unroll
                for (int k4 = 0; k4 < 4; ++k4) sum += red[(((2 * k4 + cch) * 4 + t) * 16 + r) * 64 + L];
                mod[((size_t)l * NB + bb) * MODW + c] = sum; } }
    }
    __syncthreads();
}
__device__ __forceinline__ void unpk8f(const v4u& w, f32x4& a, f32x4& b) {
    a = (f32x4){bf_lo(w.x), bf_hi(w.x), bf_lo(w.y), bf_hi(w.y)}; b = (f32x4){bf_lo(w.z), bf_hi(w.z), bf_lo(w.w), bf_hi(w.w)};
}
template <bool F32IN> __device__ __forceinline__ void norm_load(const void* xb, int row, int lane, f32x4 (&v)[8]) {
    if (F32IN) { const GAS f32x4* x4 = (const GAS f32x4*)((const float*)xb + (size_t)row * DM) + 2 * lane;
#pragma unroll
        for (int j = 0; j < 4; ++j) { v[2 * j] = x4[128 * j]; v[2 * j + 1] = x4[128 * j + 1]; } }
    else { const GAS v4u* x8 = (const GAS v4u*)((const bf16*)xb + (size_t)row * DM) + lane;
#pragma unroll
        for (int j = 0; j < 4; ++j) { const v4u w = x8[64 * j]; unpk8f(w, v[2 * j], v[2 * j + 1]); } }
}
template <bool F32IN> __device__ __forceinline__ void norm_rows(const void* xb, const float* modl, int sh_off, int sc_off, bf16* H, int lane, int gw, int NGW) {
    for (int r0 = gw * 8; r0 < MP; r0 += NGW * 8) {
        const int b = r0 >> 11;
        const GAS f32x4* sc4 = (const GAS f32x4*)(modl + (size_t)b * MODW + sc_off) + 2 * lane; const GAS f32x4* sh4 = (const GAS f32x4*)(modl + (size_t)b * MODW + sh_off) + 2 * lane;
        f32x4 sc[8], sh[8];
#pragma unroll
        for (int j = 0; j < 4; ++j) { sc[2 * j] = sc4[128 * j] + 1.f; sc[2 * j + 1] = sc4[128 * j + 1] + 1.f; sh[2 * j] = sh4[128 * j]; sh[2 * j + 1] = sh4[128 * j + 1]; }
        if constexpr (!F32IN) {
            const GAS v4u* x8 = (const GAS v4u*)((const bf16*)xb + (size_t)r0 * DM) + lane;
            v4u raw[4][4];
#pragma unroll
            for (int d = 0; d < 4; ++d)
#pragma unroll
                for (int j = 0; j < 4; ++j) raw[d][j] = x8[256 * d + 64 * j];
#pragma unroll
            for (int i = 0; i < 8; ++i) {
                f32x4 cur[8];
#pragma unroll
                for (int j = 0; j < 4; ++j) unpk8f(raw[i & 3][j], cur[2 * j], cur[2 * j + 1]);
                if (i + 4 < 8) {
#pragma unroll
                    for (int j = 0; j < 4; ++j) raw[i & 3][j] = x8[256 * (i + 4) + 64 * j]; }
                float s = 0.f;
#pragma unroll
                for (int j = 0; j < 8; ++j) s += (cur[j].x * cur[j].x + cur[j].y * cur[j].y) + (cur[j].z * cur[j].z + cur[j].w * cur[j].w);
                const float rstd = 1.0f / sqrtf(wave_sum(s) * (1.f / DM) + EPS);
                GAS v4u* o8 = (GAS v4u*)(H + (size_t)(r0 + i) * DM) + lane;
#pragma unroll
                for (int j = 0; j < 4; ++j) { const f32x4 y0 = cur[2 * j] * rstd * sc[2 * j] + sh[2 * j], y1 = cur[2 * j + 1] * rstd * sc[2 * j + 1] + sh[2 * j + 1];
                    v4u o; o.x = pkbf(y0.x, y0.y); o.y = pkbf(y0.z, y0.w); o.z = pkbf(y1.x, y1.y); o.w = pkbf(y1.z, y1.w); o8[64 * j] = o; }
            }
        } else if (true) {
            const GAS f32x4* x4 = (const GAS f32x4*)((const float*)xb + (size_t)r0 * DM) + 2 * lane;
            f32x4 raw[2][8];
#pragma unroll
            for (int d = 0; d < 2; ++d)
#pragma unroll
                for (int j = 0; j < 4; ++j) { raw[d][2 * j] = x4[512 * d + 128 * j]; raw[d][2 * j + 1] = x4[512 * d + 128 * j + 1]; }
#pragma unroll
            for (int i = 0; i < 8; ++i) {
                f32x4 cur[8];
#pragma unroll
                for (int j = 0; j < 8; ++j) cur[j] = raw[i & 1][j];
                if (i + 2 < 8) {
#pragma unroll
                    for (int j = 0; j < 4; ++j) { raw[i & 1][2 * j] = x4[512 * (i + 2) + 128 * j]; raw[i & 1][2 * j + 1] = x4[512 * (i + 2) + 128 * j + 1]; } }
                float s = 0.f;
#pragma unroll
                for (int j = 0; j < 8; ++j) s += (cur[j].x * cur[j].x + cur[j].y * cur[j].y) + (cur[j].z * cur[j].z + cur[j].w * cur[j].w);
                const float rstd = 1.0f / sqrtf(wave_sum(s) * (1.f / DM) + EPS);
                GAS v4u* o8 = (GAS v4u*)(H + (size_t)(r0 + i) * DM) + lane;
#pragma unroll
                for (int j = 0; j < 4; ++j) { const f32x4 y0 = cur[2 * j] * rstd * sc[2 * j] + sh[2 * j], y1 = cur[2 * j + 1] * rstd * sc[2 * j + 1] + sh[2 * j + 1];
                    v4u o; o.x = pkbf(y0.x, y0.y); o.y = pkbf(y0.z, y0.w); o.z = pkbf(y1.x, y1.y); o.w = pkbf(y1.z, y1.w); o8[64 * j] = o; }
            }
        } else {
        f32x4 cur[8], nxt[8];
        norm_load<F32IN>(xb, r0, lane, cur);
#pragma unroll 1
        for (int i = 0; i < 8; ++i) {
            const int row = r0 + i;
            norm_load<F32IN>(xb, i < 7 ? row + 1 : row, lane, nxt);
            float s = 0.f;
#pragma unroll
            for (int j = 0; j < 8; ++j) s += (cur[j].x * cur[j].x + cur[j].y * cur[j].y) + (cur[j].z * cur[j].z + cur[j].w * cur[j].w);
            const float rstd = 1.0f / sqrtf(wave_sum(s) * (1.f / DM) + EPS);
            GAS v4u* o8 = (GAS v4u*)(H + (size_t)row * DM) + lane;
#pragma unroll
            for (int j = 0; j < 4; ++j) { const f32x4 y0 = cur[2 * j] * rstd * sc[2 * j] + sh[2 * j], y1 = cur[2 * j + 1] * rstd * sc[2 * j + 1] + sh[2 * j + 1];
                v4u o; o.x = pkbf(y0.x, y0.y); o.y = pkbf(y0.z, y0.w); o.z = pkbf(y1.x, y1.y); o.w = pkbf(y1.z, y1.w); o8[64 * j] = o; }
#pragma unroll
            for (int j = 0; j < 8; ++j) cur[j] = nxt[j];
        }
        }
    }
}
__device__ __forceinline__ void final_norm_rows(const bf16* XB, const float* gain, float* out, int lane, int gw, int NGW) {
    const GAS f32x4* g4 = (const GAS f32x4*)gain + 2 * lane; f32x4 g[8];
#pragma unroll
    for (int j = 0; j < 4; ++j) { g[2 * j] = g4[128 * j]; g[2 * j + 1] = g4[128 * j + 1]; }
    for (int r0 = gw * 8; r0 < MP; r0 += NGW * 8) {
        const GAS v4u* x8 = (const GAS v4u*)(XB + (size_t)r0 * DM) + lane;
        v4u raw[2][4];
#pragma unroll
        for (int d = 0; d < 2; ++d)
#pragma unroll
            for (int j = 0; j < 4; ++j) raw[d][j] = x8[256 * d + 64 * j];
#pragma unroll
        for (int i = 0; i < 8; ++i) {
            f32x4 cur[8];
#pragma unroll
            for (int j = 0; j < 4; ++j) unpk8f(raw[i & 1][j], cur[2 * j], cur[2 * j + 1]);
            if (i + 2 < 8) {
#pragma unroll
                for (int j = 0; j < 4; ++j) raw[i & 1][j] = x8[256 * (i + 2) + 64 * j]; }
            float s = 0.f;
#pragma unroll
            for (int j = 0; j < 8; ++j) s += (cur[j].x * cur[j].x + cur[j].y * cur[j].y) + (cur[j].z * cur[j].z + cur[j].w * cur[j].w);
            const float rstd = 1.0f / sqrtf(wave_sum(s) * (1.f / DM) + EPS);
            GAS f32x4* o4 = (GAS f32x4*)(out + (size_t)(r0 + i) * DM) + 2 * lane;
#pragma unroll
            for (int j = 0; j < 4; ++j) { o4[128 * j] = cur[2 * j] * rstd * g[2 * j]; o4[128 * j + 1] = cur[2 * j + 1] * rstd * g[2 * j + 1]; }
        }
    }
}
__device__ __forceinline__ void elt_kpe(const bf16* H, const bf16* WPE, bf16* KPE, const float* cosT, const float* sinT, float* outp, float* outs, LAS unsigned char* lds,
                                        int tid, int lane, int wave, int vcu, int G) {
    typedef float f32x16 __attribute__((ext_vector_type(16)));
    constexpr int PITCH = 1040, WOFF = 64 * PITCH;
    LAS float* red = (LAS float*)lds;
    const int r32 = lane & 31, hi = lane >> 5, rt = wave & 1, ct = (wave >> 1) & 1, kh = wave >> 2;
    for (int it = vcu; it < MP / 64; it += G) {
        const int R0 = 64 * it;
        f32x16 acc = {};
        for (int kc = 0; kc < 4; ++kc) {
#pragma unroll
            for (int j = 0; j < 8; ++j) { const int i = wave + 8 * j;
                const bf16* hsrc = R0 < MP ? H + (size_t)(R0 + i) * DM + 512 * kc + lane * 8 : H + (size_t)MP * DM + ((size_t)(16 * kc + (lane >> 2)) * 256 + (R0 - MP + i)) * 32 + 8 * (lane & 3);
                __builtin_amdgcn_global_load_lds((const unsigned*)hsrc, (LAS unsigned*)(lds + i * PITCH), 16, 0, 0);
                __builtin_amdgcn_global_load_lds((const unsigned*)(WPE + (size_t)i * DM + 512 * kc + lane * 8), (LAS unsigned*)(lds + WOFF + i * PITCH), 16, 0, 0); }
            asm volatile("s_waitcnt vmcnt(0)" ::: "memory");
            __syncthreads();
            const LAS unsigned char* ap = lds + (32 * rt + r32) * PITCH + (256 * kh + 8 * hi) * 2;
            const LAS unsigned char* bp = lds + WOFF + (32 * ct + r32) * PITCH + (256 * kh + 8 * hi) * 2;
#pragma unroll
            for (int s = 0; s < 16; ++s) acc = __builtin_amdgcn_mfma_f32_32x32x16_bf16(*(const LAS bf16x8*)(ap + 32 * s), *(const LAS bf16x8*)(bp + 32 * s), acc, 0, 0, 0);
            __syncthreads();
        }
#pragma unroll
        for (int r = 0; r < 16; ++r) red[(wave * 16 + r) * 64 + lane] = acc[r];
        __syncthreads();
        if (wave < 2) {
#pragma unroll
            for (int r = 0; r < 16; ++r) {
                const float x1 = red[((rt + 0) * 16 + r) * 64 + lane] + red[((rt + 4) * 16 + r) * 64 + lane];
                const float x2 = red[((rt + 2) * 16 + r) * 64 + lane] + red[((rt + 6) * 16 + r) * 64 + lane];
                const int row = R0 + 32 * rt + (r & 3) + 8 * (r >> 2) + 4 * hi, pos = row_pos(row);
                const float cs = cosT[pos * 32 + r32], sn = sinT[pos * 32 + r32];
                const float o1 = x1 * cs - x2 * sn, o2 = x2 * cs + x1 * sn;
                float* of = row < MP ? outp + (size_t)row * 64 : outs + (size_t)(row - MP) * 64;
                of[r32] = o1; of[32 + r32] = o2;
                const size_t kr = row < MP ? (size_t)row : (size_t)KVROW_S + (row - MP);
                KPE[kr * 64 + r32] = (bf16)(pkbf(o1, 0.f) & 0xffffu); KPE[kr * 64 + 32 + r32] = (bf16)(pkbf(o2, 0.f) & 0xffffu); }
        }
        __syncthreads();
    }
}
struct EltRow { v4u q, kv, c0a, c0b, c1a, c1b, c2a, c2b, ba, bb; };
__device__ __forceinline__ EltRow elt_load(const bf16* Z, int row, int lane) {
    const bf16* zr = Z + (size_t)row * ZW; const int t = row & (SEQ - 1), c0 = 16 * lane;
    const bf16* z1 = t >= 1 ? zr - ZW : zr; const bf16* z2 = t >= 2 ? zr - 2 * ZW : zr;
    EltRow r;
    r.q = *(const GAS v4u*)(zr + 8 * lane); r.kv = *(const GAS v4u*)(zr + 512 + 8 * lane);
    r.c0a = *(const GAS v4u*)(zr + 1024 + c0); r.c0b = *(const GAS v4u*)(zr + 1024 + c0 + 8);
    r.c1a = *(const GAS v4u*)(z1 + 1024 + c0); r.c1b = *(const GAS v4u*)(z1 + 1024 + c0 + 8);
    r.c2a = *(const GAS v4u*)(z2 + 1024 + c0); r.c2b = *(const GAS v4u*)(z2 + 1024 + c0 + 8);
    r.ba = *(const GAS v4u*)(zr + 2048 + c0); r.bb = *(const GAS v4u*)(zr + 2048 + c0 + 8);
    return r;
}
__device__ __forceinline__ void unpk8(const v4u& w, float* x) {
#pragma unroll
    for (int i = 0; i < 4; ++i) { x[2 * i] = bf_lo(w[i]); x[2 * i + 1] = bf_hi(w[i]); }
}
__device__ __forceinline__ void elt_rows(const bf16* Z, const float* q_norm, const float* kv_norm, const float* conv_w, const float* conv_norm, const float* state_conv_l,
                                         bf16* QN, bf16* CKV, bf16* MIX, float* ockv_p, float* ockv_s, float* oconv_p, float* oconv_s, const float* ckv_cache_l, int lane, int gw  , int NGW  , int rend = MP  ) {
    (void)state_conv_l; (void)ockv_s; (void)oconv_s; (void)ckv_cache_l;
    if (gw >= rend) return;
    const int c0 = 16 * lane;
    const f32x4 qg0 = *(const GAS f32x4*)(q_norm + 8 * lane), qg1 = *(const GAS f32x4*)(q_norm + 8 * lane + 4);
    const f32x4 kg0 = *(const GAS f32x4*)(kv_norm + 8 * lane), kg1 = *(const GAS f32x4*)(kv_norm + 8 * lane + 4);
    EltRow cur = elt_load(Z, gw, lane);
    for (int row = gw; row < rend; row += NGW) {
        const int nrow = row + NGW < rend ? row + NGW : row;
        const EltRow nxt = elt_load(Z, nrow, lane);
        const int t = row & (SEQ - 1), b = row >> 11;
        { float x[8]; unpk8(cur.q, x); float s = 0.f;
#pragma unroll
          for (int i = 0; i < 8; ++i) s += x[i] * x[i];
          const float rstd = 1.0f / sqrtf(wave_sum(s) * (1.f / QLR) + EPS);
          v4u o; o.x = pkbf(x[0] * rstd * qg0.x, x[1] * rstd * qg0.y); o.y = pkbf(x[2] * rstd * qg0.z, x[3] * rstd * qg0.w); o.z = pkbf(x[4] * rstd * qg1.x, x[5] * rstd * qg1.y); o.w = pkbf(x[6] * rstd * qg1.z, x[7] * rstd * qg1.w);
          *(GAS v4u*)(QN + (size_t)row * QLR + 8 * lane) = o; }
        { float x[8]; unpk8(cur.kv, x); float s = 0.f;
#pragma unroll
          for (int i = 0; i < 8; ++i) s += x[i] * x[i];
          const float rstd = 1.0f / sqrtf(wave_sum(s) * (1.f / KVLR) + EPS);
          const f32x4 y0 = {x[0] * rstd * kg0.x, x[1] * rstd * kg0.y, x[2] * rstd * kg0.z, x[3] * rstd * kg0.w}, y1 = {x[4] * rstd * kg1.x, x[5] * rstd * kg1.y, x[6] * rstd * kg1.z, x[7] * rstd * kg1.w};
          float* of = ockv_p + (size_t)row * KVLR;
          *(GAS f32x4*)(of + 8 * lane) = y0; *(GAS f32x4*)(of + 8 * lane + 4) = y1;
          v4u o; o.x = pkbf(y0.x, y0.y); o.y = pkbf(y0.z, y0.w); o.z = pkbf(y1.x, y1.y); o.w = pkbf(y1.z, y1.w);
          *(GAS v4u*)(CKV + (size_t)row * KVLR + 8 * lane) = o; }
        { float cu[16], f1[16], f0[16], gb[16];
          unpk8(cur.c0a, cu); unpk8(cur.c0b, cu + 8); unpk8(cur.c1a, f1); unpk8(cur.c1b, f1 + 8); unpk8(cur.c2a, f0); unpk8(cur.c2b, f0 + 8); unpk8(cur.ba, gb); unpk8(cur.bb, gb + 8);
          const float m1 = t >= 1 ? 1.f : 0.f, m0 = t >= 2 ? 1.f : 0.f;
          float o[16]; float s = 0.f;
#pragma unroll
          for (int i = 0; i < 16; ++i) { const float y = conv_w[c0 + i] * (f0[i] * m0) + conv_w[DCONV + c0 + i] * (f1[i] * m1) + conv_w[2 * DCONV + c0 + i] * cu[i]; o[i] = gb[i] * y; s += o[i] * o[i]; }
          const float rstd = 1.0f / sqrtf(wave_sum(s) * (1.f / DCONV) + EPS);
          v4u p0, p1;
#pragma unroll
          for (int i = 0; i < 4; ++i) { p0[i] = pkbf(o[2 * i] * rstd * conv_norm[c0 + 2 * i], o[2 * i + 1] * rstd * conv_norm[c0 + 2 * i + 1]);
                                        p1[i] = pkbf(o[8 + 2 * i] * rstd * conv_norm[c0 + 8 + 2 * i], o[8 + 2 * i + 1] * rstd * conv_norm[c0 + 8 + 2 * i + 1]); }
          *(GAS v4u*)(MIX + (size_t)row * DM + DATT + c0) = p0; *(GAS v4u*)(MIX + (size_t)row * DM + DATT + c0 + 8) = p1;
          if (t >= SEQ - 2) { float* oc = oconv_p + ((size_t)b * 2 + (t - (SEQ - 2))) * DCONV + c0;
#pragma unroll
            for (int i = 0; i < 4; ++i) *(GAS f32x4*)(oc + 4 * i) = (f32x4){cu[4 * i], cu[4 * i + 1], cu[4 * i + 2], cu[4 * i + 3]}; }
        }
        cur = nxt;
    }
}
__device__ __forceinline__ void elt_cache(const float* kpe_l, bf16* KPE, int gt, int NGT) {
    constexpr int N2 = MC * 64 / 8;
    for (int i = gt; i < N2; i += NGT) { const f32x8v x = *(const GAS f32x8v*)(kpe_l + (size_t)i * 8);
        v4u o; o.x = pkbf(x[0], x[1]); o.y = pkbf(x[2], x[3]); o.z = pkbf(x[4], x[5]); o.w = pkbf(x[6], x[7]); *(GAS v4u*)(KPE + (size_t)KVROW_C * 64 + (size_t)i * 8) = o; }
}
__device__ __forceinline__ void anorm_rows(bf16* MIX, const float* gain, int lane, int row0, int stride, int rend) {
    float gn[16];
#pragma unroll
    for (int i = 0; i < 4; ++i) { const f32x4 g4 = *(const GAS f32x4*)(gain + 16 * lane + 4 * i); gn[4 * i] = g4.x; gn[4 * i + 1] = g4.y; gn[4 * i + 2] = g4.z; gn[4 * i + 3] = g4.w; }
    if (row0 >= rend) return;
    const size_t rs = (size_t)stride * DM;
    bf16* mr = MIX + (size_t)row0 * DM + 16 * lane;
    v4u ra[4][2];
#pragma unroll
    for (int d = 0; d < 4; ++d) { ra[d][0] = (v4u){0u, 0u, 0u, 0u}; ra[d][1] = ra[d][0]; if (row0 + d * stride < rend) { ra[d][0] = *(const GAS v4u*)(mr + d * rs); ra[d][1] = *(const GAS v4u*)(mr + d * rs + 8); } }
    for (int row = row0; row < rend; row += 4 * stride, mr += 4 * rs) {
#pragma unroll
        for (int d = 0; d < 4; ++d) {
            const int r = row + d * stride;
            if (r < rend) {
                const v4u a0 = ra[d][0], a1 = ra[d][1];
                if (r + 4 * stride < rend) { ra[d][0] = *(const GAS v4u*)(mr + (d + 4) * rs); ra[d][1] = *(const GAS v4u*)(mr + (d + 4) * rs + 8); }
                float x[16];
#pragma unroll
                for (int i = 0; i < 4; ++i) { x[2 * i] = bf_lo(a0[i]); x[2 * i + 1] = bf_hi(a0[i]); x[8 + 2 * i] = bf_lo(a1[i]); x[8 + 2 * i + 1] = bf_hi(a1[i]); }
                float s = 0.f;
#pragma unroll
                for (int i = 0; i < 16; ++i) s += x[i] * x[i];
                const float rstd = 1.0f / sqrtf(wave_sum(s) * (1.f / DATT) + EPS);
                v4u p0, p1;
#pragma unroll
                for (int i = 0; i < 4; ++i) { p0[i] = pkbf(x[2 * i] * rstd * gn[2 * i], x[2 * i + 1] * rstd * gn[2 * i + 1]);
                                              p1[i] = pkbf(x[8 + 2 * i] * rstd * gn[8 + 2 * i], x[8 + 2 * i + 1] * rstd * gn[8 + 2 * i + 1]); }
                *(GAS v4u*)(mr + d * rs) = p0; *(GAS v4u*)(mr + d * rs + 8) = p1;
            }
        }
    }
}
__device__ __forceinline__ void sattn_unit(int b, int h, const bf16* Qs  , const bf16* KVb, const bf16* KVn  , const bf16* KPb, bf16* Ob, const float* cosT, const float* sinT, LAS unsigned char* lds, int tid, int lane, int wave) {
    constexpr int NKEY = PAST + TS;
    LAS float* S = (LAS float*)lds; LAS float* invl = (LAS float*)(lds + NKEY * 64);
    const int qi = lane & 15, g = lane >> 4;
    const int qrow0 = MP + b * TS;
    bf16x8 qf[6];
#if defined(SQ_RM) && !defined(SQ_QKB)
    { const bf16* qp = Qs + (size_t)(b * TS + qi) * NQ + h * QKD + 8 * g;
#pragma unroll
      for (int s = 0; s < 6; ++s) qf[s] = *(const bf16x8*)(qp + 32 * s);
#else
    { const bf16* qp = Qs + ((size_t)(h * 6) * 256 + b * TS + qi) * 32 + 8 * g;
#pragma unroll
      for (int s = 0; s < 6; ++s) qf[s] = *(const bf16x8*)(qp + s * 8192);
#endif
      const int pos = PAST + qi; const float* cp = cosT + pos * 32 + 8 * g; const float* sp = sinT + pos * 32 + 8 * g;
      const v4u x1 = *reinterpret_cast<const v4u*>(&qf[4]), x2 = *reinterpret_cast<const v4u*>(&qf[5]); v4u y1, y2;
#pragma unroll
      for (int w = 0; w < 4; ++w) { const float ca = cp[2 * w], cb = cp[2 * w + 1], sa = sp[2 * w], sb = sp[2 * w + 1];
          const float a1 = bf_lo(x1[w]), b1 = bf_hi(x1[w]), a2 = bf_lo(x2[w]), b2 = bf_hi(x2[w]);
          y1[w] = pkbf(a1 * ca - a2 * sa, b1 * cb - b2 * sb); y2[w] = pkbf(a2 * ca + a1 * sa, b2 * cb + b1 * sb); }
      qf[4] = *reinterpret_cast<const bf16x8*>(&y1); qf[5] = *reinterpret_cast<const bf16x8*>(&y2); }
#pragma unroll 1
    for (int i0 = 0; i0 < 16; i0 += 2) {
        bf16x8 kf[2][6];
#pragma unroll
        for (int u = 0; u < 2; ++u) { const int key = 16 * (wave + 8 * (i0 + u)) + qi; const size_t krow = (size_t)KVROW_C + (size_t)b * PAST + key;
            const bf16* kn = KVb + krow * NKV + h * 256 + 8 * g; const bf16* kp = KPb + krow * 64 + 8 * g;
#pragma unroll
            for (int s = 0; s < 4; ++s) kf[u][s] = *(const GAS bf16x8*)(kn + 32 * s);
            kf[u][4] = *(const GAS bf16x8*)kp; kf[u][5] = *(const GAS bf16x8*)(kp + 32); }
#pragma unroll
        for (int u = 0; u < 2; ++u) { const int tt = wave + 8 * (i0 + u); f32x4 acc = {0.f, 0.f, 0.f, 0.f};
#pragma unroll
            for (int s = 0; s < 6; ++s) acc = __builtin_amdgcn_mfma_f32_16x16x32_bf16(kf[u][s], qf[s], acc, 0, 0, 0);
#pragma unroll
            for (int r = 0; r < 4; ++r) S[(16 * tt + 4 * g + r) * 16 + qi] = acc[r] * (ATTN_SCALE * LOG2E); }
    }
    if (wave == 0) {
        const bf16* kn = KVn + ((size_t)(h * 8) * 256 + b * TS + qi) * 32 + 8 * g; const bf16* kp = KPb + ((size_t)KVROW_S + b * TS + qi) * 64 + 8 * g;
        f32x4 acc = {0.f, 0.f, 0.f, 0.f};
#pragma unroll
        for (int s = 0; s < 4; ++s) acc = __builtin_amdgcn_mfma_f32_16x16x32_bf16(*(const GAS bf16x8*)(kn + 8192 * s), qf[s], acc, 0, 0, 0);
#pragma unroll
        for (int s = 0; s < 2; ++s) acc = __builtin_amdgcn_mfma_f32_16x16x32_bf16(*(const GAS bf16x8*)(kp + 32 * s), qf[4 + s], acc, 0, 0, 0);
#pragma unroll
        for (int r = 0; r < 4; ++r) S[(PAST + 4 * g + r) * 16 + qi] = acc[r] * (ATTN_SCALE * LOG2E);
    }
    __syncthreads();
    for (int q = 2 * wave; q < 2 * wave + 2; ++q) {
        float m = -INFINITY;
        for (int k = lane; k < NKEY; k += 64) m = fmaxf(m, S[k * 16 + q]);
        m = wave_max(m);
        float s = 0.f;
        for (int k = lane; k < NKEY; k += 64) { const float p = __builtin_amdgcn_exp2f(S[k * 16 + q] - m); S[k * 16 + q] = p; s += p; }
        s = wave_sum(s);
        if (lane == 0) invl[q] = 1.0f / s;
    }
    __syncthreads();
    { const int vc4 = tid & 31, ks = tid >> 5;
      float o[16][4];
#pragma unroll
      for (int q = 0; q < 16; ++q)
#pragma unroll
          for (int c = 0; c < 4; ++c) o[q][c] = 0.f;
#define SPV_FMA(W_, KEY_) do { float v[4]; v[0] = bf_lo((unsigned)(W_)); v[1] = bf_hi((unsigned)(W_)); v[2] = bf_lo((unsigned)((W_) >> 32)); v[3] = bf_hi((unsigned)((W_) >> 32)); \
          const LAS f32x4* p4 = (const LAS f32x4*)(S + (KEY_) * 16); \
          _Pragma("unroll") for (int qq = 0; qq < 4; ++qq) { const f32x4 p = p4[qq]; \
              _Pragma("unroll") for (int c = 0; c < 4; ++c) { o[4 * qq][c] = fmaf(p.x, v[c], o[4 * qq][c]); o[4 * qq + 1][c] = fmaf(p.y, v[c], o[4 * qq + 1][c]); o[4 * qq + 2][c] = fmaf(p.z, v[c], o[4 * qq + 2][c]); o[4 * qq + 3][c] = fmaf(p.w, v[c], o[4 * qq + 3][c]); } } } while (0)
      {
        const __amdgpu_buffer_rsrc_t rs = __builtin_amdgcn_make_buffer_rsrc((void*)KVb, 0, (unsigned)((size_t)MKV * NKV * 2), 0x00020000);
        const unsigned voff = (unsigned)((ks * NKV + 4 * vc4) * 2);
        const unsigned sb0 = (unsigned)((((size_t)KVROW_C + (size_t)b * PAST) * NKV + h * 256 + 128) * 2);
        typedef unsigned u32x2v __attribute__((ext_vector_type(2)));
#pragma unroll 1
        for (int i0 = 0; i0 < 128; i0 += 4) {
            unsigned long long w[4];
#pragma unroll
            for (int u = 0; u < 4; ++u) w[u] = __builtin_bit_cast(unsigned long long, __builtin_amdgcn_raw_buffer_load_b64(rs, voff, sb0 + (unsigned)(16 * (i0 + u)) * (NKV * 2), 0));
#pragma unroll
            for (int u = 0; u < 4; ++u) { SPV_FMA(w[u], ks + 16 * (i0 + u)); if (u & 1) __builtin_amdgcn_sched_barrier(0); }
        }
        int vcl = vc4; asm volatile("" : "+v"(vcl));
        const unsigned long long wn = *(const GAS unsigned long long*)(KVn + ((size_t)(h * 8 + 4 + (vcl >> 3)) * 256 + b * TS + ks) * 32 + ((4 * vcl) & 31));
        SPV_FMA(wn, PAST + ks); }
#undef SPV_FMA
      int ln2; asm volatile("v_mbcnt_lo_u32_b32 %0, -1, 0\n\tv_mbcnt_hi_u32_b32 %0, -1, %0" : "=v"(ln2)); const int tid2 = wave * 64 + ln2, vc4b = tid2 & 31;
#pragma unroll
      for (int q = 0; q < 16; ++q)
#pragma unroll
          for (int c = 0; c < 4; ++c) o[q][c] = half_swap_add(o[q][c]);
      __syncthreads();
      LAS float* red = (LAS float*)lds;
      if (ln2 < 32) {
#pragma unroll
          for (int q = 0; q < 16; ++q) *(LAS f32x4*)(red + (wave * 16 + q) * 128 + 4 * vc4b) = (f32x4){o[q][0], o[q][1], o[q][2], o[q][3]}; }
      const float il = invl[tid2 >> 5];
      __syncthreads();
      { int tl2 = tid2; const int q = tl2 >> 5, c4 = (tl2 & 31) * 4; f32x4 acc = {0.f, 0.f, 0.f, 0.f};
#pragma unroll
        for (int w = 0; w < NWAVES; ++w) acc += *(const LAS f32x4*)(red + (w * 16 + q) * 128 + c4);
        acc = acc * il;
        unsigned long long pk = (unsigned long long)pkbf(acc.x, acc.y) | ((unsigned long long)pkbf(acc.z, acc.w) << 32);
        *(GAS unsigned long long*)(Ob + ((size_t)(4 * h + (c4 >> 5)) * 256 + b * TS + q) * 32 + (c4 & 31)) = pk; }
    }
    __syncthreads();
}

typedef float f32x16v __attribute__((ext_vector_type(16)));
struct SEpiPart {
    float* P; int ldp;
    __device__ __forceinline__ void operator()(const f32x16v& acc, int wave, int r32, int hi, int n0) const {
#pragma unroll
        for (int r = 0; r < 16; ++r) { const int row = 32 * wave + (r & 3) + 8 * (r >> 2) + 4 * hi; P[(size_t)row * ldp + n0 + r32] = acc[r]; }
    }
};
template <int ACT> struct SEpiBf {
    bf16* O; int badd = 0;
    __device__ __forceinline__ void operator()(const f32x16v& acc, int wave, int r32, int hi, int n0) const {
        bf16* ob = O + (size_t)((n0 >> 5) + badd) * (256 * 32) + r32;
#pragma unroll
        for (int r = 0; r < 16; ++r) { const int row = 32 * wave + (r & 3) + 8 * (r >> 2) + 4 * hi; float v = acc[r]; if (ACT == 1) { v = v > 0.f ? v : 0.f; v = v * v; }
            ob[row * 32] = (bf16)(pkbf(v, 0.f) & 0xffffu); }
    }
};
__device__ __forceinline__ size_t kb32(int row, int k) { return ((size_t)(k >> 5) * 256 + row) * 32 + (k & 31); }
template <class Epi> __device__ __forceinline__ void sgemm_unit(LAS unsigned char* lds, const bf16* A  , const bf16* Bt, int ldb, int n0, int k0, int Kc, const Epi& E, int lane, int wave) {
    const int r32 = lane & 31, hi = lane >> 5;
    const int rowB = Kc * 2 + 16, cpr = Kc / 512;
    const __amdgpu_buffer_rsrc_t arsrc = __builtin_amdgcn_make_buffer_rsrc((void*)A, 0, 0x7fffffff, 0x00020000);
    const unsigned avoff = (unsigned)((r32 * 32 + 8 * hi) * 2);
    const unsigned asoff = (unsigned)((((k0 >> 5) * 256 + 32 * wave) * 32) * 2);
#define SG_ALOAD(i) __builtin_bit_cast(bf16x8, __builtin_amdgcn_raw_buffer_load_b128(arsrc, avoff, asoff + (unsigned)(((i) >> 1) * 16384 + ((i) & 1) * 32), 0))
    bf16x8 a0[8], a1[8];
#pragma unroll
    for (int i = 0; i < 8; ++i) a0[i] = SG_ALOAD(i);
    for (int ch = wave; ch < 32 * cpr; ch += NWAVES) { const int c = ch / cpr, qd = ch % cpr;
        __builtin_amdgcn_global_load_lds((const unsigned*)(Bt + (size_t)(n0 + c) * ldb + k0 + qd * 512 + lane * 8), (LAS unsigned*)(lds + c * rowB + qd * 1024), 16, 0, 0); }
    asm volatile("s_waitcnt vmcnt(0)" ::: "memory");
    __syncthreads();
    f32x16v acc = {};
    const LAS unsigned char* Bp = lds + r32 * rowB + 16 * hi;
    for (int s = 0; s < Kc / 16; s += 16) {
#pragma unroll
        for (int i = 0; i < 8; ++i) a1[i] = SG_ALOAD(s + 8 + i);
#pragma unroll
        for (int i = 0; i < 8; ++i) acc = __builtin_amdgcn_mfma_f32_32x32x16_bf16(a0[i], *(const LAS bf16x8*)(Bp + 32 * (s + i)), acc, 0, 0, 0);
        if (s + 16 < Kc / 16) {
#pragma unroll
            for (int i = 0; i < 8; ++i) a0[i] = SG_ALOAD(s + 16 + i); }
#pragma unroll
        for (int i = 0; i < 8; ++i) acc = __builtin_amdgcn_mfma_f32_32x32x16_bf16(a1[i], *(const LAS bf16x8*)(Bp + 32 * (s + 8 + i)), acc, 0, 0, 0);
    }
    E(acc, wave, r32, hi, n0);
#undef SG_ALOAD
    __syncthreads();
}
__device__ __forceinline__ void elt_rows_s(const float* ZS, const float* q_norm, const float* kv_norm, const float* conv_w, const float* conv_norm, const float* state_conv_l,
                                           bf16* QNs, bf16* CKVs, bf16* MIXs  , float* ockv_s, float* oconv_s, int lane, int gw, int NGW,
                                           const float* KS  , bf16* KPEs  , float* okpe_s, const float* cosT, const float* sinT,
                                           int part = -1  ) {
    for (int r = gw; r < MS; r += NGW) {
        const int t = r & (TS - 1), b = r >> 4;
        if (lane < 32 && (part < 0 || part == 0)) {
            const float* k0 = KS + (size_t)r * 64; const float* k1 = k0 + (size_t)MS * 64; const float* k2 = k1 + (size_t)MS * 64; const float* k3 = k2 + (size_t)MS * 64;
            const float x1 = (k0[lane] + k1[lane]) + (k2[lane] + k3[lane]), x2 = (k0[32 + lane] + k1[32 + lane]) + (k2[32 + lane] + k3[32 + lane]);
            const float cs = cosT[(PAST + t) * 32 + lane], sn = sinT[(PAST + t) * 32 + lane];
            const float o1 = x1 * cs - x2 * sn, o2 = x2 * cs + x1 * sn;
            okpe_s[(size_t)r * 64 + lane] = o1; okpe_s[(size_t)r * 64 + 32 + lane] = o2;
            KPEs[(size_t)r * 64 + lane] = (bf16)(pkbf(o1, 0.f) & 0xffffu); KPEs[(size_t)r * 64 + 32 + lane] = (bf16)(pkbf(o2, 0.f) & 0xffffu); }
        const float* z0 = ZS + (size_t)r * 4096; const float* z1 = z0 + (size_t)MS * 4096;
        if (part < 0 || part == 1) {
            const f32x4 a0 = *(const GAS f32x4*)(z0 + 8 * lane) + *(const GAS f32x4*)(z1 + 8 * lane), a1 = *(const GAS f32x4*)(z0 + 8 * lane + 4) + *(const GAS f32x4*)(z1 + 8 * lane + 4);
            const float s = (a0.x * a0.x + a0.y * a0.y) + (a0.z * a0.z + a0.w * a0.w) + (a1.x * a1.x + a1.y * a1.y) + (a1.z * a1.z + a1.w * a1.w);
            const float rstd = 1.0f / sqrtf(wave_sum(s) * (1.f / QLR) + EPS);
            const f32x4 g0 = *(const GAS f32x4*)(q_norm + 8 * lane), g1 = *(const GAS f32x4*)(q_norm + 8 * lane + 4);
            v4u o; o.x = pkbf(a0.x * rstd * g0.x, a0.y * rstd * g0.y); o.y = pkbf(a0.z * rstd * g0.z, a0.w * rstd * g0.w); o.z = pkbf(a1.x * rstd * g1.x, a1.y * rstd * g1.y); o.w = pkbf(a1.z * rstd * g1.z, a1.w * rstd * g1.w);
            *(GAS v4u*)(QNs + kb32(r, 8 * lane)) = o; }
        if (part < 0 || part == 2) {
            const f32x4 a0 = *(const GAS f32x4*)(z0 + 512 + 8 * lane) + *(const GAS f32x4*)(z1 + 512 + 8 * lane), a1 = *(const GAS f32x4*)(z0 + 512 + 8 * lane + 4) + *(const GAS f32x4*)(z1 + 512 + 8 * lane + 4);
            const float s = (a0.x * a0.x + a0.y * a0.y) + (a0.z * a0.z + a0.w * a0.w) + (a1.x * a1.x + a1.y * a1.y) + (a1.z * a1.z + a1.w * a1.w);
            const float rstd = 1.0f / sqrtf(wave_sum(s) * (1.f / KVLR) + EPS);
            const f32x4 g0 = *(const GAS f32x4*)(kv_norm + 8 * lane), g1 = *(const GAS f32x4*)(kv_norm + 8 * lane + 4);
            const f32x4 y0 = a0 * rstd * g0, y1 = a1 * rstd * g1;
            *(GAS f32x4*)(ockv_s + (size_t)r * KVLR + 8 * lane) = y0; *(GAS f32x4*)(ockv_s + (size_t)r * KVLR + 8 * lane + 4) = y1;
            v4u o; o.x = pkbf(y0.x, y0.y); o.y = pkbf(y0.z, y0.w); o.z = pkbf(y1.x, y1.y); o.w = pkbf(y1.z, y1.w);
            *(GAS v4u*)(CKVs + kb32(r, 8 * lane)) = o; }
        if (part < 0 || part == 3) {
            const int c0 = 16 * lane, vC = 1024 + 256 * (c0 >> 7) + (c0 & 127), vU = vC + 128, vB = 3072 + c0;
            float cu[16], f1[16], f0[16], gb[16];
#pragma unroll
            for (int i = 0; i < 16; ++i) { cu[i] = (z0[vC + i] + z1[vC + i]) * (z0[vU + i] + z1[vU + i]); gb[i] = z0[vB + i] + z1[vB + i]; }
            if (t >= 1) {
#pragma unroll
                for (int i = 0; i < 16; ++i) f1[i] = (z0[vC + i - 4096] + z1[vC + i - 4096]) * (z0[vU + i - 4096] + z1[vU + i - 4096]); }
            else {
#pragma unroll
                for (int i = 0; i < 16; ++i) f1[i] = state_conv_l[((size_t)b * 2 + 1) * DCONV + c0 + i]; }
            if (t >= 2) {
#pragma unroll
                for (int i = 0; i < 16; ++i) f0[i] = (z0[vC + i - 8192] + z1[vC + i - 8192]) * (z0[vU + i - 8192] + z1[vU + i - 8192]); }
            else {
#pragma unroll
                for (int i = 0; i < 16; ++i) f0[i] = state_conv_l[((size_t)b * 2 + t) * DCONV + c0 + i]; }
            float o[16]; float s = 0.f;
#pragma unroll
            for (int i = 0; i < 16; ++i) { const float y = conv_w[c0 + i] * f0[i] + conv_w[DCONV + c0 + i] * f1[i] + conv_w[2 * DCONV + c0 + i] * cu[i]; o[i] = gb[i] * y; s += o[i] * o[i]; }
            const float rstd = 1.0f / sqrtf(wave_sum(s) * (1.f / DCONV) + EPS);
            v4u p0, p1;
#pragma unroll
            for (int i = 0; i < 4; ++i) { p0[i] = pkbf(o[2 * i] * rstd * conv_norm[c0 + 2 * i], o[2 * i + 1] * rstd * conv_norm[c0 + 2 * i + 1]);
                                          p1[i] = pkbf(o[8 + 2 * i] * rstd * conv_norm[c0 + 8 + 2 * i], o[8 + 2 * i + 1] * rstd * conv_norm[c0 + 8 + 2 * i + 1]); }
            *(GAS v4u*)(MIXs + kb32(r, DATT + c0)) = p0; *(GAS v4u*)(MIXs + kb32(r, DATT + c0 + 8)) = p1;
            if (t >= TS - 2) { float* oc = oconv_s + ((size_t)b * 2 + (t - (TS - 2))) * DCONV + c0;
#pragma unroll
                for (int i = 0; i < 4; ++i) *(GAS f32x4*)(oc + 4 * i) = (f32x4){cu[4 * i], cu[4 * i + 1], cu[4 * i + 2], cu[4 * i + 3]}; }
        }
    }
}
template <bool FINAL> __device__ __forceinline__ void norm_rows_s(const float* xs, float* X, bool first, const float* PS, int np, const float* gatel  ,
                                                                  const float* modl, int sh_off, int sc_off, bf16* H, const float* gain, float* yout, int lane, int gw, int NGW, const float* ssa = nullptr  ) {
    for (int r = gw; r < MS; r += NGW) {
        const int row = MP + r, b = NBP + (r >> 4);
        float ra = 1.f;
        if (ssa) { float t = 0.f;
#pragma unroll
            for (int hh = 0; hh < NH; ++hh) t += ssa[hh * 256 + r];
            ra = 1.0f / sqrtf(t * (1.f / DATT) + EPS); }
        const GAS f32x4* x4 = (const GAS f32x4*)(first ? xs + (size_t)r * DM : X + (size_t)row * DM) + lane;
        f32x4 v[8]; float s = 0.f;
#pragma unroll
        for (int j = 0; j < 8; ++j) { v[j] = x4[64 * j];
            if (np > 0) { f32x4 p = {0.f, 0.f, 0.f, 0.f};
                for (int k = 0; k < np; ++k) { const f32x4 pk = ((const GAS f32x4*)(PS + ((size_t)k * MS + r) * DM) + lane)[64 * j]; p += (k < 2) ? pk * ra : pk; }
                v[j] += ((const GAS f32x4*)(gatel + (size_t)b * MODW) + lane)[64 * j] * p; }
            s += (v[j].x * v[j].x + v[j].y * v[j].y) + (v[j].z * v[j].z + v[j].w * v[j].w); }
        if (!FINAL && (np > 0 || first)) { GAS f32x4* xc = (GAS f32x4*)(X + (size_t)row * DM) + lane;
#pragma unroll
            for (int j = 0; j < 8; ++j) xc[64 * j] = v[j]; }
        const float rstd = 1.0f / sqrtf(wave_sum(s) * (1.f / DM) + EPS);
        if (FINAL) { const GAS f32x4* g4 = (const GAS f32x4*)gain + lane; GAS f32x4* o4 = (GAS f32x4*)(yout + (size_t)row * DM) + lane;
#pragma unroll
            for (int j = 0; j < 8; ++j) o4[64 * j] = v[j] * rstd * g4[64 * j]; }
        else { const GAS f32x4* sc4 = (const GAS f32x4*)(modl + (size_t)b * MODW + sc_off) + lane; const GAS f32x4* sh4 = (const GAS f32x4*)(modl + (size_t)b * MODW + sh_off) + lane;
#pragma unroll
            for (int j = 0; j < 8; ++j) { const f32x4 sc = sc4[64 * j], sh = sh4[64 * j]; GAS unsigned long long* o8 = (GAS unsigned long long*)(H + kb32(r, 4 * lane + 256 * j));
                const float a = v[j].x * rstd * (1.f + sc.x) + sh.x, bq = v[j].y * rstd * (1.f + sc.y) + sh.y, c = v[j].z * rstd * (1.f + sc.z) + sh.z, d = v[j].w * rstd * (1.f + sc.w) + sh.w;
                *o8 = (unsigned long long)pkbf(a, bq) | ((unsigned long long)pkbf(c, d) << 32); } }
    }
}

template <bool FINAL> __device__ __forceinline__ void norm_rows_s_coop(const float* xs, float* X, bool first, const float* PS, int np, const float* gatel, const float* modl, int sh_off, int sc_off, bf16* H,
                                                                       const float* gain, float* yout, LAS float* red, int lane, int wave, int vcu, int G, const float* ssa = nullptr) {
    for (int r = vcu; r < MS; r += G) {
        const int row = MP + r, b = NBP + (r >> 4), j = wave;
        float ra = 1.f;
        if (ssa) { float t = 0.f;
#pragma unroll
            for (int hh = 0; hh < NH; ++hh) t += ssa[hh * 256 + r];
            ra = 1.0f / sqrtf(t * (1.f / DATT) + EPS); }
        f32x4 v = ((const GAS f32x4*)(first ? xs + (size_t)r * DM : X + (size_t)row * DM) + lane)[64 * j];
        if (np > 0) { f32x4 p = {0.f, 0.f, 0.f, 0.f};
            for (int k = 0; k < np; ++k) { const f32x4 pk = ((const GAS f32x4*)(PS + ((size_t)k * MS + r) * DM) + lane)[64 * j]; p += (k < 2) ? pk * ra : pk; }
            v += ((const GAS f32x4*)(gatel + (size_t)b * MODW) + lane)[64 * j] * p; }
        const float sw = wave_sum((v.x * v.x + v.y * v.y) + (v.z * v.z + v.w * v.w));
        if (lane == 0) red[wave] = sw;
        if (!FINAL && (np > 0 || first)) ((GAS f32x4*)(X + (size_t)row * DM) + lane)[64 * j] = v;
        __syncthreads();
        float s = 0.f;
#pragma unroll
        for (int w = 0; w < NWAVES; ++w) s += red[w];
        const float rstd = 1.0f / sqrtf(s * (1.f / DM) + EPS);
        if (FINAL) ((GAS f32x4*)(yout + (size_t)row * DM) + lane)[64 * j] = v * rstd * ((const GAS f32x4*)gain + lane)[64 * j];
        else { const f32x4 sc = ((const GAS f32x4*)(modl + (size_t)b * MODW + sc_off) + lane)[64 * j], sh = ((const GAS f32x4*)(modl + (size_t)b * MODW + sh_off) + lane)[64 * j];
            const float a = v.x * rstd * (1.f + sc.x) + sh.x, bq = v.y * rstd * (1.f + sc.y) + sh.y, c = v.z * rstd * (1.f + sc.z) + sh.z, d = v.w * rstd * (1.f + sc.w) + sh.w;
            *(GAS unsigned long long*)(H + kb32(r, 4 * lane + 256 * j)) = (unsigned long long)pkbf(a, bq) | ((unsigned long long)pkbf(c, d) << 32); }
        __syncthreads();
    }
}
constexpr size_t WS_SA = WS_KV + 64 * MiB;
constexpr size_t WS_QA = WS_SA, WS_PO = WS_SA + 4 * MiB, WS_PML = WS_SA + 40 * MiB, WS_SSA = WS_SA + 41 * MiB;
constexpr int SCH = 17;
static_assert((size_t)NBS * SCH * 8 * 32 * 256 * 2 <= 36 * MiB && WS_SSA + 8192 <= WS_MIX, "absorbed-attention scratch");
typedef short s16x4v __attribute__((ext_vector_type(4)));
template <int OFF> __device__ __forceinline__ s16x4v sa_tr(int vb) { s16x4v r; asm volatile("ds_read_b64_tr_b16 %0, %1 offset:%2" : "=&v"(r) : "v"(vb), "i"(OFF) : "memory"); return r; }
__device__ __forceinline__ bf16x8 cvt8_f32(const float* p) { const f32x4 a = *(const GAS f32x4*)p, b = *(const GAS f32x4*)(p + 4); v4u o; o.x = pkbf(a.x, a.y); o.y = pkbf(a.z, a.w); o.z = pkbf(b.x, b.y); o.w = pkbf(b.z, b.w);
    return __builtin_bit_cast(bf16x8, o); }
__device__ __forceinline__ void prep_qabs(const float* w_uq, const float* w_ukv, unsigned char* ws, LAS unsigned char* lds, int tid, int lane, int wave, int first, int stride) {
    constexpr int PITCH = 272, BOFF = 128 * PITCH;
    const int i32 = lane & 31, hi = lane >> 5, ct = wave & 3, kq = wave >> 2;
    for (int it = first; it < DEPTH * NH * 8; it += stride) {
        const int kh = it & 1, cq = (it >> 1) & 3, h = (it >> 3) & 7, l = it >> 6;
        __syncthreads();
        { const float* asrc = w_ukv + ((size_t)l * KVLR + 128 * cq) * NKV + h * 256;
          const float* bsrc = w_uq + ((size_t)l * QLR + 256 * kh) * NQ + h * QKD;
          bf16x8 av[4], bv[8];
#pragma unroll
          for (int i = 0; i < 4; ++i) { const int id = tid + 512 * i; av[i] = cvt8_f32(asrc + (size_t)(id >> 4) * NKV + 8 * (id & 15)); }
#pragma unroll
          for (int i = 0; i < 8; ++i) { const int id = tid + 512 * i; bv[i] = cvt8_f32(bsrc + (size_t)(id >> 4) * NQ + 8 * (id & 15)); }
#pragma unroll
          for (int i = 0; i < 4; ++i) { const int id = tid + 512 * i; *(LAS bf16x8*)(lds + (id >> 4) * PITCH + 16 * (id & 15)) = av[i]; }
#pragma unroll
          for (int i = 0; i < 8; ++i) { const int id = tid + 512 * i; *(LAS bf16x8*)(lds + BOFF + (id >> 4) * PITCH + 16 * (id & 15)) = bv[i]; } }
        __syncthreads();
        const LAS unsigned char* ap = lds + (32 * ct + i32) * PITCH + 16 * hi;
        const LAS unsigned char* bp = lds + BOFF + (128 * kq + i32) * PITCH + 16 * hi;
        bf16* o = (bf16*)(ws + WS_W + (size_t)l * W_LAYER + WO_QA) + (size_t)(h * 512 + 128 * cq + 32 * ct) * QLR + 256 * kh + 128 * kq + i32;
#pragma unroll
        for (int kt = 0; kt < 4; ++kt) { f32x16v acc = {};
#pragma unroll
            for (int s = 0; s < 8; ++s) acc = __builtin_amdgcn_mfma_f32_32x32x16_bf16(*(const LAS bf16x8*)(ap + 32 * s), *(const LAS bf16x8*)(bp + kt * 32 * PITCH + 32 * s), acc, 0, 0, 0);
#pragma unroll
            for (int r = 0; r < 16; ++r) o[(size_t)((r & 3) + 8 * (r >> 2) + 4 * hi) * QLR + 32 * kt] = (bf16)(pkbf(acc[r], 0.f) & 0xffffu); }
    }
    __syncthreads();
}
__device__ __forceinline__ void sabs_unit(int b, int ch, const bf16* QAs  , const bf16* CKV, const bf16* KPE, const float* ckv_l  , const float* kpe_l  , const float* cosT, const float* sinT, bf16* PO, float* PML,
                                          LAS unsigned char* lds, int lane, int wave) {
    const int qi = lane & 15, g = lane >> 4, h = wave;
    const bool isnew = ch == SCH - 1;
    __syncthreads();
    bf16x8 qf[18];
    { const bf16* pp = QAs + ((size_t)(128 + 2 * h) * 256 + b * TS + qi) * 32 + 8 * g;
      qf[16] = *(const GAS bf16x8*)pp; qf[17] = *(const GAS bf16x8*)(pp + 8192);
      const int pos = PAST + qi; const float* cp = cosT + pos * 32 + 8 * g; const float* sp = sinT + pos * 32 + 8 * g;
      const v4u x1 = __builtin_bit_cast(v4u, qf[16]), x2 = __builtin_bit_cast(v4u, qf[17]); v4u y1, y2;
#pragma unroll
      for (int w = 0; w < 4; ++w) { const float ca = cp[2 * w], cb = cp[2 * w + 1], sa = sp[2 * w], sb = sp[2 * w + 1];
          const float a1 = bf_lo(x1[w]), b1 = bf_hi(x1[w]), a2 = bf_lo(x2[w]), b2 = bf_hi(x2[w]);
          y1[w] = pkbf(a1 * ca - a2 * sa, b1 * cb - b2 * sb); y2[w] = pkbf(a2 * ca + a1 * sa, b2 * cb + b1 * sb); }
      qf[16] = __builtin_bit_cast(bf16x8, y1); qf[17] = __builtin_bit_cast(bf16x8, y2); }
    f32x4 sc[8];
#pragma unroll
    for (int T = 0; T < 8; ++T) sc[T] = (f32x4){0.f, 0.f, 0.f, 0.f};
    if (!isnew) {
        const float* src = ckv_l + ((size_t)b * PAST + 128 * ch + wave) * KVLR + 8 * lane;
        const float* kf = kpe_l + ((size_t)b * PAST + 128 * ch + qi) * 64 + 8 * g;
        const int cbk = lane >> 4, c16 = lane & 15;
        f32x4 v0[8], v1[8], kq[4][4];
#define SA_SLOAD(HB) do { _Pragma("unroll") for (int j = 0; j < 8; ++j) { const float* p = src + (size_t)(8 * (8 * (HB) + j)) * KVLR; v0[j] = *(const GAS f32x4*)p; v1[j] = *(const GAS f32x4*)(p + 4); } } while (0)
#define SA_SWRITE(HB) do { _Pragma("unroll") for (int j = 0; j < 8; ++j) { const int key = 8 * (8 * (HB) + j) + wave, row = key & 31, xr = ((row & 3) << 2) | ((row >> 2) & 3); \
            v4u o; o.x = pkbf(v0[j].x, v0[j].y); o.y = pkbf(v0[j].z, v0[j].w); o.z = pkbf(v1[j].x, v1[j].y); o.w = pkbf(v1[j].z, v1[j].w); \
            *(LAS v4u*)(lds + ((key >> 5) * 4 + cbk) * 8192 + 256 * row + 16 * (c16 ^ xr)) = o; } } while (0)
#define SA_KLOAD(T0) do { _Pragma("unroll") for (int t = 0; t < 4; ++t) { const float* p = kf + (size_t)(16 * ((T0) + t)) * 64; kq[t][0] = *(const GAS f32x4*)p; kq[t][1] = *(const GAS f32x4*)(p + 4); kq[t][2] = *(const GAS f32x4*)(p + 32); kq[t][3] = *(const GAS f32x4*)(p + 36); } } while (0)
#define SA_KMMA(T0) do { _Pragma("unroll") for (int t = 0; t < 4; ++t) { v4u a, c; a.x = pkbf(kq[t][0].x, kq[t][0].y); a.y = pkbf(kq[t][0].z, kq[t][0].w); a.z = pkbf(kq[t][1].x, kq[t][1].y); a.w = pkbf(kq[t][1].z, kq[t][1].w); \
            c.x = pkbf(kq[t][2].x, kq[t][2].y); c.y = pkbf(kq[t][2].z, kq[t][2].w); c.z = pkbf(kq[t][3].x, kq[t][3].y); c.w = pkbf(kq[t][3].z, kq[t][3].w); \
            sc[(T0) + t] = __builtin_amdgcn_mfma_f32_16x16x32_bf16(__builtin_bit_cast(bf16x8, a), qf[16], sc[(T0) + t], 0, 0, 0); sc[(T0) + t] = __builtin_amdgcn_mfma_f32_16x16x32_bf16(__builtin_bit_cast(bf16x8, c), qf[17], sc[(T0) + t], 0, 0, 0); } } while (0)
        SA_SLOAD(0); SA_KLOAD(0); __builtin_amdgcn_sched_barrier(0);
        SA_SWRITE(0); __builtin_amdgcn_sched_barrier(0);
        SA_SLOAD(1); __builtin_amdgcn_sched_barrier(0);
        SA_KMMA(0); __builtin_amdgcn_sched_barrier(0);
        SA_KLOAD(4); __builtin_amdgcn_sched_barrier(0);
        SA_SWRITE(1); __builtin_amdgcn_sched_barrier(0);
        SA_KMMA(4);
#undef SA_SLOAD
#undef SA_SWRITE
#undef SA_KLOAD
#undef SA_KMMA
    } else {
        const int row = 4 * wave + g; const int chk = (lane & 15) ^ (((row & 3) << 2) | ((row >> 2) & 3));
        const bf16* src = CKV + (size_t)KVROW_S * KVLR + ((size_t)(chk >> 2) * 256 + b * TS + (row & 15)) * 32 + (chk & 3) * 8;
#pragma unroll
        for (int cbk = 0; cbk < 4; ++cbk) __builtin_amdgcn_global_load_lds((const unsigned*)(src + (size_t)cbk * 4 * 8192), (LAS unsigned*)(lds + cbk * 8192 + wave * 1024), 16, 0, 0);
        const bf16* kp = KPE + ((size_t)KVROW_S + b * TS + qi) * 64 + 8 * g;
        sc[0] = __builtin_amdgcn_mfma_f32_16x16x32_bf16(*(const GAS bf16x8*)kp, qf[16], sc[0], 0, 0, 0); sc[0] = __builtin_amdgcn_mfma_f32_16x16x32_bf16(*(const GAS bf16x8*)(kp + 32), qf[17], sc[0], 0, 0, 0);
    }
    { const bf16* qp = QAs + ((size_t)(h * 16) * 256 + b * TS + qi) * 32 + 8 * g;
#pragma unroll
      for (int s = 0; s < 16; ++s) qf[s] = *(const GAS bf16x8*)(qp + (size_t)s * 8192); }
    asm volatile("s_waitcnt vmcnt(0)" ::: "memory");
    __syncthreads();
    { const int ab = 256 * qi + 16 * (g ^ ((qi >> 2) & 3));
      int o4[4];
#pragma unroll
      for (int s4 = 0; s4 < 4; ++s4) o4[s4] = 64 * (s4 ^ (qi & 3));
#pragma unroll
      for (int T = 0; T < 8; ++T) {
          if (T < 1 || !isnew) {
              f32x4 acc = sc[T];
              const LAS unsigned char* ip = lds + (T >> 1) * 32768 + (T & 1) * 4096 + ab;
#pragma unroll
              for (int s = 0; s < 16; ++s) acc = __builtin_amdgcn_mfma_f32_16x16x32_bf16(*(const LAS bf16x8*)(ip + (s >> 2) * 8192 + o4[s & 3]), qf[s], acc, 0, 0, 0);
              sc[T] = acc * (ATTN_SCALE * LOG2E);
          } else sc[T] = (f32x4){-INFINITY, -INFINITY, -INFINITY, -INFINITY};
      }
    }
    float m = sc[0][0];
#pragma unroll
    for (int T = 0; T < 8; ++T)
#pragma unroll
        for (int r = 0; r < 4; ++r) m = fmaxf(m, sc[T][r]);
    m = fmaxf(m, swz_xor<16>(m)); m = half_swap_max(m);
    float lsum = 0.f;
#pragma unroll
    for (int T = 0; T < 8; ++T)
#pragma unroll
        for (int r = 0; r < 4; ++r) { sc[T][r] = __builtin_amdgcn_exp2f(sc[T][r] - m); lsum += sc[T][r]; }
    lsum += swz_xor<16>(lsum); lsum = half_swap_add(lsum);
    const size_t unit = (size_t)b * SCH + ch;
    if (g == 0) { float* mp = PML + ((unit * 8 + h) * 16 + qi) * 2; mp[0] = m; mp[1] = lsum; }
    bf16x8 pf[4];
#pragma unroll
    for (int kb = 0; kb < 4; ++kb) { v4u o; o.x = pkbf(sc[2 * kb][0], sc[2 * kb][1]); o.y = pkbf(sc[2 * kb][2], sc[2 * kb][3]); o.z = pkbf(sc[2 * kb + 1][0], sc[2 * kb + 1][1]); o.w = pkbf(sc[2 * kb + 1][2], sc[2 * kb + 1][3]);
        pf[kb] = __builtin_bit_cast(bf16x8, o); }
    f32x4 oacc[32];
#pragma unroll
    for (int t = 0; t < 32; ++t) oacc[t] = (f32x4){0.f, 0.f, 0.f, 0.f};
    { const int q4 = qi >> 2, p = lane & 3;
      const int trb = (int)(unsigned)(size_t)lds + 256 * (4 * g + q4) + 16 * ((p >> 1) ^ (g & 1)) + 8 * (p & 1);
      const int x3 = (q4 << 1) | (g >> 1);
      int vb[8];
#pragma unroll
      for (int c = 0; c < 8; ++c) vb[c] = trb + 32 * (c ^ x3);
#define SA_BLK(KB, CBK, VBA) do { \
          const s16x4v a0 = sa_tr<((KB) & 1) * 32768 + (CBK) * 8192>(VBA[0]), b0 = sa_tr<((KB) & 1) * 32768 + (CBK) * 8192 + 4096>(VBA[0]); \
          const s16x4v a1 = sa_tr<((KB) & 1) * 32768 + (CBK) * 8192>(VBA[1]), b1 = sa_tr<((KB) & 1) * 32768 + (CBK) * 8192 + 4096>(VBA[1]); \
          const s16x4v a2 = sa_tr<((KB) & 1) * 32768 + (CBK) * 8192>(VBA[2]), b2 = sa_tr<((KB) & 1) * 32768 + (CBK) * 8192 + 4096>(VBA[2]); \
          const s16x4v a3 = sa_tr<((KB) & 1) * 32768 + (CBK) * 8192>(VBA[3]), b3 = sa_tr<((KB) & 1) * 32768 + (CBK) * 8192 + 4096>(VBA[3]); \
          const s16x4v a4 = sa_tr<((KB) & 1) * 32768 + (CBK) * 8192>(VBA[4]), b4 = sa_tr<((KB) & 1) * 32768 + (CBK) * 8192 + 4096>(VBA[4]); \
          const s16x4v a5 = sa_tr<((KB) & 1) * 32768 + (CBK) * 8192>(VBA[5]), b5 = sa_tr<((KB) & 1) * 32768 + (CBK) * 8192 + 4096>(VBA[5]); \
          const s16x4v a6 = sa_tr<((KB) & 1) * 32768 + (CBK) * 8192>(VBA[6]), b6 = sa_tr<((KB) & 1) * 32768 + (CBK) * 8192 + 4096>(VBA[6]); \
          const s16x4v a7 = sa_tr<((KB) & 1) * 32768 + (CBK) * 8192>(VBA[7]), b7 = sa_tr<((KB) & 1) * 32768 + (CBK) * 8192 + 4096>(VBA[7]); \
          asm volatile("s_waitcnt lgkmcnt(0)" ::: "memory"); __builtin_amdgcn_sched_barrier(0); \
          oacc[(CBK) * 8 + 0] = __builtin_amdgcn_mfma_f32_16x16x32_bf16(SA_PK(a0, b0), pf[KB], oacc[(CBK) * 8 + 0], 0, 0, 0); oacc[(CBK) * 8 + 1] = __builtin_amdgcn_mfma_f32_16x16x32_bf16(SA_PK(a1, b1), pf[KB], oacc[(CBK) * 8 + 1], 0, 0, 0); \
          oacc[(CBK) * 8 + 2] = __builtin_amdgcn_mfma_f32_16x16x32_bf16(SA_PK(a2, b2), pf[KB], oacc[(CBK) * 8 + 2], 0, 0, 0); oacc[(CBK) * 8 + 3] = __builtin_amdgcn_mfma_f32_16x16x32_bf16(SA_PK(a3, b3), pf[KB], oacc[(CBK) * 8 + 3], 0, 0, 0); \
          oacc[(CBK) * 8 + 4] = __builtin_amdgcn_mfma_f32_16x16x32_bf16(SA_PK(a4, b4), pf[KB], oacc[(CBK) * 8 + 4], 0, 0, 0); oacc[(CBK) * 8 + 5] = __builtin_amdgcn_mfma_f32_16x16x32_bf16(SA_PK(a5, b5), pf[KB], oacc[(CBK) * 8 + 5], 0, 0, 0); \
          oacc[(CBK) * 8 + 6] = __builtin_amdgcn_mfma_f32_16x16x32_bf16(SA_PK(a6, b6), pf[KB], oacc[(CBK) * 8 + 6], 0, 0, 0); oacc[(CBK) * 8 + 7] = __builtin_amdgcn_mfma_f32_16x16x32_bf16(SA_PK(a7, b7), pf[KB], oacc[(CBK) * 8 + 7], 0, 0, 0); \
          __builtin_amdgcn_sched_barrier(0); } while (0)
#define SA_PK(L, H) ((bf16x8){L[0], L[1], L[2], L[3], H[0], H[1], H[2], H[3]})
#define SA_KB(KB, VBA) do { SA_BLK(KB, 0, VBA); SA_BLK(KB, 1, VBA); SA_BLK(KB, 2, VBA); SA_BLK(KB, 3, VBA); } while (0)
      SA_KB(0, vb);
      if (!isnew) { SA_KB(1, vb);
          int vc[8];
#pragma unroll
          for (int c = 0; c < 8; ++c) vc[c] = vb[c] + 65536;
          SA_KB(2, vc); SA_KB(3, vc); }
#undef SA_KB
#undef SA_BLK
#undef SA_PK
    }
    { bf16* po = PO + ((unit * 8 + h) * 32) * 256 + lane * 4;
#pragma unroll
      for (int t = 0; t < 32; ++t) *(GAS unsigned long long*)(po + t * 256) = (unsigned long long)pkbf(oacc[t][0], oacc[t][1]) | ((unsigned long long)pkbf(oacc[t][2], oacc[t][3]) << 32); }
    __syncthreads();
}
__device__ __forceinline__ void scomb_unit(int b, int h, const bf16* PO, const float* PML, const bf16* WUKVt  , const float* gain, bf16* MIXs  , float* SSA,
                                           LAS unsigned char* lds, int lane, int wave) {
    const int qi = lane & 15, g = lane >> 4;
    __syncthreads();
    const float* ml0 = PML + (((size_t)b * SCH * 8 + h) * 16 + qi) * 2;
    const bf16* po0 = PO + (((size_t)b * SCH * 8 + h) * 32 + 4 * wave) * 256 + lane * 4;
    const bf16* wp = WUKVt + (size_t)(h * 256 + 128 + qi) * KVLR + 64 * wave + 4 * g;
    pg8::f32x2 ml[SCH]; unsigned long long wl_[8][2][2], pa[6][4], pb[6][4];
#pragma unroll
    for (int ch = 0; ch < SCH; ++ch) ml[ch] = *(const GAS pg8::f32x2*)(ml0 + ch * 256);
#pragma unroll
    for (int c = 0; c < 6; ++c)
#pragma unroll
        for (int t = 0; t < 4; ++t) pa[c][t] = *(const GAS unsigned long long*)(po0 + (size_t)c * 65536 + t * 256);
#pragma unroll
    for (int c = 0; c < 6; ++c)
#pragma unroll
        for (int t = 0; t < 4; ++t) pb[c][t] = *(const GAS unsigned long long*)(po0 + (size_t)(6 + c) * 65536 + t * 256);
#pragma unroll
    for (int vt = 0; vt < 8; ++vt)
#pragma unroll
        for (int k2 = 0; k2 < 2; ++k2) { wl_[vt][k2][0] = *(const GAS unsigned long long*)(wp + (size_t)vt * 16 * KVLR + 32 * k2); wl_[vt][k2][1] = *(const GAS unsigned long long*)(wp + (size_t)vt * 16 * KVLR + 32 * k2 + 16); }
    __builtin_amdgcn_sched_barrier(0);
    float M = ml[0].x;
#pragma unroll
    for (int ch = 1; ch < SCH; ++ch) M = fmaxf(M, ml[ch].x);
    float L = 0.f; f32x4 acc[4];
#pragma unroll
    for (int t = 0; t < 4; ++t) acc[t] = (f32x4){0.f, 0.f, 0.f, 0.f};
#define SC_ACC(PV, C0, NC) do { _Pragma("unroll") for (int c = 0; c < NC; ++c) { const float w = __builtin_amdgcn_exp2f(ml[(C0) + c].x - M); L += w * ml[(C0) + c].y; \
            _Pragma("unroll") for (int t = 0; t < 4; ++t) { const unsigned lo = (unsigned)PV[c][t], hi2 = (unsigned)(PV[c][t] >> 32); acc[t] += w * (f32x4){bf_lo(lo), bf_hi(lo), bf_lo(hi2), bf_hi(hi2)}; } } } while (0)
    SC_ACC(pa, 0, 6);
    __builtin_amdgcn_sched_barrier(0);
#pragma unroll
    for (int c = 0; c < 5; ++c)
#pragma unroll
        for (int t = 0; t < 4; ++t) pa[c][t] = *(const GAS unsigned long long*)(po0 + (size_t)(12 + c) * 65536 + t * 256);
    __builtin_amdgcn_sched_barrier(0);
    SC_ACC(pb, 6, 6);
    __builtin_amdgcn_sched_barrier(0);
    SC_ACC(pa, 12, 5);
#undef SC_ACC
    const float inv = 1.0f / L;
    bf16x8 afr[2];
#pragma unroll
    for (int k2 = 0; k2 < 2; ++k2) { v4u o; o.x = pkbf(acc[2 * k2][0] * inv, acc[2 * k2][1] * inv); o.y = pkbf(acc[2 * k2][2] * inv, acc[2 * k2][3] * inv);
        o.z = pkbf(acc[2 * k2 + 1][0] * inv, acc[2 * k2 + 1][1] * inv); o.w = pkbf(acc[2 * k2 + 1][2] * inv, acc[2 * k2 + 1][3] * inv); afr[k2] = __builtin_bit_cast(bf16x8, o); }
    LAS f32x4* red = (LAS f32x4*)lds;
    {
      __builtin_amdgcn_sched_barrier(0);
#pragma unroll
      for (int vt = 0; vt < 8; ++vt) { f32x4 o = {0.f, 0.f, 0.f, 0.f};
#pragma unroll
          for (int k2 = 0; k2 < 2; ++k2) { v4u bw; bw.x = (unsigned)wl_[vt][k2][0]; bw.y = (unsigned)(wl_[vt][k2][0] >> 32); bw.z = (unsigned)wl_[vt][k2][1]; bw.w = (unsigned)(wl_[vt][k2][1] >> 32);
              o = __builtin_amdgcn_mfma_f32_16x16x32_bf16(afr[k2], __builtin_bit_cast(bf16x8, bw), o, 0, 0, 0); }
          red[(wave * 8 + vt) * 64 + lane] = o; } }
    __syncthreads();
    f32x4 s = {0.f, 0.f, 0.f, 0.f};
#pragma unroll
    for (int w = 0; w < 8; ++w) s += red[(w * 8 + wave) * 64 + lane];
    f32x4 ss = s * s;
#pragma unroll
    for (int r = 0; r < 4; ++r) { float t = ss[r]; t += swz_xor<1>(t); t += swz_xor<2>(t); t += swz_xor<4>(t); t += swz_xor<8>(t); ss[r] = t; }
    LAS float* sq = (LAS float*)(lds + 65536);
    if (qi == 0) {
#pragma unroll
        for (int r = 0; r < 4; ++r) sq[wave * 16 + 4 * g + r] = ss[r]; }
    const int col = h * 128 + 16 * wave + qi; const float gn = gain[col];
#pragma unroll
    for (int r = 0; r < 4; ++r) MIXs[kb32(b * TS + 4 * g + r, col)] = (bf16)(pkbf(s[r] * gn, 0.f) & 0xffffu);
    __syncthreads();
    if (wave == 0 && lane < 16) { float t = 0.f;
#pragma unroll
        for (int w = 0; w < 8; ++w) t += sq[w * 16 + lane];
        SSA[h * 256 + b * TS + lane] = t; }
    __syncthreads();
}

#ifndef MK_MULTI
#define MK_MULTI 0
#endif
#ifndef REP_PREP
#define REP_PREP 1
#endif
#ifndef REP_MOD
#define REP_MOD 1
#endif
#ifndef REP_DN
#define REP_DN 1
#endif
#ifndef REP_OUT
#define REP_OUT 1
#endif
#ifndef REP_N1
#define REP_N1 1
#endif
#ifndef REP_SATT
#define REP_SATT 1
#endif
#ifndef REP_UP
#define REP_UP 1
#endif
#ifndef REP_IN
#define REP_IN 1
#endif
#ifndef REP_QKV
#define REP_QKV 1
#endif
#ifndef REP_ATT
#define REP_ATT 1
#endif
#ifndef REP_QABS
#define REP_QABS 1
#endif
#ifndef REP_SABS
#define REP_SABS 1
#endif
#ifndef REP_COMB
#define REP_COMB 1
#endif
#ifndef REP_ELT
#define REP_ELT 1
#endif
constexpr int PH_PREP = 0, PH_MOD = 1, PH_L0 = 2, PH_PER_LAYER = 10, PH_FINAL = PH_L0 + DEPTH * PH_PER_LAYER, N_PHASES = PH_FINAL + 1;
struct Args { const float* in[21]; float* out; unsigned char* ws; int ph_lo, ph_hi; };
static_assert(sizeof(Args) == 21 * 8 + 8 + 8 + 8, "Args has no padding");

__global__ void __launch_bounds__(NWAVES * 64, 2) trunk_fwd(Args args) {
    extern __shared__ __attribute__((aligned(16))) unsigned char lds_raw[];
    LAS unsigned char* lds = (LAS unsigned char*)lds_raw;
    volatile LAS unsigned* MISC = (volatile LAS unsigned*)(lds + MISC_OFF);
    const int wave0 = __builtin_amdgcn_readfirstlane((int)threadIdx.x >> 6);
    const int G = gridDim.x; const int bx = blockIdx.x; const int vcu = (G % 8 == 0) ? (bx % 8) * (G / 8) + bx / 8 : bx;
    { const int t0 = threadIdx.x; for (int u = t0; u < (LDS_BYTES - LDSCTL_OFF) / 4; u += NWAVES * 64) ((LAS unsigned*)(lds + LDSCTL_OFF))[u] = 0u; }
    __syncthreads();
#if MK_MULTI
#define GRID_BAR() do { } while (0)
#else
    XcdBarrier bar = xcd_barrier_post((unsigned*)((gu32*)(args.ws + WS_CTL) + CW_BAR), MISC + 8);
#define GRID_BAR() xcd_barrier(bar)
#endif
    const int lo = args.ph_lo, hi = args.ph_hi;
#define IN(k) (lo <= (k) && (k) < hi)
#ifndef REP_SG
#define REP_SG 1
#endif
#ifndef REP_KPE
#define REP_KPE 1
#endif
#ifndef REP_ROWS
#define REP_ROWS 1
#endif
#ifndef REP_BAR
#define REP_BAR 1
#endif
#define SEAM(k) do { if ((k) + 1 < hi) { for (int rb_ = 0; rb_ < REP_BAR; ++rb_) GRID_BAR(); } } while (0)
#define PHASE_ENV() int ln_; asm volatile("v_mbcnt_lo_u32_b32 %0, -1, 0\n\tv_mbcnt_hi_u32_b32 %0, -1, %0" : "=v"(ln_)); int wv_ = wave0; asm volatile("" : "+s"(wv_)); const int wave = wv_, lane = ln_, tid = wave * 64 + lane; \
    const int SGW_ = (wave == 0) ? vcu : (1 << 20); (void)SGW_; const int PGW_ = (G == 256) ? (wave * 256 + vcu) : (vcu * NWAVES + wave); (void)PGW_;         \
    const int gw = vcu * NWAVES + wave, NGW = G * NWAVES, gt = gw * 64 + lane, NGT = NGW * 64; (void)gt; (void)NGT; (void)gw; (void)NGW; (void)tid; (void)lane; \
    size_t zoff_ = 0; asm volatile("" : "+s"(zoff_)); unsigned char* ws = args.ws + zoff_; float* out = args.out; (void)out; \
    float* X = (float*)(ws + WS_X); bf16* XB = (bf16*)(ws + WS_X); (void)XB; bf16* H = (bf16*)(ws + WS_H); bf16* Z = (bf16*)(ws + WS_Z); bf16* QN = (bf16*)(ws + WS_QN); bf16* CKV = (bf16*)(ws + WS_CKV); \
    bf16* KPE = (bf16*)(ws + WS_KPE); bf16* Qb = (bf16*)(ws + WS_Q); bf16* KVb = (bf16*)(ws + WS_KV); bf16* MIX = (bf16*)(ws + WS_MIX); bf16* HB = (bf16*)(ws + WS_HB); \
    const float* cosT = (const float*)(ws + WS_COS); const float* sinT = (const float*)(ws + WS_SIN); \
    const unsigned char* wl = ws + WS_W + (size_t)l * W_LAYER; const float* modl = (const float*)(ws + WS_MOD) + (size_t)l * NB * MODW; \
    float* ZS = (float*)(ws + WS_ZS); float* PS = (float*)(ws + WS_PS); const int rbx = G - 1 - bx; const bool sg_first_ = (bx & 1) != 0; (void)ZS; (void)PS; (void)rbx; (void)sg_first_; \
    (void)X; (void)H; (void)Z; (void)QN; (void)CKV; (void)KPE; (void)Qb; (void)KVb; (void)MIX; (void)HB; (void)cosT; (void)sinT; (void)wl; (void)modl;

    if (IN(PH_PREP)) for (int rep_ = 0; rep_ < REP_PREP; ++rep_) { const int l = 0; PHASE_ENV(); p0_prep(args.in[9], args.in[11], args.in[13], args.in[17], args.in[18], args.in[19], args.in[2], args.in[3], ws, lds, tid, lane, wave, vcu, G);
        if (G != 256) prep_qabs(args.in[11], args.in[13], ws, lds, tid, lane, wave, vcu, G);
        SEAM(PH_PREP); }
    if (IN(PH_MOD)) for (int rep_ = 0; rep_ < REP_MOD; ++rep_) { const int l = 0; PHASE_ENV(); p1_mod(args.in[7], args.in[8], ws, lds, tid, lane, wave, vcu, G);
        if (G == 256 && (vcu & 3) == 3) prep_qabs(args.in[11], args.in[13], ws, lds, tid, lane, wave, vcu >> 2, 64);
        SEAM(PH_MOD); }

    for (int l = 0; l < DEPTH; ++l) {
        const int pb = PH_L0 + l * PH_PER_LAYER;
        if (hi <= pb || lo >= pb + PH_PER_LAYER) continue;
        if (IN(pb + 0)) { PHASE_ENV(); for (int rep_ = 0; rep_ < REP_N1; ++rep_) { if (l == 0) norm_rows<true>(args.in[0], modl, 0, DM, H, lane, PGW_, NGW); else norm_rows<false>(XB, modl, 0, DM, H, lane, PGW_, NGW); }
            norm_rows_s_coop<false>(args.in[1], X, l == 0, PS, l == 0 ? 0 : 4, modl - (size_t)NB * MODW + 5 * DM, modl, 0, DM, H + (size_t)MP * DM, nullptr, nullptr, (LAS float*)lds, lane, wave, vcu, G);
            SEAM(pb + 0); }
        if (IN(pb + 1)) for (int rep_ = 0; rep_ < REP_IN; ++rep_) { PHASE_ENV();
            if (sg_first_) {
            for (int u = rbx; u < 264; u += G) {
                const bool pe = u >= 256; const int cb = pe ? (u & 1) : (u & 127), ks = pe ? ((u - 256) >> 1) : (u >> 7);
                SEpiPart Es{pe ? (float*)(ws + WS_SSA + 65536) + (size_t)ks * MS * 64 : ZS + (size_t)ks * MS * 4096, pe ? 64 : 4096};
                sgemm_unit(lds, H + (size_t)MP * DM, (const bf16*)(wl + (pe ? WO_PE : WO_IN)), DM, 32 * cb, pe ? 512 * ks : 1024 * ks, pe ? 512 : 1024, Es, lane, wave); }
            }
            pg8::Gemm g{H, (const bf16*)(wl + WO_IN), MP, 4096, DM, (pg8::bf16_t*)(ws + WS_DUMMY)}; pg8::StaticOrder S; S.init(MP, 4096, G, bx);
            pg8::EpiZ E{Z};
            pg8::gemm_phase<pg8::EpiZ, pg8::StaticOrder, true, true>(lds, g, S, E, wave0);
            __syncthreads();
            if (!sg_first_) {
            for (int u = rbx; u < 264; u += G) {
                const bool pe = u >= 256; const int cb = pe ? (u & 1) : (u & 127), ks = pe ? ((u - 256) >> 1) : (u >> 7);
                SEpiPart Es{pe ? (float*)(ws + WS_SSA + 65536) + (size_t)ks * MS * 64 : ZS + (size_t)ks * MS * 4096, pe ? 64 : 4096};
                sgemm_unit(lds, H + (size_t)MP * DM, (const bf16*)(wl + (pe ? WO_PE : WO_IN)), DM, 32 * cb, pe ? 512 * ks : 1024 * ks, pe ? 512 : 1024, Es, lane, wave); }
            }
            SEAM(pb + 1);
        }
        if (IN(pb + 2)) for (int rep_ = 0; rep_ < REP_ELT; ++rep_) {
#pragma unroll 1
            for (int slot = 0; slot < 2; ++slot) { PHASE_ENV();
                if ((slot == 0) != sg_first_) elt_kpe(H, (const bf16*)(wl + WO_PE), KPE, cosT, sinT, out + O_KPEP + (size_t)l * MP * 64, out + O_KPES + (size_t)l * MS * 64, lds, tid, lane, wave, vcu, G);
                else elt_rows(Z, args.in[10] + l * QLR, args.in[12] + l * KVLR, args.in[14] + l * 3 * DCONV, args.in[16] + l * DCONV, args.in[6] + (size_t)l * NBS * 2 * DCONV,
                     QN, CKV, MIX, out + O_CKVP + (size_t)l * MP * 512, out + O_CKVS + (size_t)l * MS * 512, out + O_CONVP + (size_t)l * NBP * 2 * DCONV, out + O_CONVS + (size_t)l * NBS * 2 * DCONV, args.in[4] + (size_t)l * MC * 512, lane, gw, NGW);
            }
            PHASE_ENV();
            elt_rows_s(ZS, args.in[10] + l * QLR, args.in[12] + l * KVLR, args.in[14] + l * 3 * DCONV, args.in[16] + l * DCONV, args.in[6] + (size_t)l * NBS * 2 * DCONV,
                       QN + (size_t)MP * QLR, CKV + (size_t)KVROW_S * KVLR, MIX + (size_t)MP * DM, out + O_CKVS + (size_t)l * MS * 512, out + O_CONVS + (size_t)l * NBS * 2 * DCONV, lane, wave < 4 ? vcu : (1 << 20), G,
                       (const float*)(ws + WS_SSA + 65536), KPE + (size_t)KVROW_S * 64, out + O_KPES + (size_t)l * MS * 64, cosT, sinT, wave);
            SEAM(pb + 2);
        }
        if (IN(pb + 3)) for (int rep_ = 0; rep_ < REP_QKV; ++rep_) { PHASE_ENV();
            { pg8::Gemm g{QN, (const bf16*)(wl + WO_UQ), MP, NQ, QLR, (pg8::bf16_t*)(ws + WS_DUMMY)}; pg8::StaticOrder S; S.init(MP, NQ, G, bx);
              pg8::EpiStore<0> E{Qb, NQ};
              pg8::gemm_phase<pg8::EpiStore<0>, pg8::StaticOrder, true, true>(lds, g, S, E, wave0); }
            __syncthreads();
            { pg8::Gemm g{CKV, (const bf16*)(wl + WO_UKV), MP, NKV, KVLR, (pg8::bf16_t*)(ws + WS_DUMMY)}; pg8::StaticOrder S; S.init(MP, NKV, G, bx);
              pg8::EpiStore<0> E{KVb, NKV};
              pg8::gemm_phase<pg8::EpiStore<0>, pg8::StaticOrder, true, true>(lds, g, S, E, wave0); }
            __syncthreads();
            if (G != 256 || rbx < 128) for (int u = rbx; u < 144; u += (G == 256 ? 128 : G)) {
                if (u < 128) { SEpiBf<0> Es{(bf16*)(ws + WS_QA)}; sgemm_unit(lds, QN + (size_t)MP * QLR, (const bf16*)(wl + WO_QA), QLR, 32 * u, 0, 512, Es, lane, wave); }
                else { const int hh = (u - 128) >> 1, hf = (u - 128) & 1; SEpiBf<0> Es{(bf16*)(ws + WS_QA), 124 - 4 * hh};
                    sgemm_unit(lds, QN + (size_t)MP * QLR, (const bf16*)(wl + WO_UQ), QLR, hh * QKD + 128 + 32 * hf, 0, 512, Es, lane, wave); } }
            SEAM(pb + 3);
        }
        if (IN(pb + 4)) for (int rep_ = 0; rep_ < REP_ATT; ++rep_) {
#pragma unroll 1
            for (int slot = 0; slot < 3; ++slot) { PHASE_ENV();
                const int bh = vcu >> 2, role = vcu & 3;
                const int kind = sg_first_ ? (slot == 0 ? 2 : slot - 1) : (slot == 2 ? 2 : slot);
                if (kind == 2) {
                    const int su2_ = (G == 256) ? (((vcu & 15) == 0) ? 256 + (vcu >> 4) : NBS * SCH) : vcu + G;
#pragma unroll 1
                    for (int su = vcu, ns_ = 0; su < NBS * SCH; su = (ns_++ == 0 ? su2_ : su + G)) { const int sb = su < 256 ? (su >> 4) : su - 256, sc_ = su < 256 ? (su & 15) : 16;
                        sabs_unit(sb, sc_, (const bf16*)(ws + WS_QA), CKV, KPE, args.in[4] + (size_t)l * MC * 512, args.in[5] + (size_t)l * MC * 64, cosT, sinT, (bf16*)(ws + WS_PO), (float*)(ws + WS_PML), lds, lane, wave); }
                } else if (G == NBP * NH * 4) att::attn_unit(bh >> 3, bh & 7, kind == 0 ? 7 - role : role, Qb, KVb, KPE, MIX, cosT, sinT, (char*)lds_raw, wave0);
            }
            if (G != NBP * NH * 4) { PHASE_ENV(); (void)lane;
                for (int pu = vcu; pu < NBP * NH * 4; pu += G) { const int bh = pu >> 2, s = pu & 3;
#pragma unroll 1
                    for (int k = 0; k < 2; ++k) att::attn_unit(bh >> 3, bh & 7, k == 0 ? 7 - s : s, Qb, KVb, KPE, MIX, cosT, sinT, (char*)lds_raw, wave0); } }
            SEAM(pb + 4);
        }
        if (IN(pb + 5)) { PHASE_ENV();
#pragma unroll 1
            for (int cu = (G == 256 ? ((vcu & 1) ? NBS * NH : (vcu >> 1)) : vcu); cu < NBS * NH; cu += G) scomb_unit((cu & 127) >> 3, cu & 7, (const bf16*)(ws + WS_PO), (const float*)(ws + WS_PML), (const bf16*)(wl + WO_UKV), args.in[15] + l * DATT, MIX + (size_t)MP * DM, (float*)(ws + WS_SSA), lds, lane, wave);
            if (G == 256) { const int hw_ = (vcu >> 1) * NWAVES + wave; if ((vcu & 1) == 0) anorm_rows(MIX, args.in[15] + l * DATT, lane, hw_, 1024, 2048); else anorm_rows(MIX, args.in[15] + l * DATT, lane, 2048 + hw_, 1024, MP); }
            else anorm_rows(MIX, args.in[15] + l * DATT, lane, gw, NGW, MP);
            SEAM(pb + 5); }
        if (IN(pb + 6)) { PHASE_ENV();
            if (sg_first_) {
            for (int u = rbx; u < 256 * REP_SG; u += G) { const int uu = u & 255; const int cb = uu & 63, ks = uu >> 6; SEpiPart Es{PS + (size_t)ks * MS * DM, DM};
                sgemm_unit(lds, MIX + (size_t)MP * DM, (const bf16*)(wl + WO_OUT), DM, 32 * cb, 512 * ks, 512, Es, lane, wave); }
            }
            pg8::Gemm g{MIX, (const bf16*)(wl + WO_OUT), MP, DM, DM, (pg8::bf16_t*)(ws + WS_DUMMY)}; pg8::StaticOrder S; S.init(MP, DM, G, bx);
            for (int rep_ = 1; rep_ < REP_OUT; ++rep_) { pg8::EpiResid Ed{l == 0 ? args.in[0] : nullptr, XB, (bf16*)(ws + WS_END), modl + 2 * DM}; pg8::gemm_phase<pg8::EpiResid, pg8::StaticOrder, true, true>(lds, g, S, Ed, wave0); __syncthreads(); }
            pg8::EpiResid E{l == 0 ? args.in[0] : nullptr, XB, XB, modl + 2 * DM};
            pg8::gemm_phase<pg8::EpiResid, pg8::StaticOrder, true, true>(lds, g, S, E, wave0);
            __syncthreads();
            if (!sg_first_) {
            for (int u = rbx; u < 256 * REP_SG; u += G) { const int uu = u & 255; const int cb = uu & 63, ks = uu >> 6; SEpiPart Es{PS + (size_t)ks * MS * DM, DM};
                sgemm_unit(lds, MIX + (size_t)MP * DM, (const bf16*)(wl + WO_OUT), DM, 32 * cb, 512 * ks, 512, Es, lane, wave); }
            }
            SEAM(pb + 6);
        }
        if (IN(pb + 7)) { PHASE_ENV(); norm_rows<false>(XB, modl, 3 * DM, 4 * DM, H, lane, PGW_, NGW);
            norm_rows_s_coop<false>(nullptr, X, false, PS, 4, modl + 2 * DM, modl, 3 * DM, 4 * DM, H + (size_t)MP * DM, nullptr, nullptr, (LAS float*)lds, lane, wave, vcu, G, (const float*)(ws + WS_SSA));
            SEAM(pb + 7); }
        if (IN(pb + 8)) for (int rep_ = 0; rep_ < REP_UP; ++rep_) { PHASE_ENV();
            if (sg_first_) {
            for (int u = rbx; u < 256 * REP_SG; u += G) { SEpiBf<1> Es{HB + (size_t)MP * DFF};
                sgemm_unit(lds, H + (size_t)MP * DM, (const bf16*)(wl + WO_UP), DM, 32 * (u & 255), 0, 2048, Es, lane, wave); }
            }
            pg8::Gemm g{H, (const bf16*)(wl + WO_UP), MP, DFF, DM, (pg8::bf16_t*)(ws + WS_DUMMY)}; pg8::StaticOrder S; S.init(MP, DFF, G, bx);
            pg8::EpiStore<1> E{HB, DFF};
            pg8::gemm_phase<pg8::EpiStore<1>, pg8::StaticOrder, true, true>(lds, g, S, E, wave0);
            __syncthreads();
            if (!sg_first_) {
            for (int u = rbx; u < 256 * REP_SG; u += G) { SEpiBf<1> Es{HB + (size_t)MP * DFF};
                sgemm_unit(lds, H + (size_t)MP * DM, (const bf16*)(wl + WO_UP), DM, 32 * (u & 255), 0, 2048, Es, lane, wave); }
            }
            SEAM(pb + 8);
        }
        if (IN(pb + 9)) { PHASE_ENV();
            if (sg_first_) {
            for (int u = rbx; u < 256 * REP_SG; u += G) { const int uu = u & 255; const int cb = uu & 63, ks = uu >> 6; SEpiPart Es{PS + (size_t)ks * MS * DM, DM};
                sgemm_unit(lds, HB + (size_t)MP * DFF, (const bf16*)(wl + WO_DN), DFF, 32 * cb, 2048 * ks, 2048, Es, lane, wave); }
            }
            pg8::Gemm g{HB, (const bf16*)(wl + WO_DN), MP, DM, DFF, (pg8::bf16_t*)(ws + WS_DUMMY)}; pg8::StaticOrder S; S.init(MP, DM, G, bx);
            for (int rep_ = 1; rep_ < REP_DN; ++rep_) { pg8::EpiResid Ed{nullptr, XB, (bf16*)(ws + WS_END), modl + 5 * DM}; pg8::gemm_phase<pg8::EpiResid, pg8::StaticOrder, true, true>(lds, g, S, Ed, wave0); __syncthreads(); }
            pg8::EpiResid E{nullptr, XB, XB, modl + 5 * DM};
            pg8::gemm_phase<pg8::EpiResid, pg8::StaticOrder, true, true>(lds, g, S, E, wave0);
            __syncthreads();
            if (!sg_first_) {
            for (int u = rbx; u < 256 * REP_SG; u += G) { const int uu = u & 255; const int cb = uu & 63, ks = uu >> 6; SEpiPart Es{PS + (size_t)ks * MS * DM, DM};
                sgemm_unit(lds, HB + (size_t)MP * DFF, (const bf16*)(wl + WO_DN), DFF, 32 * cb, 2048 * ks, 2048, Es, lane, wave); }
            }
            SEAM(pb + 9);
        }
    }
    int lo_f = args.ph_lo, hi_f = args.ph_hi; asm volatile("" : "+s"(lo_f), "+s"(hi_f));
    if (lo_f <= PH_FINAL && PH_FINAL < hi_f) { const int l = 0; PHASE_ENV(); final_norm_rows(XB, args.in[20], out, lane, PGW_, NGW);
        norm_rows_s_coop<true>(nullptr, X, false, PS, 4, (const float*)(ws + WS_MOD) + (size_t)(DEPTH - 1) * NB * MODW + 5 * DM, nullptr, 0, 0, nullptr, args.in[20], out, (LAS float*)lds, lane, wave, vcu, G); }
#undef IN
#undef SEAM
}

extern "C" void kernel_launch(void* const* d_in, const int* in_sizes, int n_in, void* d_out, int out_size, void* d_ws, size_t ws_size, hipStream_t stream) {
    static int grid = 0;
    if (grid == 0) {
        if (n_in != 21 || in_sizes[0] != MP * DM || (size_t)out_size != O_END || ws_size < WS_END + ((REP_DN > 1 || REP_OUT > 1) ? (size_t)MP * DM * 4 : 0)) {
            fprintf(stderr, "kernel_launch: shape mismatch: n_in %d in0 %d out %d ws %zu (need %zu); nothing launched\n", n_in, n_in > 0 ? in_sizes[0] : -1, out_size, ws_size, (size_t)WS_END); grid = -1; return; }
        int dev = 0, cus = 0, per_cu = 0;
        if (hipGetDevice(&dev) != hipSuccess || hipDeviceGetAttribute(&cus, hipDeviceAttributeMultiprocessorCount, dev) != hipSuccess) { fprintf(stderr, "kernel_launch: device query failed\n"); grid = -1; return; }
        if (hipFuncSetAttribute((const void*)trunk_fwd, hipFuncAttributeMaxDynamicSharedMemorySize, LDS_BYTES) != hipSuccess) { fprintf(stderr, "kernel_launch: hipFuncSetAttribute failed\n"); grid = -1; return; }
        if (hipOccupancyMaxActiveBlocksPerMultiprocessor(&per_cu, (const void*)trunk_fwd, NWAVES * 64, LDS_BYTES) != hipSuccess || per_cu < 1)
            fprintf(stderr, "kernel_launch: note: occupancy query reports %d workgroups per CU\n", per_cu);
        (void)hipGetLastError();
        grid = cus;
    }
    if (grid < 0) return;
    if (hipMemsetAsync((char*)d_ws + WS_CTL, 0, CTL_ZERO_BYTES, stream) != hipSuccess) { fprintf(stderr, "kernel_launch: memset failed\n"); return; }
    Args a{};
    for (int i = 0; i < 21; ++i) a.in[i] = (const float*)d_in[i];
    a.out = (float*)d_out; a.ws = (unsigned char*)d_ws;
#if MK_MULTI
    for (int p = 0; p < N_PHASES; ++p) { a.ph_lo = p; a.ph_hi = p + 1; hipLaunchKernelGGL(trunk_fwd, dim3(grid), dim3(NWAVES * 64), LDS_BYTES, stream, a); }
#else
    a.ph_lo = 0; a.ph_hi = N_PHASES;
    hipLaunchKernelGGL(trunk_fwd, dim3(grid), dim3(NWAVES * 64), LDS_BYTES, stream, a);
#endif
    const hipError_t le = hipPeekAtLastError();
    if (le != hipSuccess) fprintf(stderr, "kernel_launch: launch failed: %s\n", hipGetErrorName(le));
}
```
